# Optimizing an MI355X kernel written in HIP

```python
import math
import jax, jax.numpy as jnp
from jax import lax
import numpy as np

D_MODEL = 1024
BATCH = 4
SEQ = 8192
DEPTH = 2

CHUNK = 64
N_MEM = 256
EPS = 1e-6
ROPE_BASE = 10000.0
MAX_POS_OFFSET = 16384

RET_HEADS = 4
RET_DK = 96
RET_DV = 96
RET_QK = RET_HEADS * RET_DK
RET_VW = RET_HEADS * RET_DV
HG_HEADS = 4
HG_DK = 128
HG_DV = 96
HG_QK = HG_HEADS * HG_DK
HG_VW = HG_HEADS * HG_DV
LRU_WIDTH = 256
LRU_BLOCKS = 4
LRU_BW = LRU_WIDTH // LRU_BLOCKS
CONV_W = 4
LRU_C = 8.0
D_IN = 2 * RET_QK + 2 * RET_VW + 2 * HG_QK + 2 * HG_VW + 2 * LRU_WIDTH
D_MIX = RET_VW + HG_VW + LRU_WIDTH
X_HEADS = 4
X_HD = D_MODEL // X_HEADS
D_FF = 2816

kernel_name = "hymba_ret_hgrn2_rglru_macaron_encoder"

F32 = jnp.float32


def rms_norm(x, g):
    xf = x.astype(F32)
    y = xf * lax.rsqrt(jnp.mean(xf * xf, axis=-1, keepdims=True) + EPS)
    return (y * g.astype(F32)).astype(x.dtype)


def head_group_norm(o, g):
    of = o.astype(F32)
    c = of - jnp.mean(of, axis=-1, keepdims=True)
    y = c * lax.rsqrt(jnp.mean(c * c, axis=-1, keepdims=True) + EPS)
    return y.reshape(o.shape[0], o.shape[1], -1) * g.astype(F32)


def head_rms_norm(o, g):
    of = o.astype(F32)
    y = of * lax.rsqrt(jnp.mean(of * of, axis=-1, keepdims=True) + EPS)
    return y.reshape(o.shape[0], o.shape[1], -1) * g.astype(F32)


def swiglu(h, w1, w3, w2):
    return (jax.nn.silu(h @ w1) * (h @ w3)) @ w2


def apply_rope(t, positions):
    d = t.shape[-1]
    half = d // 2
    inv_freq = jnp.exp(-math.log(ROPE_BASE) * jnp.arange(half, dtype=F32) / half)
    ang = positions.astype(F32)[..., None] * inv_freq
    cos = jnp.cos(ang)[:, :, None, :]
    sin = jnp.sin(ang)[:, :, None, :]
    t1 = t[..., :half].astype(F32)
    t2 = t[..., half:].astype(F32)
    return jnp.concatenate([t1 * cos - t2 * sin, t1 * sin + t2 * cos], axis=-1).astype(t.dtype)


def retention(q, k, v, positions):
    b, s, h, dk = q.shape
    dv = v.shape[-1]
    n = s // CHUNK
    q = apply_rope(q, positions) * (dk ** -0.5)
    k = apply_rope(k, positions)
    log_gamma = jnp.log1p(-jnp.exp2(-5.0 - jnp.arange(h, dtype=F32)))
    idx = jnp.arange(CHUNK, dtype=F32)
    dist = jnp.abs(idx[:, None] - idx[None, :])
    intra_decay = jnp.exp(log_gamma[:, None, None] * dist)
    q_in = jnp.exp(log_gamma[None, :] * (idx[:, None] + 1.0))
    k_out = jnp.exp(log_gamma[None, :] * (CHUNK - 1.0 - idx[:, None]))
    chunk_decay = jnp.exp(log_gamma * CHUNK)
    qc = q.reshape(b, n, CHUNK, h, dk)
    kc = k.reshape(b, n, CHUNK, h, dk)
    vc = v.reshape(b, n, CHUNK, h, dv)
    scores = jnp.einsum('bnihd,bnjhd->bnhij', qc, kc) * intra_decay
    intra = jnp.einsum('bnhij,bnjhe->bnihe', scores, vc)
    kv_local = jnp.einsum('bnjhd,jh,bnjhe->nbhde', kc, k_out, vc)

    def step(state, kv):
        return chunk_decay[None, :, None, None] * state + kv, state

    _, prev = lax.scan(step, jnp.zeros(kv_local.shape[1:], kv_local.dtype), kv_local)
    inter = jnp.einsum('bnihd,ih,nbhde->bnihe', qc, q_in, prev)
    return (intra + inter).reshape(b, s, h, dv)


def hgrn2(q, f_logit, inp, lb):
    b, s, h, dk = q.shape
    dv = inp.shape[-1]
    n = s // CHUNK
    lbh = lb.reshape(h, dk).astype(F32)
    f = lbh + (1.0 - lbh) * jax.nn.sigmoid(f_logit.astype(F32))
    log_f = jnp.log(f)
    k = 1.0 - f
    q = jax.nn.silu(q)

    def to_chunks(t):
        return t.reshape(b, n, CHUNK, h, t.shape[-1]).swapaxes(0, 1)

    def step(state, xs):
        qc, kc, ic, lfc = xs
        cum = jnp.cumsum(lfc, axis=1)
        decay = jnp.exp(-jnp.abs(cum[:, :, None] - cum[:, None, :]))
        scores = jnp.einsum('bthd,bjhd,btjhd->bhtj', qc, kc, decay)
        intra = jnp.einsum('bhtj,bjhe->bthe', scores, ic)
        inter = jnp.einsum('bthd,bhde->bthe', qc * jnp.exp(cum), state)
        last = cum[:, -1]
        new_state = jnp.exp(last)[..., None] * state + jnp.einsum(
            'bjhd,bjhe->bhde', kc * jnp.exp(last[:, None] - cum), ic)
        return new_state, (intra + inter).astype(F32)

    state0 = jnp.zeros((b, h, dk, dv), F32)
    _, out = lax.scan(step, state0, (to_chunks(q), to_chunks(k), to_chunks(inp), to_chunks(log_f)))
    return out.swapaxes(0, 1).reshape(b, s, h, dv)


def _linear_combine(c1, c2):
    a1, b1 = c1
    a2, b2 = c2
    return a1 * a2, a2 * b1 + b2


def rg_lru_branch(xb, gb, conv_w, conv_b, wa, ba, wx, bx, lam):
    b, s, w = xb.shape
    xc = lax.conv_general_dilated(
        xb, conv_w[:, None, :].astype(xb.dtype), window_strides=(1,),
        padding=[(CONV_W - 1, 0)], dimension_numbers=('NWC', 'WIO', 'NWC'),
        feature_group_count=w) + conv_b
    xr = xc.reshape(b, s, LRU_BLOCKS, LRU_BW)
    r = jax.nn.sigmoid(jnp.einsum('bsnc,ncd->bsnd', xr, wa).reshape(b, s, w) + ba).astype(F32)
    i = jax.nn.sigmoid(jnp.einsum('bsnc,ncd->bsnd', xr, wx).reshape(b, s, w) + bx).astype(F32)
    log_a = -LRU_C * jax.nn.softplus(-lam.astype(F32)) * r
    a = jnp.exp(log_a)
    u = jnp.sqrt(-jnp.expm1(2.0 * log_a)) * (i * xc.astype(F32))
    _, hs = lax.associative_scan(_linear_combine, (a, u), axis=1)
    return (hs * jax.nn.gelu(gb.astype(F32))).astype(xb.dtype)


def cross_attention(h, mem_n, wq, wkv, wo):
    b, s, _ = h.shape
    m = mem_n.shape[1]
    q = (h @ wq).reshape(b, s, X_HEADS, X_HD)
    kv = mem_n @ wkv
    k = kv[..., :D_MODEL].reshape(b, m, X_HEADS, X_HD)
    v = kv[..., D_MODEL:].reshape(b, m, X_HEADS, X_HD)
    sc = jnp.einsum('bshd,bmhd->bhsm', q, k).astype(F32) * (X_HD ** -0.5)
    p = jax.nn.softmax(sc, axis=-1).astype(v.dtype)
    o = jnp.einsum('bhsm,bmhd->bshd', p, v).reshape(b, s, D_MODEL)
    return o @ wo


def setup_inputs(seed: int = 0) -> dict:
    key = jax.random.key(seed)
    ks = iter(jax.random.split(key, 40))

    def nrm(shape, scale):
        return jax.random.normal(next(ks), shape, F32) * scale

    def gain(shape):
        return 1.0 + 0.02 * jax.random.normal(next(ks), shape, F32)

    x = nrm((BATCH, SEQ, D_MODEL), 1.0)
    mem = nrm((BATCH, N_MEM, D_MODEL), 1.0)
    start = jax.random.randint(next(ks), (BATCH, 1), 0, MAX_POS_OFFSET, dtype=jnp.int32)
    positions = (start + jnp.arange(SEQ, dtype=jnp.int32)[None, :]).astype(jnp.int32)
    ffn1_norm_g = gain((DEPTH, D_MODEL))
    ffn1_w1 = nrm((DEPTH, D_MODEL, D_FF), D_MODEL ** -0.5)
    ffn1_w3 = nrm((DEPTH, D_MODEL, D_FF), D_MODEL ** -0.5)
    ffn1_w2 = nrm((DEPTH, D_FF, D_MODEL), D_FF ** -0.5)
    mix_norm_g = gain((DEPTH, D_MODEL))
    w_in = nrm((DEPTH, D_MODEL, D_IN), D_MODEL ** -0.5)
    ret_gn_g = gain((DEPTH, RET_VW))
    hg_lb_param = nrm((DEPTH, HG_QK), 0.1)
    hg_norm_g = gain((DEPTH, HG_VW))
    lru_conv_w = nrm((DEPTH, CONV_W, LRU_WIDTH), CONV_W ** -0.5)
    lru_conv_b = nrm((DEPTH, LRU_WIDTH), 0.01)
    lru_wa = nrm((DEPTH, LRU_BLOCKS, LRU_BW, LRU_BW), LRU_BW ** -0.5)
    lru_ba = nrm((DEPTH, LRU_WIDTH), 0.01)
    lru_wx = nrm((DEPTH, LRU_BLOCKS, LRU_BW, LRU_BW), LRU_BW ** -0.5)
    lru_bx = nrm((DEPTH, LRU_WIDTH), 0.01)
    a_pow = jax.random.uniform(next(ks), (DEPTH, LRU_WIDTH), F32, minval=0.9, maxval=0.999)
    a0 = a_pow ** (1.0 / LRU_C)
    lru_lambda = jnp.log(a0) - jnp.log1p(-a0)
    w_out = nrm((DEPTH, D_MIX, D_MODEL), D_MIX ** -0.5)
    xattn_norm_g = gain((DEPTH, D_MODEL))
    xattn_mem_g = gain((DEPTH, D_MODEL))
    xattn_wq = nrm((DEPTH, D_MODEL, D_MODEL), D_MODEL ** -0.5)
    xattn_wkv = nrm((DEPTH, D_MODEL, 2 * D_MODEL), D_MODEL ** -0.5)
    xattn_wo = nrm((DEPTH, D_MODEL, D_MODEL), D_MODEL ** -0.5)
    ffn2_norm_g = gain((DEPTH, D_MODEL))
    ffn2_w1 = nrm((DEPTH, D_MODEL, D_FF), D_MODEL ** -0.5)
    ffn2_w3 = nrm((DEPTH, D_MODEL, D_FF), D_MODEL ** -0.5)
    ffn2_w2 = nrm((DEPTH, D_FF, D_MODEL), D_FF ** -0.5)
    final_norm_g = gain((D_MODEL,))
    return {
        "x": x, "mem": mem, "positions": positions,
        "ffn1_norm_g": ffn1_norm_g, "ffn1_w1": ffn1_w1, "ffn1_w3": ffn1_w3, "ffn1_w2": ffn1_w2,
        "mix_norm_g": mix_norm_g, "w_in": w_in, "ret_gn_g": ret_gn_g,
        "hg_lb_param": hg_lb_param, "hg_norm_g": hg_norm_g,
        "lru_conv_w": lru_conv_w, "lru_conv_b": lru_conv_b, "lru_wa": lru_wa, "lru_ba": lru_ba,
        "lru_wx": lru_wx, "lru_bx": lru_bx, "lru_lambda": lru_lambda, "w_out": w_out,
        "xattn_norm_g": xattn_norm_g, "xattn_mem_g": xattn_mem_g, "xattn_wq": xattn_wq,
        "xattn_wkv": xattn_wkv, "xattn_wo": xattn_wo,
        "ffn2_norm_g": ffn2_norm_g, "ffn2_w1": ffn2_w1, "ffn2_w3": ffn2_w3, "ffn2_w2": ffn2_w2,
        "final_norm_g": final_norm_g,
    }


def reference(x, mem, positions, ffn1_norm_g, ffn1_w1, ffn1_w3, ffn1_w2, mix_norm_g, w_in,
              ret_gn_g, hg_lb_param, hg_norm_g, lru_conv_w, lru_conv_b, lru_wa, lru_ba,
              lru_wx, lru_bx, lru_lambda, w_out, xattn_norm_g, xattn_mem_g, xattn_wq,
              xattn_wkv, xattn_wo, ffn2_norm_g, ffn2_w1, ffn2_w3, ffn2_w2, final_norm_g):
    b, s, _ = x.shape
    sizes = (RET_QK, RET_QK, RET_VW, RET_VW, HG_QK, HG_QK, HG_VW, HG_VW, LRU_WIDTH, LRU_WIDTH)
    points = [sum(sizes[:j + 1]) for j in range(len(sizes) - 1)]
    lb_all = jnp.cumsum(jax.nn.softmax(hg_lb_param.astype(F32), axis=0), axis=0)
    lb_all = lb_all - lb_all[0:1]
    for l in range(DEPTH):
        x = x + 0.5 * swiglu(rms_norm(x, ffn1_norm_g[l]), ffn1_w1[l], ffn1_w3[l], ffn1_w2[l])
        h = rms_norm(x, mix_norm_g[l])
        proj = h @ w_in[l]
        rq, rk, rv, rg, hq, hf, hi, hg, lx, lg = jnp.split(proj, points, axis=-1)
        ret = retention(rq.reshape(b, s, RET_HEADS, RET_DK), rk.reshape(b, s, RET_HEADS, RET_DK),
                        rv.reshape(b, s, RET_HEADS, RET_DV), positions)
        ret = (head_group_norm(ret, ret_gn_g[l]) * jax.nn.silu(rg.astype(F32))).astype(x.dtype)
        hgo = hgrn2(hq.reshape(b, s, HG_HEADS, HG_DK), hf.reshape(b, s, HG_HEADS, HG_DK),
                    hi.reshape(b, s, HG_HEADS, HG_DV), lb_all[l])
        hgo = (head_rms_norm(hgo, hg_norm_g[l]) * jax.nn.silu(hg.astype(F32))).astype(x.dtype)
        lru = rg_lru_branch(lx, lg, lru_conv_w[l], lru_conv_b[l], lru_wa[l], lru_ba[l],
                            lru_wx[l], lru_bx[l], lru_lambda[l])
        x = x + jnp.concatenate([ret, hgo, lru], axis=-1) @ w_out[l]
        x = x + cross_attention(rms_norm(x, xattn_norm_g[l]), rms_norm(mem, xattn_mem_g[l]),
                                xattn_wq[l], xattn_wkv[l], xattn_wo[l])
        x = x + 0.5 * swiglu(rms_norm(x, ffn2_norm_g[l]), ffn2_w1[l], ffn2_w3[l], ffn2_w2[l])
    return rms_norm(x, final_norm_g)
```

```cpp
#include <hip/hip_runtime.h>
#include <hip/hip_cooperative_groups.h>
#include <cstdio>
namespace cg = cooperative_groups;

#define LAS __attribute__((address_space(3)))
typedef unsigned short bf16_t;
typedef short bf16x8 __attribute__((ext_vector_type(8)));
typedef float f32x4 __attribute__((ext_vector_type(4)));
typedef unsigned u32x4 __attribute__((ext_vector_type(4)));
typedef unsigned u32x2 __attribute__((ext_vector_type(2)));

constexpr int LDS_BYTES = 155648;
constexpr int NTHREADS = 512;
constexpr long T_TOK = 32768;
#ifndef PHMASK
#define PHMASK 0xffffffffu
#endif
#define PH(n) if ((PHMASK >> (n)) & 1u)
#ifndef REPK
#define REPK 0u
#endif
#define REP_GEMM (((REPK >> k) & 1u) ? 2 : 1)
#ifndef REP_MIX
#define REP_MIX 1
#endif
#ifndef REP_MT
#define REP_MT 0u
#endif
#define RMT(b) for (int r2 = 0; r2 < (((REP_MT >> (b)) & 1u) ? 2 : 1); ++r2)
#ifndef REP_EW
#define REP_EW 1
#endif

constexpr size_t WB_UP1 = 0;
constexpr size_t WB_DN1 = WB_UP1 + 5632ull * 1024 * 2;
constexpr size_t WB_IN = WB_DN1 + 1024ull * 2816 * 2;
constexpr size_t WB_OUT = WB_IN + 3840ull * 1024 * 2;
constexpr size_t WB_Q = WB_OUT + 1024ull * 1024 * 2;
constexpr size_t WB_KV = WB_Q + 1024ull * 1024 * 2;
constexpr size_t WB_O = WB_KV + 2048ull * 1024 * 2;
constexpr size_t WB_UP2 = WB_O + 1024ull * 1024 * 2;
constexpr size_t WB_DN2 = WB_UP2 + 5632ull * 1024 * 2;
constexpr size_t WB_WA = WB_DN2 + 1024ull * 2816 * 2;
constexpr size_t WB_WX = WB_WA + 16384ull * 2;
constexpr size_t WS_BIG = WB_WX + 16384ull * 2;
constexpr size_t WS_H = WS_BIG + 32768ull * 3840 * 2;
constexpr size_t WS_STH = WS_H + 32768ull * 1024 * 2;
constexpr size_t WS_STR = WS_STH + 2048ull * 96 * 128 * 2;
constexpr size_t WS_LASTH = WS_STR + 2048ull * 96 * 96 * 2;
constexpr size_t WS_LRUP = WS_LASTH + 2048ull * 128 * 4;
constexpr size_t WS_LRUH = WS_LRUP + 32768ull * 256 * 2;
constexpr size_t WS_LRUPE = WS_LRUH + 32768ull * 256 * 2;
constexpr size_t WS_LRUHE = WS_LRUPE + 512ull * 256 * 4;
constexpr size_t WS_LRUCI = WS_LRUHE + 512ull * 256 * 4;
constexpr size_t WS_MEMN = WS_LRUCI + 512ull * 256 * 4;
constexpr size_t WS_KMEM = WS_MEMN + 1024ull * 1024 * 2;
constexpr size_t WS_VT = WS_KMEM + 1024ull * 1024 * 2;
constexpr size_t WS_BAR = WS_VT + 1024ull * 1024 * 2;
constexpr size_t WS_SS = WS_BAR + 16384;
constexpr size_t WS_MBT = WS_SS + 2ull * 32768 * 16 * 4;
constexpr size_t WS_VWT = WS_MBT + 4ull * 1024 * 1024 * 2;
constexpr size_t WS_END = WS_VWT + 4ull * 1024 * 1024 * 2;

struct Params {
    const float* in[30];
    float* outp_;
    unsigned char* wsp_;
};

typedef const __attribute__((address_space(4))) Params* KArgP;
__device__ __forceinline__ KArgP kargs() { auto q = __builtin_amdgcn_kernarg_segment_ptr(); asm volatile("" : "+s"(q)); return (KArgP)q; }
#define PIN(i) (kargs()->in[i])
#define WSP (kargs()->wsp_)
#define XOUT (kargs()->outp_)
__device__ __forceinline__ int ltid() { int t = threadIdx.x; asm volatile("" : "+v"(t)); return t; }
__device__ __forceinline__ float bf2f(bf16_t b) { return __uint_as_float(((unsigned)b) << 16); }
typedef float f32x2_t __attribute__((ext_vector_type(2)));
typedef __bf16 bf16x2_t __attribute__((ext_vector_type(2)));
__device__ __forceinline__ unsigned pk2(float lo, float hi) { const f32x2_t f = {lo, hi}; const bf16x2_t b = __builtin_convertvector(f, bf16x2_t); return __builtin_bit_cast(unsigned, b); }
__device__ __forceinline__ bf16_t f2bf(float f) { return (bf16_t)(pk2(f, f) & 0xffffu); }
__device__ __forceinline__ float lo16(unsigned w) { return __uint_as_float(w << 16); }
__device__ __forceinline__ float hi16(unsigned w) { return __uint_as_float(w & 0xffff0000u); }
__device__ __forceinline__ float sigm(float x) { return __builtin_amdgcn_rcpf(1.0f + __expf(-x)); }
__device__ __forceinline__ float silu(float x) { return x * sigm(x); }
__device__ __forceinline__ float gelu_tanh(float x) { return x * sigm(1.5957691216f * (x + 0.044715f * x * x * x)); }
#define UNPACK8(v, f) do { _Pragma("unroll") for (int _i = 0; _i < 4; ++_i) { f[2 * _i] = lo16(v[_i]); f[2 * _i + 1] = hi16(v[_i]); } } while (0)

__device__ __forceinline__ f32x4 mma16(const LAS bf16_t* A, int lda, const LAS bf16_t* B, int ldb, int K, f32x4 acc, int lane) {
    const int r = lane & 15, q = lane >> 4;
    const LAS bf16_t* ap = A + r * lda + q * 8;
    const LAS bf16_t* bp = B + r * ldb + q * 8;
    for (int k0 = 0; k0 < K; k0 += 32) {
        const bf16x8 a = *(const LAS bf16x8*)(ap + k0);
        const bf16x8 b = *(const LAS bf16x8*)(bp + k0);
        acc = __builtin_amdgcn_mfma_f32_16x16x32_bf16(a, b, acc, 0, 0, 0);
    }
    return acc;
}

constexpr int BM = 256, BK = 64, HALF = 128, HTB = HALF * BK * 2;
__device__ __forceinline__ int lds_byte(int r, int c) { const int st = (r >> 4) * 2 + (c >> 5), rr = r & 15, cc = c & 31, ob = rr * 64 + cc * 2; return st * 1024 + (ob ^ (((ob >> 9) & 1) << 5)); }
__device__ __forceinline__ void stage_rc(int b, int& R, int& C) { const int st = b / 1024, sb = b % 1024, swz = sb ^ (((sb >> 9) & 1) << 5); R = (st >> 1) * 16 + swz / 64; C = (st & 1) * 32 + (swz % 64) / 2; }
__device__ __forceinline__ int perm32(int rho) { const int n = rho >> 4, i = rho & 15; return 8 * (i >> 2) + 4 * n + (i & 3); }

struct Unit { int pm, pn, z; };
struct GJob {
    const bf16_t* A; const bf16_t* Bt; int lda, ldb, K, nM, nN, nZ, zshift; long aZ1, aZ2, bZ1, bZ2;
    long rowZ;
};
__device__ __forceinline__ bool g_next(const GJob& g, int i, int G, int c, Unit& u) {
    const int per = g.nM * g.nN, tot = per * g.nZ;
    const long L = (long)i * G + c; if (L >= tot) return false;
    int wgid = (int)L; { const int q = tot / 8, r = tot % 8, xcd = wgid % 8, off = wgid / 8; wgid = (xcd < r ? xcd * (q + 1) : r * (q + 1) + (xcd - r) * q) + off; }
    u.z = wgid / per; const int w = wgid % per;
    const int nig = 8 * g.nN, gid = w / nig, fm = gid * 8, gsz = (g.nM - fm) < 8 ? (g.nM - fm) : 8;
    u.pm = fm + ((w % nig) % gsz); u.pn = (w % nig) / gsz; return true;
}
__device__ __forceinline__ const char* g_aptr(const GJob& g, const Unit& u) {
    const long z1 = u.z >> g.zshift, z2 = u.z & ((1 << g.zshift) - 1);
    return (const char*)(g.A + z1 * g.aZ1 + z2 * g.aZ2 + (long)u.pm * BM * g.lda);
}
__device__ __forceinline__ const char* g_bptr(const GJob& g, const Unit& u) {
    const long z1 = u.z >> g.zshift, z2 = u.z & ((1 << g.zshift) - 1);
    return (const char*)(g.Bt + z1 * g.bZ1 + z2 * g.bZ2 + (long)u.pn * BM * g.ldb);
}

typedef f32x4 AccT[2][2][4][2];

struct Epi {
    int mode; int ldo; int zshift; float scale; bf16_t* O; long oZ1, oZ2; const bf16_t* resb; LAS float* tab;
    long rowZ;
    const float* ss_in;
    float* ss_out;
};
__device__ __forceinline__ float row_rstd(const float* ss, long row) {
    const f32x4* sp = (const f32x4*)(ss + row * 16);
    const f32x4 a = (sp[0] + sp[1]) + (sp[2] + sp[3]);
    return rsqrtf(((a[0] + a[1]) + (a[2] + a[3])) * (1.0f / 1024.0f) + 1e-6f);
}
__device__ __forceinline__ void epi_swiglu(const Epi& E, AccT& acc, const Unit& u, int wr, int wc, int fr, int fq, const LAS float* rst) {
    const long row0 = (long)u.pm * BM + wr * 64 + fr; const int col0 = u.pn * 128 + wc * 32 + 8 * fq;
#pragma unroll
    for (int ai = 0; ai < 2; ++ai)
#pragma unroll
        for (int m = 0; m < 4; ++m) {
            const float rs = rst[ai * 128 + wr * 64 + m * 16 + fr];
            float o[8];
#pragma unroll
            for (int n = 0; n < 2; ++n)
#pragma unroll
                for (int j = 0; j < 4; ++j) o[n * 4 + j] = silu(acc[ai][0][m][n][j] * rs) * (acc[ai][1][m][n][j] * rs);
            u32x4 pk; pk[0] = pk2(o[0], o[1]); pk[1] = pk2(o[2], o[3]); pk[2] = pk2(o[4], o[5]); pk[3] = pk2(o[6], o[7]);
            *(u32x4*)(E.O + (row0 + ai * HALF + m * 16) * 2816 + col0) = pk;
        }
}
#define RESID_LOAD(ai, rv) _Pragma("unroll") for (int m = 0; m < 4; ++m) _Pragma("unroll") for (int bj = 0; bj < 2; ++bj) rv[m][bj] = *(const u32x4*)(E.resb + (row0 + (ai) * HALF + m * 16) * 1024 + col0 + bj * HALF)
#define RESID_COMP(ai, rv, pk) _Pragma("unroll") for (int m = 0; m < 4; ++m) { float sl = 0.f; _Pragma("unroll") for (int bj = 0; bj < 2; ++bj) { \
        float rf[8]; UNPACK8(rv[m][bj], rf); float v[8]; \
        _Pragma("unroll") for (int j = 0; j < 4; ++j) { v[j] = rf[j] + acc[ai][bj][m][0][j] * E.scale; v[4 + j] = rf[4 + j] + acc[ai][bj][m][1][j] * E.scale; } \
        _Pragma("unroll") for (int j = 0; j < 8; ++j) sl += v[j] * v[j]; \
        pk[m][bj][0] = pk2(v[0], v[1]); pk[m][bj][1] = pk2(v[2], v[3]); pk[m][bj][2] = pk2(v[4], v[5]); pk[m][bj][3] = pk2(v[6], v[7]); } ssl[ai][m] = sl; }
#define RESID_STORE(ai, pk) _Pragma("unroll") for (int m = 0; m < 4; ++m) _Pragma("unroll") for (int bj = 0; bj < 2; ++bj) *(u32x4*)(E.O + (row0 + (ai) * HALF + m * 16) * 1024 + col0 + bj * HALF) = pk[m][bj]
__device__ __forceinline__ void epi_resid(const Epi& E, AccT& acc, const Unit& u, int wr, int wc, int fr, int fq) {
    const long row0 = (long)u.z * E.rowZ + (long)u.pm * BM + wr * 64 + fr; const int col0 = u.pn * BM + wc * 32 + 8 * fq;
    float ssl[2][4];
    u32x4 rvA[4][2], pkA[4][2];
    RESID_LOAD(0, rvA);
    asm volatile("" ::: "memory");
    RESID_COMP(0, rvA, pkA);
    u32x4 rvB[4][2];
    RESID_LOAD(1, rvB);
    asm volatile("" ::: "memory");
    RESID_STORE(0, pkA);
    asm volatile("" ::: "memory");
    u32x4 pkB[4][2];
    RESID_COMP(1, rvB, pkB);
    RESID_STORE(1, pkB);
#pragma unroll
    for (int ai = 0; ai < 2; ++ai)
#pragma unroll
        for (int m = 0; m < 4; ++m) {
            float sl = ssl[ai][m];
            sl += __shfl_xor(sl, 16); sl += __shfl_xor(sl, 32);
            if (fq == 0) E.ss_out[(row0 + ai * HALF + m * 16) * 16 + u.pn * 4 + wc] = sl;
        }
}
#undef RESID_LOAD
#undef RESID_COMP
#undef RESID_STORE
__device__ __forceinline__ void epi_bf16(const Epi& E, AccT& acc, const Unit& u, int wr, int wc, int fr, int fq, const LAS float* rst) {
    const long z1 = u.z >> E.zshift, z2 = u.z & ((1 << E.zshift) - 1);
    bf16_t* base = E.O + z1 * E.oZ1 + z2 * E.oZ2;
    const long row0 = (long)u.pm * BM + wr * 64 + fr; const int col0 = u.pn * BM + wc * 32 + 8 * fq;
    const long ldo = E.ldo;
#pragma unroll
    for (int ai = 0; ai < 2; ++ai)
#pragma unroll
        for (int m = 0; m < 4; ++m) {
            float scale = E.scale;
            if (E.ss_in != nullptr) scale *= rst[ai * 128 + wr * 64 + m * 16 + fr];
#pragma unroll
            for (int bj = 0; bj < 2; ++bj) {
                const f32x4 a0 = acc[ai][bj][m][0] * scale, a1 = acc[ai][bj][m][1] * scale;
                u32x4 pk; pk[0] = pk2(a0[0], a0[1]); pk[1] = pk2(a0[2], a0[3]); pk[2] = pk2(a1[0], a1[1]); pk[3] = pk2(a1[2], a1[3]);
                *(u32x4*)(base + (row0 + ai * HALF + m * 16) * ldo + col0 + bj * HALF) = pk;
            }
        }
}
__device__ __forceinline__ void epi_softmax(const Epi& E, AccT& acc, const Unit& u, int wr, int wc, int fr, int fq, const LAS float* rst) {
    bf16_t* base = E.O + (long)u.z * E.rowZ * 1024 + u.pn * 256;
    const long row0 = (long)u.pm * BM + wr * 64 + fr; const int col0 = wc * 32 + 8 * fq;
    LAS float* tab = E.tab; LAS float* tab2 = tab + 1024;
#pragma unroll
    for (int ai = 0; ai < 2; ++ai)
#pragma unroll
        for (int m = 0; m < 4; ++m) {
            const float rs = rst[ai * 128 + wr * 64 + m * 16 + fr];
            float v = -3.0e38f;
#pragma unroll
            for (int bj = 0; bj < 2; ++bj)
#pragma unroll
                for (int n = 0; n < 2; ++n)
#pragma unroll
                    for (int j = 0; j < 4; ++j) { acc[ai][bj][m][n][j] *= rs; v = fmaxf(v, acc[ai][bj][m][n][j]); }
            v = fmaxf(v, __shfl_xor(v, 16)); v = fmaxf(v, __shfl_xor(v, 32));
            if (fq == 0) tab[(ai * 128 + wr * 64 + m * 16 + fr) * 4 + wc] = v;
        }
    asm volatile("s_waitcnt lgkmcnt(0)" ::: "memory"); __builtin_amdgcn_s_barrier(); asm volatile("" ::: "memory");
#pragma unroll
    for (int ai = 0; ai < 2; ++ai)
#pragma unroll
        for (int m = 0; m < 4; ++m) {
            const int rl = ai * 128 + wr * 64 + m * 16 + fr;
            const f32x4 t4 = *(const LAS f32x4*)(tab + rl * 4);
            const float M = fmaxf(fmaxf(t4[0], t4[1]), fmaxf(t4[2], t4[3]));
            float sm = 0.f;
#pragma unroll
            for (int bj = 0; bj < 2; ++bj)
#pragma unroll
                for (int n = 0; n < 2; ++n)
#pragma unroll
                    for (int j = 0; j < 4; ++j) { const float e = __expf(acc[ai][bj][m][n][j] - M); acc[ai][bj][m][n][j] = e; sm += e; }
            sm += __shfl_xor(sm, 16); sm += __shfl_xor(sm, 32);
            if (fq == 0) tab2[rl * 4 + wc] = sm;
        }
    asm volatile("s_waitcnt lgkmcnt(0)" ::: "memory"); __builtin_amdgcn_s_barrier(); asm volatile("" ::: "memory");
#pragma unroll
    for (int ai = 0; ai < 2; ++ai)
#pragma unroll
        for (int m = 0; m < 4; ++m) {
            const int rl = ai * 128 + wr * 64 + m * 16 + fr;
            const f32x4 t4 = *(const LAS f32x4*)(tab2 + rl * 4);
            const float inv = 1.0f / (t4[0] + t4[1] + t4[2] + t4[3]);
#pragma unroll
            for (int bj = 0; bj < 2; ++bj) {
                const f32x4 a0 = acc[ai][bj][m][0] * inv, a1 = acc[ai][bj][m][1] * inv;
                u32x4 pk; pk[0] = pk2(a0[0], a0[1]); pk[1] = pk2(a0[2], a0[3]); pk[2] = pk2(a1[0], a1[1]); pk[3] = pk2(a1[2], a1[3]);
                *(u32x4*)(base + (row0 + ai * HALF + m * 16) * 1024 + col0 + bj * HALF) = pk;
            }
        }
}

template <int MODE>
__device__ __forceinline__ void gemm_phase(LAS unsigned char* lds, const GJob& g, const Epi& E, int G, int c) {
    const int tid = ltid();
    const int wid = __builtin_amdgcn_readfirstlane(tid >> 6), lane = tid & 63, wr = wid >> 2, wc = wid & 3, fr = lane & 15, fq = lane >> 4;
    const int K = g.K, nt = K / BK;
    unsigned voffA[2], voffB[2];
#pragma unroll
    for (int i = 0; i < 2; ++i) { int R, C; stage_rc(tid * 16 + i * 8192, R, C); const int Rb = (R & ~31) + perm32(R & 31);
        voffA[i] = (unsigned)(R * g.lda + C) * 2u; voffB[i] = (unsigned)(Rb * g.ldb + C) * 2u; }
    const size_t kstep = (size_t)(BK * 2);
    const size_t hstepA = (size_t)HALF * g.lda * 2, hstepB = (size_t)HALF * g.ldb * 2;
    const unsigned ldsw = (unsigned)wid * 1024u;
    const int aoff = lds_byte(wr * 64 + fr, fq * 8), boff = lds_byte(wc * 32 + fr, fq * 8);
#define PG8_SA(b, h) (((b) * 2 + (h)) * HTB)
#define PG8_SB(b, h) ((4 + (b) * 2 + (h)) * HTB)
#define PG8_STAGE(bufoff, gbase, voff) do { _Pragma("unroll") for (int _i = 0; _i < 2; ++_i) \
        __builtin_amdgcn_global_load_lds((const unsigned*)((const char*)(gbase) + (voff)[_i]), (LAS unsigned*)(lds + (bufoff) + ldsw + _i * 8192), 16, 0, 0); } while (0)
#define PG8_LDA(dst, b, h) do { _Pragma("unroll") for (int m = 0; m < 4; ++m) _Pragma("unroll") for (int k = 0; k < 2; ++k) dst[m][k] = *(const LAS bf16x8*)(lds + PG8_SA(b, h) + aoff + m * 2048 + k * 1024); } while (0)
#define PG8_LDB(dst, b, h) do { _Pragma("unroll") for (int n = 0; n < 2; ++n) _Pragma("unroll") for (int k = 0; k < 2; ++k) dst[n][k] = *(const LAS bf16x8*)(lds + PG8_SB(b, h) + boff + n * 2048 + k * 1024); } while (0)
#define PG8_MMA(ai, bj, At, Bt) do { __builtin_amdgcn_s_setprio(1); _Pragma("unroll") for (int m = 0; m < 4; ++m) _Pragma("unroll") for (int n = 0; n < 2; ++n) _Pragma("unroll") for (int k = 0; k < 2; ++k) \
        acc[ai][bj][m][n] = __builtin_amdgcn_mfma_f32_16x16x32_bf16(Bt[n][k], At[m][k], acc[ai][bj][m][n], 0, 0, 0); __builtin_amdgcn_s_setprio(0); } while (0)
#define PG8_WAIT_V(n) asm volatile("s_waitcnt vmcnt(" #n ")" ::: "memory")
#define PG8_WAIT_L(n) asm volatile("s_waitcnt lgkmcnt(" #n ")" ::: "memory")
#define PG8_BAR __builtin_amdgcn_s_barrier()
#define PG8_SCHED __builtin_amdgcn_sched_barrier(0)
    Unit cur, nxt; int ui = 0;
    LAS float* rstab = (LAS float*)(lds + 139264);
    if ((MODE == 0 || MODE == 2 || MODE == 3) && E.ss_in != nullptr) {
        for (int u0 = 0; u0 < 16; u0 += 2) {
            Unit uu; const int uidx = u0 + (tid >> 8);
            if (g_next(g, uidx, G, c, uu)) rstab[uidx * 256 + (tid & 255)] = row_rstd(E.ss_in, (long)(uu.z >> g.zshift) * g.rowZ + (long)uu.pm * BM + (tid & 255));
        }
        __syncthreads();
    }
    if (!g_next(g, 0, G, c, cur)) return;
    AccT acc;
#pragma unroll
    for (int a = 0; a < 2; ++a)
#pragma unroll
        for (int b = 0; b < 2; ++b)
#pragma unroll
            for (int m = 0; m < 4; ++m)
#pragma unroll
                for (int n = 0; n < 2; ++n) acc[a][b][m][n] = (f32x4){0.f, 0.f, 0.f, 0.f};
    bf16x8 At[4][2], B0[2][2], B1[2][2];
    const char* cA = g_aptr(g, cur); const char* cB = g_bptr(g, cur);
    PG8_STAGE(PG8_SB(0, 0), cB, voffB); PG8_STAGE(PG8_SA(0, 0), cA, voffA); PG8_STAGE(PG8_SB(0, 1), cB + hstepB, voffB); PG8_STAGE(PG8_SA(0, 1), cA + hstepA, voffA);
    if (wr == 1) PG8_BAR;
    PG8_WAIT_V(4); PG8_BAR;
    PG8_STAGE(PG8_SB(1, 0), cB + kstep, voffB); PG8_STAGE(PG8_SA(1, 0), cA + kstep, voffA); PG8_STAGE(PG8_SB(1, 1), cB + hstepB + kstep, voffB);
    PG8_WAIT_V(6); PG8_BAR;
    for (;;) {
        const bool has_next = g_next(g, ui + 1, G, c, nxt);
        const char* nA = has_next ? g_aptr(g, nxt) : cA; const char* nB = has_next ? g_bptr(g, nxt) : cB;
        for (int t = 0; t < nt; t += 2) {
            const bool last = (t == nt - 2);
            const char* a1 = cA + (size_t)(t + 1) * kstep;
            const char* a2 = last ? nA : cA + (size_t)(t + 2) * kstep; const char* b2 = last ? nB : cB + (size_t)(t + 2) * kstep;
            const char* a3 = a2 + kstep; const char* b3 = b2 + kstep;
            PG8_LDB(B0, 0, 0); PG8_SCHED; PG8_LDA(At, 0, 0); PG8_STAGE(PG8_SA(1, 1), a1 + hstepA, voffA);
            PG8_WAIT_L(8); PG8_BAR; PG8_WAIT_L(0); PG8_MMA(0, 0, At, B0); PG8_BAR; PG8_SCHED;
            PG8_LDB(B1, 0, 1); PG8_STAGE(PG8_SB(0, 0), b2, voffB);
            PG8_BAR; PG8_WAIT_L(0); PG8_MMA(0, 1, At, B1); PG8_BAR;
            PG8_LDA(At, 0, 1); PG8_STAGE(PG8_SA(0, 0), a2, voffA);
            PG8_BAR; PG8_WAIT_L(0); PG8_MMA(1, 0, At, B0); PG8_BAR; PG8_SCHED;
            PG8_STAGE(PG8_SB(0, 1), b2 + hstepB, voffB);
            PG8_WAIT_V(6); PG8_BAR; PG8_MMA(1, 1, At, B1); PG8_BAR;
            PG8_LDB(B0, 1, 0); PG8_SCHED; PG8_LDA(At, 1, 0); PG8_STAGE(PG8_SA(0, 1), a2 + hstepA, voffA);
            PG8_WAIT_L(8); PG8_BAR; PG8_WAIT_L(0); PG8_MMA(0, 0, At, B0); PG8_BAR; PG8_SCHED;
            PG8_LDB(B1, 1, 1); PG8_STAGE(PG8_SB(1, 0), b3, voffB);
            PG8_BAR; PG8_WAIT_L(0); PG8_MMA(0, 1, At, B1); PG8_BAR;
            PG8_LDA(At, 1, 1); PG8_STAGE(PG8_SA(1, 0), a3, voffA);
            PG8_BAR; PG8_WAIT_L(0); PG8_MMA(1, 0, At, B0); PG8_BAR; PG8_SCHED;
            PG8_STAGE(PG8_SB(1, 1), b3 + hstepB, voffB);
            PG8_WAIT_V(6); PG8_BAR; PG8_MMA(1, 1, At, B1); PG8_BAR;
        }
        if (MODE == 0) epi_swiglu(E, acc, cur, wr, wc, fr, fq, rstab + ui * 256); else if (MODE == 1) epi_resid(E, acc, cur, wr, wc, fr, fq);
        else if (MODE == 2) epi_bf16(E, acc, cur, wr, wc, fr, fq, rstab + ui * 256); else epi_softmax(E, acc, cur, wr, wc, fr, fq, rstab + ui * 256);
        if (!has_next) break;
#pragma unroll
        for (int a = 0; a < 2; ++a)
#pragma unroll
            for (int b = 0; b < 2; ++b)
#pragma unroll
                for (int m = 0; m < 4; ++m)
#pragma unroll
                    for (int n = 0; n < 2; ++n) acc[a][b][m][n] = (f32x4){0.f, 0.f, 0.f, 0.f};
        cur = nxt; cA = nA; cB = nB; ++ui;
    }
    PG8_WAIT_V(0);
    if (wr == 0) PG8_BAR;
    PG8_BAR;
#undef PG8_SA
#undef PG8_SB
#undef PG8_STAGE
#undef PG8_LDA
#undef PG8_LDB
#undef PG8_MMA
#undef PG8_WAIT_V
#undef PG8_WAIT_L
#undef PG8_BAR
#undef PG8_SCHED
}

__device__ __forceinline__ void phase_convert(int l, LAS unsigned char* lds, int t_lo, int t_hi) {
    LAS float* tl = (LAS float*)lds;
    const int tid = ltid();
    const long FW = 1024l * 2816;
    for (int tile = t_lo + blockIdx.x; tile < t_hi; tile += gridDim.x) {
        const float* src = nullptr; bf16_t* dst = nullptr; const float* gk = nullptr;
        int K = 64, N = 64, Gd = 64, rs = 0, roff = 0, local = 0;
        unsigned char* ws = WSP;
#define JOB(T0, NT, SRC, KK, NN, DST, GG, RS, RO, GK) if (tile >= (T0) && tile < (T0) + (NT)) { src = (SRC); K = (KK); N = (NN); dst = (bf16_t*)(DST); Gd = (GG); rs = (RS); roff = (RO); gk = (GK); local = tile - (T0); }
        JOB(0, 704, PIN(4) + l * FW, 1024, 2816, ws + WB_UP1, 128, 256, 0, PIN(3) + l * 1024)
        else JOB(704, 704, PIN(5) + l * FW, 1024, 2816, ws + WB_UP1, 128, 256, 128, PIN(3) + l * 1024)
        else JOB(1408, 704, PIN(6) + l * FW, 2816, 1024, ws + WB_DN1, 1024, 0, 0, nullptr)
        else JOB(2112, 960, PIN(8) + l * 1024l * 3840, 1024, 3840, ws + WB_IN, 3840, 0, 0, PIN(7) + l * 1024)
        else JOB(3072, 256, PIN(19) + l * 1024l * 1024, 1024, 1024, ws + WB_OUT, 1024, 0, 0, nullptr)
        else if (tile >= 3328 && tile < 3584) { continue; }
        else JOB(3584, 512, PIN(23) + l * 1024l * 2048, 1024, 2048, ws + WB_KV, 2048, 0, 0, nullptr)
        else JOB(4096, 256, PIN(24) + l * 1024l * 1024, 1024, 1024, ws + WB_O, 1024, 0, 0, nullptr)
        else JOB(4352, 704, PIN(26) + l * FW, 1024, 2816, ws + WB_UP2, 128, 256, 0, PIN(25) + l * 1024)
        else JOB(5056, 704, PIN(27) + l * FW, 1024, 2816, ws + WB_UP2, 128, 256, 128, PIN(25) + l * 1024)
        else JOB(5760, 704, PIN(28) + l * FW, 2816, 1024, ws + WB_DN2, 1024, 0, 0, nullptr)
        else if (tile < 6468) { const int nb = tile - 6464; src = PIN(14) + l * 16384 + nb * 4096; dst = (bf16_t*)(ws + WB_WA + nb * 8192); }
        else { const int nb = tile - 6468; src = PIN(16) + l * 16384 + nb * 4096; dst = (bf16_t*)(ws + WB_WX + nb * 8192); }
#undef JOB
        const int ntn = N / 64, k0 = (local / ntn) * 64, n0 = (local % ntn) * 64;
#pragma unroll
        for (int i = 0; i < 2; ++i) {
            const int idx = tid + i * 512, row = idx >> 4, c4 = idx & 15;
            f32x4 v = *(const f32x4*)(src + (long)(k0 + row) * N + n0 + c4 * 4);
            if (gk != nullptr) v = v * gk[k0 + row];
            tl[(c4 * 4 + 0) * 65 + row] = v[0]; tl[(c4 * 4 + 1) * 65 + row] = v[1]; tl[(c4 * 4 + 2) * 65 + row] = v[2]; tl[(c4 * 4 + 3) * 65 + row] = v[3];
        }
        __syncthreads();
        {
            const int n = tid >> 3, kk = (tid & 7) * 8, nn = n0 + n;
            const int drow = (nn / Gd) * rs + roff + (nn % Gd);
            u32x4 pk;
#pragma unroll
            for (int q = 0; q < 4; ++q) pk[q] = pk2(tl[n * 65 + kk + 2 * q], tl[n * 65 + kk + 2 * q + 1]);
            *(u32x4*)(dst + (long)drow * K + k0 + kk) = pk;
        }
        __syncthreads();
    }
}

__device__ __forceinline__ void phase_convert_straight(const float* src, const float* gk, bf16_t* dst) {
    const long gt = (long)blockIdx.x * NTHREADS + ltid();
    for (long v = gt; v < 131072; v += (long)gridDim.x * NTHREADS) {
        const int k = (int)(v >> 7);
        const f32x4 a = *(const f32x4*)(src + v * 8), b = *(const f32x4*)(src + v * 8 + 4);
        const float gg = gk[k];
        u32x4 pk; pk[0] = pk2(a[0] * gg, a[1] * gg); pk[1] = pk2(a[2] * gg, a[3] * gg); pk[2] = pk2(b[0] * gg, b[1] * gg); pk[3] = pk2(b[2] * gg, b[3] * gg);
        *(u32x4*)(dst + v * 8) = pk;
    }
}

__device__ __forceinline__ void phase_norm(const float* src, const float* g, bf16_t* dst, int nrows) {
    const int tid_ = ltid(); const int lane = tid_ & 63, gw = blockIdx.x * 8 + (tid_ >> 6), nw = gridDim.x * 8;
    for (int row = gw; row < nrows; row += nw) {
        const f32x4* pr = (const f32x4*)(src + (long)row * 1024);
        f32x4 v[4]; float ss = 0.f;
#pragma unroll
        for (int i = 0; i < 4; ++i) { v[i] = pr[lane + 64 * i]; ss += v[i][0] * v[i][0] + v[i][1] * v[i][1] + v[i][2] * v[i][2] + v[i][3] * v[i][3]; }
#pragma unroll
        for (int m = 32; m >= 1; m >>= 1) ss += __shfl_xor(ss, m);
        const float rstd = rsqrtf(ss * (1.0f / 1024.0f) + 1e-6f);
#pragma unroll
        for (int i = 0; i < 4; ++i) {
            const f32x4 gg = ((const f32x4*)g)[lane + 64 * i];
            u32x2 pk; pk[0] = pk2(v[i][0] * rstd * gg[0], v[i][1] * rstd * gg[1]); pk[1] = pk2(v[i][2] * rstd * gg[2], v[i][3] * rstd * gg[3]);
            *(u32x2*)(dst + (long)row * 1024 + (lane + 64 * i) * 4) = pk;
        }
    }
}
__device__ __forceinline__ void phase_prep(const float* src, bf16_t* dst, float* ss_out, int nrows) {
    const int tid_ = ltid(); const int lane = tid_ & 63, gw = blockIdx.x * 8 + (tid_ >> 6), nw = gridDim.x * 8;
    for (int row = gw; row < nrows; row += nw) {
        const f32x4* pr = (const f32x4*)(src + (long)row * 1024);
        f32x4 v[4]; float ss = 0.f;
#pragma unroll
        for (int i = 0; i < 4; ++i) { v[i] = pr[lane + 64 * i]; ss += v[i][0] * v[i][0] + v[i][1] * v[i][1] + v[i][2] * v[i][2] + v[i][3] * v[i][3]; }
#pragma unroll
        for (int m = 32; m >= 1; m >>= 1) ss += __shfl_xor(ss, m);
        if (lane < 16) ss_out[(long)row * 16 + lane] = (lane == 0) ? ss : 0.f;
#pragma unroll
        for (int i = 0; i < 4; ++i) { u32x2 pk; pk[0] = pk2(v[i][0], v[i][1]); pk[1] = pk2(v[i][2], v[i][3]); *(u32x2*)(dst + (long)row * 1024 + (lane + 64 * i) * 4) = pk; }
    }
}
__device__ __forceinline__ void phase_final_norm(const bf16_t* xb, float* out, const float* g, int nrows) {
    const int tid_ = ltid(); const int lane = tid_ & 63, gw = blockIdx.x * 8 + (tid_ >> 6), nw = gridDim.x * 8;
    for (int row = gw; row < nrows; row += nw) {
        float v[16]; float ss = 0.f;
#pragma unroll
        for (int i = 0; i < 2; ++i) {
            const u32x4 rv = *(const u32x4*)(xb + (long)row * 1024 + (lane + 64 * i) * 8);
#pragma unroll
            for (int q = 0; q < 4; ++q) { v[i * 8 + 2 * q] = lo16(rv[q]); v[i * 8 + 2 * q + 1] = hi16(rv[q]); }
        }
#pragma unroll
        for (int j = 0; j < 16; ++j) ss += v[j] * v[j];
#pragma unroll
        for (int m = 32; m >= 1; m >>= 1) ss += __shfl_xor(ss, m);
        const float rstd = rsqrtf(ss * (1.0f / 1024.0f) + 1e-6f);
#pragma unroll
        for (int i = 0; i < 2; ++i) {
            const f32x4 g0 = *(const f32x4*)(g + (lane + 64 * i) * 8), g1 = *(const f32x4*)(g + (lane + 64 * i) * 8 + 4);
            f32x4 o0, o1;
#pragma unroll
            for (int j = 0; j < 4; ++j) { o0[j] = v[i * 8 + j] * rstd * g0[j]; o1[j] = v[i * 8 + 4 + j] * rstd * g1[j]; }
            *(f32x4*)(out + (long)row * 1024 + (lane + 64 * i) * 8) = o0; *(f32x4*)(out + (long)row * 1024 + (lane + 64 * i) * 8 + 4) = o1;
        }
    }
}

__device__ __forceinline__ void lds_barrier() { asm volatile("s_waitcnt lgkmcnt(0)" ::: "memory"); __builtin_amdgcn_s_barrier(); asm volatile("" ::: "memory"); }
struct MixCtx {
    LAS unsigned char* lds;
    const bf16_t* proj;
    bf16_t* mix;
    bf16_t* sth; bf16_t* str; float* lasth;
    bf16_t* lrup; bf16_t* lruh; float* lrupe; float* lruhe; float* lruci;
    const bf16_t* waT; const bf16_t* wxT;
    const int* pos;
    const float* ret_gn_g; const float* hg_lb; const float* hg_norm_g;
    const float* conv_w; const float* conv_b; const float* ba; const float* bx; const float* lam;
    int l;
};

template <bool M3>
__device__ __forceinline__ void hg_unit(const MixCtx& c, int unit) {
    LAS unsigned char* lds = c.lds;
    const int tid = ltid(), wid = tid >> 6, lane = tid & 63;
    const int h = unit & 3; const long row0 = (long)(unit >> 2) * 64;
    LAS float* cum = (LAS float*)lds;
    LAS bf16_t* inpT = (LAS bf16_t*)(lds + (M3 ? 102400 : 51200));
    float kk[2][8], qq[2][8];
    u32x4 stv[3]; unsigned gwv[6];
    if (M3) {
#pragma unroll
        for (int i = 0; i < 3; ++i) { const int v = tid + 512 * i; stv[i] = *(const u32x4*)(c.sth + (long)unit * 12288 + (v >> 4) * 128 + (v & 15) * 8); }
        const bf16_t* gp = c.proj + (row0 + (tid >> 3)) * 3840 + 2944 + h * 96 + (tid & 7) * 12;
#pragma unroll
        for (int j = 0; j < 6; ++j) gwv[j] = *(const unsigned*)(gp + 2 * j);
    }
#pragma unroll
    for (int i = 0; i < 2; ++i) {
        const int e8 = tid + 512 * i, t = e8 >> 4, d0 = (e8 & 15) * 8;
        const bf16_t* pr = c.proj + (row0 + t) * 3840;
        const u32x4 vf = *(const u32x4*)(pr + 2048 + h * 128 + d0);
        float xf[8]; UNPACK8(vf, xf);
        float lbv[8];
        if (c.l == 0) {
#pragma unroll
            for (int j = 0; j < 8; ++j) lbv[j] = 0.f;
        } else {
            const f32x4 p0a = *(const f32x4*)(c.hg_lb + h * 128 + d0), p0b = *(const f32x4*)(c.hg_lb + h * 128 + d0 + 4);
            const f32x4 p1a = *(const f32x4*)(c.hg_lb + 512 + h * 128 + d0), p1b = *(const f32x4*)(c.hg_lb + 512 + h * 128 + d0 + 4);
#pragma unroll
            for (int j = 0; j < 4; ++j) { lbv[j] = 1.0f / (1.0f + __expf(p0a[j] - p1a[j])); lbv[4 + j] = 1.0f / (1.0f + __expf(p0b[j] - p1b[j])); }
        }
#pragma unroll
        for (int j = 0; j < 8; ++j) {
            const float s = 1.0f / (1.0f + __expf(-xf[j]));
            const float f = lbv[j] + (1.0f - lbv[j]) * s;
            kk[i][j] = 1.0f - f;
            cum[t * 128 + d0 + j] = __logf(f);
        }
        if (M3) {
            const u32x4 vq = *(const u32x4*)(pr + 1536 + h * 128 + d0);
            float xq[8]; UNPACK8(vq, xq);
#pragma unroll
            for (int j = 0; j < 8; ++j) qq[i][j] = silu(xq[j]);
        }
    }
    for (int v = tid; v < 768; v += 512) {
        const int t = v & 63, e0 = (v >> 6) * 8;
        const u32x4 vi = *(const u32x4*)(c.proj + (row0 + t) * 3840 + 2560 + h * 96 + e0);
#pragma unroll
        for (int j = 0; j < 4; ++j) { inpT[(e0 + 2 * j) * 72 + t] = (bf16_t)(vi[j] & 0xffffu); inpT[(e0 + 2 * j + 1) * 72 + t] = (bf16_t)(vi[j] >> 16); }
    }
    lds_barrier();
    {
        LAS float* ptot = (LAS float*)(lds + 152064);
        const int d = tid & 127, part = tid >> 7;
        float v[16]; float run = 0.f;
#pragma unroll
        for (int t = 0; t < 16; ++t) { v[t] = cum[(part * 16 + t) * 128 + d]; run += v[t]; }
        ptot[part * 128 + d] = run;
        lds_barrier();
        float base = 0.f;
#pragma unroll
        for (int pp = 0; pp < 3; ++pp) base += (pp < part) ? ptot[pp * 128 + d] : 0.f;
#pragma unroll
        for (int t = 0; t < 16; ++t) { base += v[t]; cum[(part * 16 + t) * 128 + d] = base; }
    }
    lds_barrier();
    if (!M3) {
        LAS bf16_t* KlT = (LAS bf16_t*)(lds + 32768);
        LAS float* Eb = (LAS float*)(lds + 65536);
        LAS bf16_t* kvs = (LAS bf16_t*)(lds + 99328);
#pragma unroll
        for (int i = 0; i < 2; ++i) {
            const int e8 = tid + 512 * i, t = e8 >> 4, d0 = (e8 & 15) * 8;
#pragma unroll
            for (int j = 0; j < 8; ++j) { const int d = d0 + j; Eb[t * 129 + d] = kk[i][j] * __expf(cum[63 * 128 + d] - cum[t * 128 + d]); }
        }
        if (tid < 128) c.lasth[(long)unit * 128 + tid] = cum[63 * 128 + tid];
        lds_barrier();
#pragma unroll
        for (int i = 0; i < 2; ++i) {
            const int v = tid + 512 * i, d = v & 127, t0 = (v >> 7) * 8;
            u32x4 pk;
#pragma unroll
            for (int q2 = 0; q2 < 4; ++q2) pk[q2] = pk2(Eb[(t0 + 2 * q2) * 129 + d], Eb[(t0 + 2 * q2 + 1) * 129 + d]);
            *(LAS u32x4*)(KlT + d * 72 + t0) = pk;
        }
        lds_barrier();
        const int r = lane & 15, q = lane >> 4;
        for (int i = 0; i < 6; ++i) {
            const int idx = wid + 8 * i, et = idx >> 3, dt = idx & 7;
            f32x4 acc = (f32x4){0.f, 0.f, 0.f, 0.f};
            acc = mma16(inpT + et * 16 * 72, 72, KlT + dt * 16 * 72, 72, 64, acc, lane);
#pragma unroll
            for (int j = 0; j < 4; ++j) kvs[(et * 16 + q * 4 + j) * 136 + dt * 16 + r] = f2bf(acc[j]);
        }
        lds_barrier();
#pragma unroll
        for (int i = 0; i < 3; ++i) {
            const int v = tid + 512 * i, e = v >> 4, d0 = (v & 15) * 8;
            *(u32x4*)(c.sth + (long)unit * 12288 + e * 128 + d0) = *(const LAS u32x4*)(kvs + e * 136 + d0);
        }
        lds_barrier();
    } else {
        LAS bf16_t* Qp = (LAS bf16_t*)(lds + 32768); LAS bf16_t* Qm = (LAS bf16_t*)(lds + 50176);
        LAS bf16_t* Kp = (LAS bf16_t*)(lds + 67584); LAS bf16_t* Km = (LAS bf16_t*)(lds + 84992);
        LAS bf16_t* stT = (LAS bf16_t*)(lds + 116224); LAS bf16_t* S = (LAS bf16_t*)(lds + 142336);
        LAS float* O = (LAS float*)lds;
#pragma unroll
        for (int i = 0; i < 2; ++i) {
            const int e8 = tid + 512 * i, t = e8 >> 4, d0 = (e8 & 15) * 8;
            float qp[8], qm[8], kp[8], km[8];
#pragma unroll
            for (int j = 0; j < 8; ++j) {
                const float cref = cum[31 * 128 + d0 + j], cc = cum[t * 128 + d0 + j];
                const float ep = __expf(cc - cref), em = __expf(cref - cc);
                qp[j] = qq[i][j] * ep; qm[j] = qq[i][j] * em; kp[j] = kk[i][j] * ep; km[j] = kk[i][j] * em;
            }
            u32x4 a, b, cc4, d;
#pragma unroll
            for (int j = 0; j < 4; ++j) { a[j] = pk2(qp[2 * j], qp[2 * j + 1]); b[j] = pk2(qm[2 * j], qm[2 * j + 1]); cc4[j] = pk2(kp[2 * j], kp[2 * j + 1]); d[j] = pk2(km[2 * j], km[2 * j + 1]); }
            *(LAS u32x4*)(Qp + t * 136 + d0) = a; *(LAS u32x4*)(Qm + t * 136 + d0) = b; *(LAS u32x4*)(Kp + t * 136 + d0) = cc4; *(LAS u32x4*)(Km + t * 136 + d0) = d;
        }
#pragma unroll
        for (int i = 0; i < 3; ++i) {
            const int v = tid + 512 * i, e = v >> 4, d0 = (v & 15) * 8;
            const u32x4 s = stv[i];
            float sf[8]; UNPACK8(s, sf);
            u32x4 o;
#pragma unroll
            for (int j = 0; j < 4; ++j) o[j] = pk2(sf[2 * j] * __expf(cum[31 * 128 + d0 + 2 * j]), sf[2 * j + 1] * __expf(cum[31 * 128 + d0 + 2 * j + 1]));
            *(LAS u32x4*)(stT + e * 136 + d0) = o;
        }
        lds_barrier();
        const int r = lane & 15, q = lane >> 4;
        for (int i = 0; i < 2; ++i) {
            const int idx = wid * 2 + i, ti = idx >> 2, tj = idx & 3;
            f32x4 s1 = (f32x4){0.f, 0.f, 0.f, 0.f}, s2 = (f32x4){0.f, 0.f, 0.f, 0.f};
            if (ti >= tj) s1 = mma16(Qp + ti * 16 * 136, 136, Km + tj * 16 * 136, 136, 128, s1, lane);
            if (ti <= tj) s2 = mma16(Qm + ti * 16 * 136, 136, Kp + tj * 16 * 136, 136, 128, s2, lane);
#pragma unroll
            for (int j = 0; j < 4; ++j) {
                const int t = ti * 16 + q * 4 + j, jj = tj * 16 + r;
                S[t * 72 + jj] = f2bf(t >= jj ? s1[j] : s2[j]);
            }
        }
        lds_barrier();
        for (int i = 0; i < 3; ++i) {
            const int idx = wid * 3 + i, tt = idx / 6, et = idx % 6;
            f32x4 acc = (f32x4){0.f, 0.f, 0.f, 0.f};
            acc = mma16(S + tt * 16 * 72, 72, inpT + et * 16 * 72, 72, 64, acc, lane);
            acc = mma16(Qp + tt * 16 * 136, 136, stT + et * 16 * 136, 136, 128, acc, lane);
#pragma unroll
            for (int j = 0; j < 4; ++j) O[(tt * 16 + q * 4 + j) * 100 + et * 16 + r] = acc[j];
        }
        lds_barrier();
        {
            const int t = tid >> 3, sub = tid & 7;
            float o[12], ss = 0.f;
#pragma unroll
            for (int j = 0; j < 12; ++j) { o[j] = O[t * 100 + sub * 12 + j]; ss += o[j] * o[j]; }
            ss += __shfl_xor(ss, 1); ss += __shfl_xor(ss, 2); ss += __shfl_xor(ss, 4);
            const float rstd = rsqrtf(ss * (1.0f / 96.0f) + 1e-6f);
            bf16_t* op = c.mix + (row0 + t) * 1024 + 384 + h * 96 + sub * 12;
            const float* gg = c.hg_norm_g + h * 96 + sub * 12;
#pragma unroll
            for (int j = 0; j < 6; ++j) {
                const unsigned gw = gwv[j];
                const float y0 = o[2 * j] * rstd * gg[2 * j] * silu(lo16(gw)), y1 = o[2 * j + 1] * rstd * gg[2 * j + 1] * silu(hi16(gw));
                *(unsigned*)(op + 2 * j) = pk2(y0, y1);
            }
        }
        lds_barrier();
    }
}

__device__ __forceinline__ void rope_tables(const MixCtx& c, long row0, LAS float* cs, LAS float* sn) {
    for (int p = ltid(); p < 3072; p += 512) {
        const int t = p / 48, i = p % 48;
        const float inv_freq = __expf(-9.210340371976184f * (float)i * (1.0f / 48.0f));
        const float ang = (float)c.pos[row0 + t] * inv_freq;
        const float k = rintf(ang * 0.15915494309189535f);
        float r = fmaf(-k, 6.28125f, ang); r = fmaf(-k, 1.9353071795864769e-3f, r);
        cs[p] = __cosf(r); sn[p] = __sinf(r);
    }
}
template <bool M3>
__device__ __forceinline__ void ret_unit(const MixCtx& c, int unit) {
    LAS unsigned char* lds = c.lds;
    const int tid = ltid(), wid = tid >> 6, lane = tid & 63;
    const int h = unit & 3; const long row0 = (long)(unit >> 2) * 64;
    const float lg = log1pf(-exp2f(-5.0f - (float)h));
    LAS float* cs = (LAS float*)lds; LAS float* sn = (LAS float*)(lds + 12288);
    u32x4 stv[3]; unsigned gwv[6];
    if (M3) {
#pragma unroll
        for (int i = 0; i < 3; ++i) { const int v = tid + 512 * i; if (v < 1152) stv[i] = *(const u32x4*)(c.str + (long)unit * 9216 + (v / 12) * 96 + (v % 12) * 8); }
        const bf16_t* gp = c.proj + (row0 + (tid >> 3)) * 3840 + 1152 + h * 96 + (tid & 7) * 12;
#pragma unroll
        for (int j = 0; j < 6; ++j) gwv[j] = *(const unsigned*)(gp + 2 * j);
    }
    rope_tables(c, row0, cs, sn);
    LAS bf16_t* vT = (LAS bf16_t*)(lds + 51200);
    for (int v = tid; v < 768; v += 512) {
        const int t = v & 63, e0 = (v >> 6) * 8;
        const u32x4 vi = *(const u32x4*)(c.proj + (row0 + t) * 3840 + 768 + h * 96 + e0);
#pragma unroll
        for (int j = 0; j < 4; ++j) { vT[(e0 + 2 * j) * 72 + t] = (bf16_t)(vi[j] & 0xffffu); vT[(e0 + 2 * j + 1) * 72 + t] = (bf16_t)(vi[j] >> 16); }
    }
    lds_barrier();
    const int r = lane & 15, q = lane >> 4;
    if (!M3) {
        LAS bf16_t* KdT = (LAS bf16_t*)(lds + 24576);
        if (tid < 384) {
            const int j = tid & 63, i0 = (tid >> 6) * 8;
            const bf16_t* kp = c.proj + (row0 + j) * 3840 + 384 + h * 96;
            const u32x4 v1 = *(const u32x4*)(kp + i0), v2 = *(const u32x4*)(kp + 48 + i0);
            float k1[8], k2[8]; UNPACK8(v1, k1); UNPACK8(v2, k2);
            const float dec = __expf(lg * (float)(63 - j));
#pragma unroll
            for (int e = 0; e < 8; ++e) {
                const float co = cs[j * 48 + i0 + e], si = sn[j * 48 + i0 + e];
                KdT[(i0 + e) * 72 + j] = f2bf((k1[e] * co - k2[e] * si) * dec);
                KdT[(48 + i0 + e) * 72 + j] = f2bf((k1[e] * si + k2[e] * co) * dec);
            }
        }
        lds_barrier();
        LAS bf16_t* kvs = (LAS bf16_t*)(lds + 65536);
        for (int i = 0; i < 5; ++i) {
            const int idx = wid + 8 * i;
            if (idx < 36) {
                const int et = idx / 6, dt = idx % 6;
                f32x4 acc = (f32x4){0.f, 0.f, 0.f, 0.f};
                acc = mma16(vT + et * 16 * 72, 72, KdT + dt * 16 * 72, 72, 64, acc, lane);
#pragma unroll
                for (int j = 0; j < 4; ++j) kvs[(et * 16 + q * 4 + j) * 104 + dt * 16 + r] = f2bf(acc[j]);
            }
        }
        lds_barrier();
#pragma unroll
        for (int i = 0; i < 3; ++i) { const int v = tid + 512 * i; if (v < 1152) *(u32x4*)(c.str + (long)unit * 9216 + (v / 12) * 96 + (v % 12) * 8) = *(const LAS u32x4*)(kvs + (v / 12) * 104 + (v % 12) * 8); }
        lds_barrier();
    } else {
        LAS bf16_t* Qr = (LAS bf16_t*)(lds + 24576); LAS bf16_t* Kr = (LAS bf16_t*)(lds + 37888);
        LAS bf16_t* stT = (LAS bf16_t*)(lds + 65024);
        LAS bf16_t* S = (LAS bf16_t*)(lds + 84992);
        LAS float* O = (LAS float*)(lds + 94208);
        if (tid < 384) {
            const int j = tid / 6, i0 = (tid % 6) * 8;
            const bf16_t* qp = c.proj + (row0 + j) * 3840 + h * 96;
            const bf16_t* kp = qp + 384;
            const u32x4 vq1 = *(const u32x4*)(qp + i0), vq2 = *(const u32x4*)(qp + 48 + i0), vk1 = *(const u32x4*)(kp + i0), vk2 = *(const u32x4*)(kp + 48 + i0);
            float q1[8], q2[8], k1[8], k2[8]; UNPACK8(vq1, q1); UNPACK8(vq2, q2); UNPACK8(vk1, k1); UNPACK8(vk2, k2);
            const float sc = 0.10206207261596575f;
            float qa[8], qb[8], ka[8], kb[8];
#pragma unroll
            for (int e = 0; e < 8; ++e) {
                const float co = cs[j * 48 + i0 + e], si = sn[j * 48 + i0 + e];
                qa[e] = (q1[e] * co - q2[e] * si) * sc; qb[e] = (q1[e] * si + q2[e] * co) * sc;
                ka[e] = k1[e] * co - k2[e] * si; kb[e] = k1[e] * si + k2[e] * co;
            }
            u32x4 o1, o2, o3, o4;
#pragma unroll
            for (int e = 0; e < 4; ++e) { o1[e] = pk2(qa[2 * e], qa[2 * e + 1]); o2[e] = pk2(qb[2 * e], qb[2 * e + 1]); o3[e] = pk2(ka[2 * e], ka[2 * e + 1]); o4[e] = pk2(kb[2 * e], kb[2 * e + 1]); }
            *(LAS u32x4*)(Qr + j * 104 + i0) = o1; *(LAS u32x4*)(Qr + j * 104 + 48 + i0) = o2;
            *(LAS u32x4*)(Kr + j * 104 + i0) = o3; *(LAS u32x4*)(Kr + j * 104 + 48 + i0) = o4;
        }
#pragma unroll
        for (int i = 0; i < 3; ++i) { const int v = tid + 512 * i; if (v < 1152) *(LAS u32x4*)(stT + (v / 12) * 104 + (v % 12) * 8) = stv[i]; }
        lds_barrier();
        for (int i = 0; i < 2; ++i) {
            const int idx = wid * 2 + i, ti = idx >> 2, tj = idx & 3;
            f32x4 s = (f32x4){0.f, 0.f, 0.f, 0.f};
            s = mma16(Qr + ti * 16 * 104, 104, Kr + tj * 16 * 104, 104, 96, s, lane);
#pragma unroll
            for (int j = 0; j < 4; ++j) {
                const int t = ti * 16 + q * 4 + j, jj = tj * 16 + r;
                const int dd = t > jj ? t - jj : jj - t;
                S[t * 72 + jj] = f2bf(s[j] * __expf(lg * (float)dd));
            }
        }
        lds_barrier();
        for (int i = 0; i < 3; ++i) {
            const int idx = wid * 3 + i, tt = idx / 6, et = idx % 6;
            f32x4 a1 = (f32x4){0.f, 0.f, 0.f, 0.f}, a2 = (f32x4){0.f, 0.f, 0.f, 0.f};
            a1 = mma16(S + tt * 16 * 72, 72, vT + et * 16 * 72, 72, 64, a1, lane);
            a2 = mma16(Qr + tt * 16 * 104, 104, stT + et * 16 * 104, 104, 96, a2, lane);
#pragma unroll
            for (int j = 0; j < 4; ++j) { const int t = tt * 16 + q * 4 + j; O[t * 100 + et * 16 + r] = a1[j] + __expf(lg * (float)(t + 1)) * a2[j]; }
        }
        lds_barrier();
        {
            const int t = tid >> 3, sub = tid & 7;
            float o[12], sm = 0.f;
#pragma unroll
            for (int j = 0; j < 12; ++j) { o[j] = O[t * 100 + sub * 12 + j]; sm += o[j]; }
            sm += __shfl_xor(sm, 1); sm += __shfl_xor(sm, 2); sm += __shfl_xor(sm, 4);
            const float mean = sm * (1.0f / 96.0f);
            float ss = 0.f;
#pragma unroll
            for (int j = 0; j < 12; ++j) { o[j] -= mean; ss += o[j] * o[j]; }
            ss += __shfl_xor(ss, 1); ss += __shfl_xor(ss, 2); ss += __shfl_xor(ss, 4);
            const float rstd = rsqrtf(ss * (1.0f / 96.0f) + 1e-6f);
            bf16_t* op = c.mix + (row0 + t) * 1024 + h * 96 + sub * 12;
            const float* gg = c.ret_gn_g + h * 96 + sub * 12;
#pragma unroll
            for (int j = 0; j < 6; ++j) {
                const unsigned gw = gwv[j];
                const float y0 = o[2 * j] * rstd * gg[2 * j] * silu(lo16(gw)), y1 = o[2 * j + 1] * rstd * gg[2 * j + 1] * silu(hi16(gw));
                *(unsigned*)(op + 2 * j) = pk2(y0, y1);
            }
        }
        lds_barrier();
    }
}

__device__ __forceinline__ void lru_m1(const MixCtx& c, int unit) {
    LAS unsigned char* lds = c.lds;
    const int tid = ltid(), wid = tid >> 6, lane = tid & 63;
    const int hh = unit & 1, bn = unit >> 1, n = bn & 127; const long row0 = (long)bn * 64; const int c0 = hh * 128;
    LAS float* xc = (LAS float*)lds; LAS float* Aa = (LAS float*)(lds + 32768); LAS bf16_t* xcb = (LAS bf16_t*)(lds + 65536);
    LAS bf16_t* lxs = (LAS bf16_t*)(lds + 83968);
    for (int v = tid; v < 67 * 16; v += 512) {
        const int rr = v >> 4, cc = (v & 15) * 8, tt = rr - 3;
        u32x4 val = (u32x4){0u, 0u, 0u, 0u};
        if (n * 64 + tt >= 0) val = *(const u32x4*)(c.proj + (row0 + tt) * 3840 + 3328 + c0 + cc);
        *(LAS u32x4*)(lxs + rr * 128 + cc) = val;
    }
    LAS bf16_t* wsm = (LAS bf16_t*)(lds + 101376);
#pragma unroll
    for (int i = 0; i < 4; ++i) {
        const int v = tid + 512 * i, mat = v >> 10, nbl = (v >> 9) & 1, d = (v >> 3) & 63, c8 = (v & 7) * 8;
        const u32x4 val = *(const u32x4*)((mat ? c.wxT : c.waT) + (hh * 2 + nbl) * 4096 + d * 64 + c8);
        *(LAS u32x4*)(wsm + ((mat * 2 + nbl) * 64 + d) * 72 + c8) = val;
    }
    const int cc = tid & 127, ch = c0 + cc;
    const float cw0 = c.conv_w[ch], cw1 = c.conv_w[256 + ch], cw2 = c.conv_w[512 + ch], cw3 = c.conv_w[768 + ch], cbv = c.conv_b[ch];
    lds_barrier();
#pragma unroll
    for (int i = 0; i < 16; ++i) {
        const int t = (tid >> 7) + 4 * i;
        const float acc = cbv + cw0 * bf2f(lxs[t * 128 + cc]) + cw1 * bf2f(lxs[(t + 1) * 128 + cc]) + cw2 * bf2f(lxs[(t + 2) * 128 + cc]) + cw3 * bf2f(lxs[(t + 3) * 128 + cc]);
        xc[t * 128 + cc] = acc; xcb[t * 136 + cc] = f2bf(acc);
    }
    lds_barrier();
    const int r = lane & 15, q = lane >> 4;
    for (int i = 0; i < 4; ++i) {
        const int idx = wid * 4 + i, nbl = idx >> 4, tt = (idx >> 2) & 3, dt = idx & 3;
        f32x4 ar = (f32x4){0.f, 0.f, 0.f, 0.f}, ai = (f32x4){0.f, 0.f, 0.f, 0.f};
#pragma unroll
        for (int k0 = 0; k0 < 64; k0 += 32) {
            const bf16x8 a = *(const LAS bf16x8*)(xcb + (tt * 16 + r) * 136 + nbl * 64 + k0 + q * 8);
            const bf16x8 b1 = *(const LAS bf16x8*)(wsm + ((0 + nbl) * 64 + dt * 16 + r) * 72 + k0 + q * 8);
            const bf16x8 b2 = *(const LAS bf16x8*)(wsm + ((2 + nbl) * 64 + dt * 16 + r) * 72 + k0 + q * 8);
            ar = __builtin_amdgcn_mfma_f32_16x16x32_bf16(a, b1, ar, 0, 0, 0);
            ai = __builtin_amdgcn_mfma_f32_16x16x32_bf16(a, b2, ai, 0, 0, 0);
        }
        const int c2 = nbl * 64 + dt * 16 + r, ch2 = c0 + c2;
        const float sp = log1pf(expf(-c.lam[ch2])), bav = c.ba[ch2], bxv = c.bx[ch2];
#pragma unroll
        for (int j = 0; j < 4; ++j) {
            const int t = tt * 16 + q * 4 + j;
            const float rr = 1.0f / (1.0f + __expf(-(ar[j] + bav))), ii = 1.0f / (1.0f + __expf(-(ai[j] + bxv)));
            const float la = -8.0f * sp * rr;
            const float a = __expf(la);
            const float u = sqrtf(fmaxf(1.0f - a * a, 0.f)) * ii * xc[t * 128 + c2];
            Aa[t * 128 + c2] = a; xc[t * 128 + c2] = u;
        }
    }
    lds_barrier();
    {
        LAS float* pt = (LAS float*)(lds + 138240);
        const int part = tid >> 7;
        float hs = 0.f, P = 1.f;
#pragma unroll
        for (int t = part * 16; t < part * 16 + 16; ++t) {
            const float a = Aa[t * 128 + cc], u = xc[t * 128 + cc];
            hs = a * hs + u; P *= a;
            xc[t * 128 + cc] = hs; Aa[t * 128 + cc] = P;
        }
        pt[part * 128 + cc] = P; pt[512 + part * 128 + cc] = hs;
        lds_barrier();
        float ch_ = 0.f, cP = 1.f;
#pragma unroll
        for (int pp = 0; pp < 3; ++pp) if (pp < part) { const float Pp = pt[pp * 128 + cc], hp = pt[512 + pp * 128 + cc]; ch_ = Pp * ch_ + hp; cP *= Pp; }
        if (part > 0) {
#pragma unroll
            for (int t = part * 16; t < part * 16 + 16; ++t) {
                const float Pl = Aa[t * 128 + cc];
                xc[t * 128 + cc] += Pl * ch_; Aa[t * 128 + cc] = Pl * cP;
            }
        }
        if (part == 3) { c.lruhe[(long)bn * 256 + ch] = xc[63 * 128 + cc]; c.lrupe[(long)bn * 256 + ch] = Aa[63 * 128 + cc]; }
    }
    lds_barrier();
#pragma unroll
    for (int i = 0; i < 2; ++i) {
        const int v = tid + 512 * i, t = v >> 4, c8 = (v & 15) * 8;
        const f32x4 h0 = *(const LAS f32x4*)(xc + t * 128 + c8), h1 = *(const LAS f32x4*)(xc + t * 128 + c8 + 4);
        const f32x4 p0 = *(const LAS f32x4*)(Aa + t * 128 + c8), p1 = *(const LAS f32x4*)(Aa + t * 128 + c8 + 4);
        u32x4 ph, pp; ph[0] = pk2(h0[0], h0[1]); ph[1] = pk2(h0[2], h0[3]); ph[2] = pk2(h1[0], h1[1]); ph[3] = pk2(h1[2], h1[3]);
        pp[0] = pk2(p0[0], p0[1]); pp[1] = pk2(p0[2], p0[3]); pp[2] = pk2(p1[0], p1[1]); pp[3] = pk2(p1[2], p1[3]);
        *(u32x4*)(c.lruh + (row0 + t) * 256 + c0 + c8) = ph; *(u32x4*)(c.lrup + (row0 + t) * 256 + c0 + c8) = pp;
    }
    lds_barrier();
}
__device__ __forceinline__ void lru_m3(const MixCtx& c, int bn) {
    const int tid = ltid(); const long row0 = (long)bn * 64;
#pragma unroll
    for (int i = 0; i < 4; ++i) {
        const int v = tid + 512 * i, t = v >> 5, cc = (v & 31) * 8;
        const u32x4 hv = *(const u32x4*)(c.lruh + (row0 + t) * 256 + cc);
        const u32x4 pv = *(const u32x4*)(c.lrup + (row0 + t) * 256 + cc);
        const u32x4 gv = *(const u32x4*)(c.proj + (row0 + t) * 3840 + 3584 + cc);
        const f32x4 ca = *(const f32x4*)(c.lruci + (long)bn * 256 + cc), cb = *(const f32x4*)(c.lruci + (long)bn * 256 + cc + 4);
        float hf[8], pf[8], gf[8]; UNPACK8(hv, hf); UNPACK8(pv, pf); UNPACK8(gv, gf);
        float o[8];
#pragma unroll
        for (int j = 0; j < 4; ++j) { o[j] = (hf[j] + pf[j] * ca[j]) * gelu_tanh(gf[j]); o[4 + j] = (hf[4 + j] + pf[4 + j] * cb[j]) * gelu_tanh(gf[4 + j]); }
        u32x4 pk; pk[0] = pk2(o[0], o[1]); pk[1] = pk2(o[2], o[3]); pk[2] = pk2(o[4], o[5]); pk[3] = pk2(o[6], o[7]);
        *(u32x4*)(c.mix + (row0 + t) * 1024 + 768 + cc) = pk;
    }
}

__device__ __forceinline__ void phase_scan(const MixCtx& c) {
    const long gt = (long)blockIdx.x * NTHREADS + ltid();
    if (gt < 49152) {
        const int bh = (int)(gt / 3072), g4 = (int)(gt % 3072), b = bh >> 2, h = bh & 3, d0 = (g4 * 4) & 127;
        float s0 = 0.f, s1 = 0.f, s2 = 0.f, s3 = 0.f;
        for (int n0 = 0; n0 < 128; n0 += 8) {
            u32x2 kv[8]; f32x4 la[8];
#pragma unroll
            for (int i = 0; i < 8; ++i) {
                const long unit = ((long)(b * 128 + n0 + i)) * 4 + h;
                kv[i] = *(const u32x2*)(c.sth + unit * 12288 + g4 * 4);
                la[i] = *(const f32x4*)(c.lasth + unit * 128 + d0);
            }
#pragma unroll
            for (int i = 0; i < 8; ++i) {
                const long unit = ((long)(b * 128 + n0 + i)) * 4 + h;
                u32x2 o; o[0] = pk2(s0, s1); o[1] = pk2(s2, s3); *(u32x2*)(c.sth + unit * 12288 + g4 * 4) = o;
                s0 = __expf(la[i][0]) * s0 + lo16(kv[i][0]); s1 = __expf(la[i][1]) * s1 + hi16(kv[i][0]);
                s2 = __expf(la[i][2]) * s2 + lo16(kv[i][1]); s3 = __expf(la[i][3]) * s3 + hi16(kv[i][1]);
            }
        }
    } else if (gt < 49152 + 36864) {
        const long g = gt - 49152; const int bh = (int)(g / 2304), g4 = (int)(g % 2304), b = bh >> 2, h = bh & 3;
        const float dec = expf(64.0f * log1pf(-exp2f(-5.0f - (float)h)));
        float s0 = 0.f, s1 = 0.f, s2 = 0.f, s3 = 0.f;
        for (int n0 = 0; n0 < 128; n0 += 8) {
            u32x2 kv[8];
#pragma unroll
            for (int i = 0; i < 8; ++i) { const long unit = ((long)(b * 128 + n0 + i)) * 4 + h; kv[i] = *(const u32x2*)(c.str + unit * 9216 + g4 * 4); }
#pragma unroll
            for (int i = 0; i < 8; ++i) {
                const long unit = ((long)(b * 128 + n0 + i)) * 4 + h;
                u32x2 o; o[0] = pk2(s0, s1); o[1] = pk2(s2, s3); *(u32x2*)(c.str + unit * 9216 + g4 * 4) = o;
                s0 = dec * s0 + lo16(kv[i][0]); s1 = dec * s1 + hi16(kv[i][0]); s2 = dec * s2 + lo16(kv[i][1]); s3 = dec * s3 + hi16(kv[i][1]);
            }
        }
    } else if (gt < 49152 + 36864 + 1024) {
        const int g = (int)(gt - 49152 - 36864), b = g >> 8, ch = g & 255;
        float carry = 0.f;
        for (int n0 = 0; n0 < 128; n0 += 8) {
            float pe[8], he[8];
#pragma unroll
            for (int i = 0; i < 8; ++i) { const long o = (long)(b * 128 + n0 + i) * 256 + ch; pe[i] = c.lrupe[o]; he[i] = c.lruhe[o]; }
#pragma unroll
            for (int i = 0; i < 8; ++i) { const long o = (long)(b * 128 + n0 + i) * 256 + ch; c.lruci[o] = carry; carry = pe[i] * carry + he[i]; }
        }
    }
}

#define XB_TMO      128
#define XB_XCNT(j)  (256  + 64 * (j))
#define XB_XSUB(j)  (1280 + 64 * (j))
#define XB_XGEN(j)  (2304 + 64 * (j))
#define XB_TOP      3328
#define XB_TOPGEN   3392
#define XCD_BAR_WORDS 3456
#define XB_SPIN_CAP (1u << 18)
__device__ __forceinline__ unsigned xb_ld(unsigned* p)              { return __hip_atomic_load(p, __ATOMIC_RELAXED, __HIP_MEMORY_SCOPE_AGENT); }
__device__ __forceinline__ unsigned xb_add(unsigned* p, unsigned v) { return __hip_atomic_fetch_add(p, v, __ATOMIC_RELAXED, __HIP_MEMORY_SCOPE_AGENT); }
__device__ __forceinline__ unsigned xb_xcc_id() { return (unsigned)__builtin_amdgcn_s_getreg((3 << 11) | 20) & 0xFu; }
#define XB_SPIN(cond, bar) do { unsigned _sp = 0; while (cond) { __builtin_amdgcn_s_sleep(1); \
    if ((++_sp & 255u) == 0u) { if (xb_ld(&(bar)[XB_TMO])) break; if (_sp > XB_SPIN_CAP) { atomicAdd(&(bar)[XB_TMO], 1u); break; } } } } while (0)
struct XcdBarrier { unsigned* bar; unsigned x; volatile LAS unsigned* st; };
__device__ __forceinline__ XcdBarrier xcd_barrier_post(unsigned* bar, volatile LAS unsigned* st) {
    XcdBarrier b; b.bar = bar; b.x = xb_xcc_id(); b.st = st;
    if (threadIdx.x == 0) (void)xb_add(&bar[XB_XCNT(b.x)], 1u);
    return b;
}
__device__ __forceinline__ void xcd_barrier_complete(unsigned* bar, unsigned x, unsigned& nloc, unsigned& nx) {
    const unsigned G = gridDim.x * gridDim.y * gridDim.z;
    unsigned sum, cnt, mine, sp = 0u;
    for (;;) {
        sum = 0u; cnt = 0u; mine = 0u;
#pragma unroll
        for (unsigned j = 0; j < 16; ++j) { const unsigned c = xb_ld(&bar[XB_XCNT(j)]); sum += c; cnt += (c > 0u) ? 1u : 0u; mine = (j == x) ? c : mine; }
        if (sum == G) break;
        __builtin_amdgcn_s_sleep(1);
        if ((++sp & 255u) == 0u) { if (xb_ld(&bar[XB_TMO])) break; if (sp > XB_SPIN_CAP) { atomicAdd(&bar[XB_TMO], 1u); break; } }
    }
    nloc = mine > 0u ? mine : 1u; nx = cnt > 0u ? cnt : 1u;
}
__device__ __forceinline__ void xcd_barrier(const XcdBarrier& b) {
    asm volatile("s_waitcnt vmcnt(0)" ::: "memory");
    __syncthreads();
    if (threadIdx.x == 0) {
        unsigned* bar = b.bar;
        __builtin_amdgcn_s_waitcnt(0);
        unsigned nloc = b.st[0], nx = b.st[1];
        if (nloc == 0u) { xcd_barrier_complete(bar, b.x, nloc, nx); b.st[0] = nloc; b.st[1] = nx; }
        const unsigned old = xb_add(&bar[XB_XSUB(b.x)], 1u);
        const unsigned gen = old / nloc;
        if (old + 1u == (gen + 1u) * nloc) {
            __builtin_amdgcn_fence(__ATOMIC_RELEASE, "agent");
            asm volatile("s_waitcnt vmcnt(0)" ::: "memory");
            const unsigned og = xb_add(&bar[XB_TOP], 1u);
            const unsigned tg = og / nx;
            if (og + 1u == (tg + 1u) * nx) xb_add(&bar[XB_TOPGEN], 1u);
            else XB_SPIN(xb_ld(&bar[XB_TOPGEN]) == tg, bar);
            __builtin_amdgcn_fence(__ATOMIC_ACQUIRE, "agent");
            xb_add(&bar[XB_XGEN(b.x)], 1u);
            asm volatile("s_waitcnt vmcnt(0)" ::: "memory");
        } else {
            XB_SPIN(xb_ld(&bar[XB_XGEN(b.x)]) == gen, bar);
            __builtin_amdgcn_fence(__ATOMIC_ACQUIRE, "agent");
            asm volatile("s_waitcnt vmcnt(0)" ::: "memory");
        }
    }
    __syncthreads();
}

__global__ void __launch_bounds__(NTHREADS) mega(Params p) {
    extern __shared__ __attribute__((aligned(16))) unsigned char shm[];
    LAS unsigned char* lds = (LAS unsigned char*)shm;
    cg::grid_group grid = cg::this_grid();
    const int G = gridDim.x, cb = blockIdx.x;
    volatile LAS unsigned* xst = (volatile LAS unsigned*)(lds + LDS_BYTES - 16);
    if (threadIdx.x < 2) xst[threadIdx.x] = 0u;
    __syncthreads();
    const XcdBarrier xb = xcd_barrier_post((unsigned*)(WSP + WS_BAR), xst);
#define ws WSP
#define BIG ((bf16_t*)(WSP + WS_BIG))
#define Hb ((bf16_t*)XOUT)
#define XB ((bf16_t*)(WSP + WS_H))
#define MEMN ((bf16_t*)(WSP + WS_MEMN))
#define KMEM ((bf16_t*)(WSP + WS_KMEM))
#define KV ((bf16_t*)(WSP + WS_KMEM))
#define MBT ((bf16_t*)(WSP + WS_MBT))
#define VWT ((bf16_t*)(WSP + WS_VWT))
#define VT ((bf16_t*)(WSP + WS_VT))
#define Qb (BIG + 32768l * 1024)
#define Pb (BIG + 2 * 32768l * 1024)
#define SSP(i) ((float*)(WSP + WS_SS) + (long)((i) & 1) * 32768 * 16)
#define X XOUT

    for (int ph = 0; ph < 38; ++ph) {
        const int l = ph / 19, k = ph % 19;

        GJob g{}; Epi E{}; bool is_gemm = true;
        g.lda = 1024; g.ldb = 1024; g.K = 1024; g.nM = 128; g.nN = 4; g.nZ = 1; E.scale = 1.0f; E.ldo = 1024;
        const float* ng = nullptr;
        switch (k) {
            case 1: g.A = XB; g.Bt = (const bf16_t*)(ws + WB_UP1); g.nN = 22; E.O = BIG; E.ss_in = SSP(l * 4 + 0); for (int rr = 0; rr < REP_GEMM; ++rr) { PH(2) gemm_phase<0>(lds, g, E, G, cb); } break;
            case 17: g.A = XB; g.Bt = (const bf16_t*)(ws + WB_UP2); g.nN = 22; E.O = BIG; E.ss_in = SSP(l * 4 + 3); for (int rr = 0; rr < REP_GEMM; ++rr) { PH(18) gemm_phase<0>(lds, g, E, G, cb); } break;
            case 2: case 3: continue;
            case 4: g.A = BIG; g.Bt = (const bf16_t*)(ws + WB_DN1); g.lda = 2816; g.ldb = 2816; g.K = 2816; E.resb = XB; E.scale = 0.5f; E.ss_out = SSP(l * 4 + 1); for (int rr = 0; rr < REP_GEMM; ++rr) { E.O = (rr == REP_GEMM - 1) ? XB : Hb; PH(4) gemm_phase<1>(lds, g, E, G, cb); } break;
            case 18: g.A = BIG; g.Bt = (const bf16_t*)(ws + WB_DN2); g.lda = 2816; g.ldb = 2816; g.K = 2816; E.resb = XB; E.scale = 0.5f; E.ss_out = SSP(l * 4 + 4); for (int rr = 0; rr < REP_GEMM; ++rr) { E.O = (rr == REP_GEMM - 1) ? XB : Hb; PH(19) gemm_phase<1>(lds, g, E, G, cb); } break;
            case 6: g.A = XB; g.Bt = (const bf16_t*)(ws + WB_IN); g.nN = 15; E.O = BIG; E.ldo = 3840; E.ss_in = SSP(l * 4 + 1); for (int rr = 0; rr < REP_GEMM; ++rr) { PH(5) gemm_phase<2>(lds, g, E, G, cb); } break;
            case 10: {
                GJob g2{}; Epi E2{}; g2.lda = 1024; g2.ldb = 1024; g2.K = 1024; g2.nZ = 1; E2.scale = 1.0f;
                g2.A = MEMN; g2.Bt = (const bf16_t*)(ws + WB_KV); g2.nM = 4; g2.nN = 8; E2.O = KV; E2.ldo = 2048; gemm_phase<2>(lds, g2, E2, G, (cb + 64) % G);
                }
                g.A = Hb; g.Bt = (const bf16_t*)(ws + WB_OUT); E.resb = XB; E.ss_out = SSP(l * 4 + 2); for (int rr = 0; rr < REP_GEMM; ++rr) { E.O = (rr == REP_GEMM - 1) ? XB : BIG; PH(13) gemm_phase<1>(lds, g, E, G, cb); } break;
            case 12: {
                GJob g2{}; Epi E2{}; g2.A = KV; g2.lda = 2048; g2.aZ1 = 256l * 2048; g2.aZ2 = 256; g2.Bt = (const bf16_t*)(ws + WB_Q); g2.ldb = 1024; g2.bZ2 = 256; g2.K = 256; g2.nM = 1; g2.nN = 4; g2.nZ = 16; g2.zshift = 2;
                E2.O = MBT; E2.ldo = 1024; E2.oZ1 = 1024l * 1024; E2.oZ2 = 256l * 1024; E2.zshift = 2; E2.scale = 0.0625f; gemm_phase<2>(lds, g2, E2, G, cb);
                GJob g3{}; Epi E3{}; g3.A = (const bf16_t*)(ws + WB_O); g3.lda = 1024; g3.aZ2 = 256; g3.Bt = KV + 1024; g3.ldb = 2048; g3.bZ1 = 256l * 2048; g3.bZ2 = 256; g3.K = 256; g3.nM = 4; g3.nN = 1; g3.nZ = 16; g3.zshift = 2;
                E3.O = VWT; E3.ldo = 1024; E3.oZ1 = 1024l * 1024; E3.oZ2 = 256; E3.zshift = 2; E3.scale = 1.0f; gemm_phase<2>(lds, g3, E3, G, (cb + 64) % G);
                } break;
            case 13: g.A = XB; g.aZ1 = 8192l * 1024; g.Bt = MBT; g.bZ1 = 1024l * 1024; g.nM = 32; g.nN = 4; g.nZ = 4; g.rowZ = 8192;
                     E.O = Pb; E.rowZ = 8192; E.ss_in = SSP(l * 4 + 2); E.tab = (LAS float*)(lds + 131072); for (int rr = 0; rr < REP_GEMM; ++rr) { PH(15) gemm_phase<3>(lds, g, E, G, cb); } break;
            case 14: continue;
            case 15: g.A = Pb; g.aZ1 = 8192l * 1024; g.Bt = VWT; g.bZ1 = 1024l * 1024; g.nM = 32; g.nN = 4; g.nZ = 4; E.rowZ = 8192;
                     E.resb = XB; E.ss_out = SSP(l * 4 + 3); for (int rr = 0; rr < REP_GEMM; ++rr) { E.O = (rr == REP_GEMM - 1) ? XB : BIG; PH(17) gemm_phase<1>(lds, g, E, G, cb); } break;
            case 0: is_gemm = false; ng = PIN(3); break;
            case 5: case 11: case 16: continue;
            default: is_gemm = false; break;
        }
        if (is_gemm) {
        } else if (ng != nullptr) {
            for (int rr = 0; rr < REP_EW; ++rr) {
            if (k == 0) { PH(0) phase_convert(l, lds, 0, 3072); PH(0) phase_convert(l, lds, 6464, 6472); }
            if (l == 0) { PH(1) phase_prep(PIN(0), XB, SSP(0), 32768); }
            PH(1) phase_norm(PIN(1), PIN(21) + l * 1024, MEMN, 1024);
            }
        } else {
        MixCtx mc;
            mc.lds = lds; mc.proj = BIG; mc.mix = Hb; mc.sth = (bf16_t*)(ws + WS_STH); mc.str = (bf16_t*)(ws + WS_STR); mc.lasth = (float*)(ws + WS_LASTH);
            mc.lrup = (bf16_t*)(ws + WS_LRUP); mc.lruh = (bf16_t*)(ws + WS_LRUH); mc.lrupe = (float*)(ws + WS_LRUPE); mc.lruhe = (float*)(ws + WS_LRUHE); mc.lruci = (float*)(ws + WS_LRUCI);
            mc.waT = (const bf16_t*)(ws + WB_WA); mc.wxT = (const bf16_t*)(ws + WB_WX);
            mc.pos = (const int*)PIN(2); mc.hg_lb = PIN(10);
            mc.ret_gn_g = PIN(9) + l * 384; mc.hg_norm_g = PIN(11) + l * 384;
            mc.conv_w = PIN(12) + l * 1024; mc.conv_b = PIN(13) + l * 256; mc.ba = PIN(15) + l * 256; mc.bx = PIN(17) + l * 256; mc.lam = PIN(18) + l * 256;
            mc.l = l;
            if (k == 7) {
                for (int rr = 0; rr < REP_MIX; ++rr) for (int idx = cb; idx < 5120; idx += G) {
                    const int kk5 = idx % 5, u = idx / 5;
                    if (kk5 < 2) { RMT(0) ret_unit<false>(mc, 2 * u + kk5); }
                    else if (kk5 < 4) { RMT(1) hg_unit<false>(mc, 2 * u + (kk5 - 2)); }
                    else { RMT(2) lru_m1(mc, u); }
                }
            } else if (k == 8) {
                PH(9) phase_scan(mc);
                PH(0) phase_convert(l, lds, 3072, 6464);
                PH(0) phase_convert_straight(PIN(22) + l * 1024l * 1024, PIN(20) + l * 1024, (bf16_t*)(ws + WB_Q));
            } else {
                for (int rr = 0; rr < REP_MIX; ++rr) for (int idx = cb; idx < 4608; idx += G) {
                    const int kk9 = idx % 9, u = idx / 9;
                    if (kk9 < 4) { RMT(3) ret_unit<true>(mc, 4 * u + kk9); }
                    else if (kk9 < 8) { RMT(4) hg_unit<true>(mc, 4 * u + (kk9 - 4)); }
                    else { RMT(5) lru_m3(mc, u); }
                }
            }
        }
        if (ph == 0) grid.sync(); else xcd_barrier(xb);
    }
    PH(20) phase_final_norm(XB, X, PIN(29), 32768);
}

#undef ws
#undef BIG
#undef Hb
#undef XB
#undef MEMN
#undef KMEM
#undef KV
#undef MBT
#undef VWT
#undef VT
#undef Qb
#undef SSP
#undef Pb
#undef X
extern "C" void kernel_launch(void* const* d_in, const int* in_sizes, int n_in, void* d_out, int out_size, void* d_ws, size_t ws_size, hipStream_t stream) {
    static int grid = 0;
    if (grid == 0) {
        int dev = 0, cus = 0, per_cu = 0;
        (void)hipGetDevice(&dev);
        (void)hipDeviceGetAttribute(&cus, hipDeviceAttributeMultiprocessorCount, dev);
        if (hipFuncSetAttribute((const void*)mega, hipFuncAttributeMaxDynamicSharedMemorySize, LDS_BYTES) != hipSuccess) fprintf(stderr, "kernel_launch: hipFuncSetAttribute failed\n");
        if (hipOccupancyMaxActiveBlocksPerMultiprocessor(&per_cu, (const void*)mega, NTHREADS, LDS_BYTES) != hipSuccess || per_cu < 1) { fprintf(stderr, "kernel_launch: occupancy query says %d\n", per_cu); per_cu = 1; }
        (void)hipGetLastError();
        grid = cus * 1;
        if (ws_size < WS_END) fprintf(stderr, "kernel_launch: workspace too small: %zu < %zu\n", ws_size, (size_t)WS_END);
    }
    Params p{};
    for (int i = 0; i < 30; ++i) p.in[i] = (const float*)d_in[i];
    p.outp_ = (float*)d_out; p.wsp_ = (unsigned char*)d_ws;
    if (hipMemsetAsync((char*)d_ws + WS_BAR, 0, 16384, stream) != hipSuccess) fprintf(stderr, "kernel_launch: memset of barrier words failed\n");
    void* args[] = {&p};
    hipError_t e = hipLaunchCooperativeKernel((const void*)mega, dim3(grid), dim3(NTHREADS), args, LDS_BYTES, stream);
    if (e != hipSuccess) fprintf(stderr, "cooperative launch failed: %s (grid %d)\n", hipGetErrorString(e), grid);
}
```

```cpp
#include <hip/hip_runtime.h>
#include <hip/hip_cooperative_groups.h>
#include <cstdio>
namespace cg = cooperative_groups;

#define LAS __attribute__((address_space(3)))
typedef unsigned short bf16_t;
typedef short bf16x8 __attribute__((ext_vector_type(8)));
typedef float f32x4 __attribute__((ext_vector_type(4)));
typedef unsigned u32x4 __attribute__((ext_vector_type(4)));
typedef unsigned u32x2 __attribute__((ext_vector_type(2)));

constexpr int LDS_BYTES = 155648;
constexpr int NTHREADS = 512;
constexpr long T_TOK = 32768;
#ifndef PHMASK
#define PHMASK 0xffffffffu
#endif
#define PH(n) if ((PHMASK >> (n)) & 1u)
#ifndef REPK
#define REPK 0u
#endif
#define REP_GEMM (((REPK >> k) & 1u) ? 2 : 1)
#ifndef REP_MIX
#define REP_MIX 1
#endif
#ifndef REP_MT
#define REP_MT 0u
#endif
#define RMT(b) for (int r2 = 0; r2 < (((REP_MT >> (b)) & 1u) ? 2 : 1); ++r2)
#ifndef REP_EW
#define REP_EW 1
#endif

constexpr size_t WB_UP1 = 0;
constexpr size_t WB_DN1 = WB_UP1 + 5632ull * 1024 * 2;
constexpr size_t WB_IN = WB_DN1 + 1024ull * 2816 * 2;
constexpr size_t WB_OUT = WB_IN + 3840ull * 1024 * 2;
constexpr size_t WB_Q = WB_OUT + 1024ull * 1024 * 2;
constexpr size_t WB_KV = WB_Q + 1024ull * 1024 * 2;
constexpr size_t WB_O = WB_KV + 2048ull * 1024 * 2;
constexpr size_t WB_UP2 = WB_O + 1024ull * 1024 * 2;
constexpr size_t WB_DN2 = WB_UP2 + 5632ull * 1024 * 2;
constexpr size_t WB_WA = WB_DN2 + 1024ull * 2816 * 2;
constexpr size_t WB_WX = WB_WA + 16384ull * 2;
constexpr size_t WS_BIG = WB_WX + 16384ull * 2;
constexpr size_t WS_H = WS_BIG + 32768ull * 3840 * 2;
constexpr size_t WS_STH = WS_H + 32768ull * 1024 * 2;
constexpr size_t WS_STR = WS_STH + 2048ull * 96 * 128 * 2;
constexpr size_t WS_LASTH = WS_STR + 2048ull * 96 * 96 * 2;
constexpr size_t WS_LRUP = WS_LASTH + 2048ull * 128 * 4;
constexpr size_t WS_LRUH = WS_LRUP + 32768ull * 256 * 2;
constexpr size_t WS_LRUPE = WS_LRUH + 32768ull * 256 * 2;
constexpr size_t WS_LRUHE = WS_LRUPE + 512ull * 256 * 4;
constexpr size_t WS_LRUCI = WS_LRUHE + 512ull * 256 * 4;
constexpr size_t WS_MEMN = WS_LRUCI + 512ull * 256 * 4;
constexpr size_t WS_KMEM = WS_MEMN + 1024ull * 1024 * 2;
constexpr size_t WS_VT = WS_KMEM + 1024ull * 1024 * 2;
constexpr size_t WS_BAR = WS_VT + 1024ull * 1024 * 2;
constexpr size_t WS_SS = WS_BAR + 16384;
constexpr size_t WS_MBT = WS_SS + 2ull * 32768 * 16 * 4;
constexpr size_t WS_VWT = WS_MBT + 4ull * 1024 * 1024 * 2;
constexpr size_t WS_END = WS_VWT + 4ull * 1024 * 1024 * 2;

struct Params {
    const float* in[30];
    float* outp_;
    unsigned char* wsp_;
};

typedef const __attribute__((address_space(4))) Params* KArgP;
__device__ __forceinline__ KArgP kargs() { auto q = __builtin_amdgcn_kernarg_segment_ptr(); asm volatile("" : "+s"(q)); return (KArgP)q; }
#define PIN(i) (kargs()->in[i])
#define WSP (kargs()->wsp_)
#define XOUT (kargs()->outp_)
__device__ __forceinline__ int ltid() { int t = threadIdx.x; asm volatile("" : "+v"(t)); return t; }
__device__ __forceinline__ float bf2f(bf16_t b) { return __uint_as_float(((unsigned)b) << 16); }
typedef float f32x2_t __attribute__((ext_vector_type(2)));
typedef __bf16 bf16x2_t __attribute__((ext_vector_type(2)));
__device__ __forceinline__ unsigned pk2(float lo, float hi) { const f32x2_t f = {lo, hi}; const bf16x2_t b = __builtin_convertvector(f, bf16x2_t); return __builtin_bit_cast(unsigned, b); }
__device__ __forceinline__ bf16_t f2bf(float f) { return (bf16_t)(pk2(f, f) & 0xffffu); }
__device__ __forceinline__ float lo16(unsigned w) { return __uint_as_float(w << 16); }
__device__ __forceinline__ float hi16(unsigned w) { return __uint_as_float(w & 0xffff0000u); }
__device__ __forceinline__ float sigm(float x) { return __builtin_amdgcn_rcpf(1.0f + __expf(-x)); }
__device__ __forceinline__ float silu(float x) { return x * sigm(x); }
__device__ __forceinline__ float gelu_tanh(float x) { return x * sigm(1.5957691216f * (x + 0.044715f * x * x * x)); }
#define UNPACK8(v, f) do { _Pragma("unroll") for (int _i = 0; _i < 4; ++_i) { f[2 * _i] = lo16(v[_i]); f[2 * _i + 1] = hi16(v[_i]); } } while (0)

__device__ __forceinline__ f32x4 mma16(const LAS bf16_t* A, int lda, const LAS bf16_t* B, int ldb, int K, f32x4 acc, int lane) {
    const int r = lane & 15, q = lane >> 4;
    const LAS bf16_t* ap = A + r * lda + q * 8;
    const LAS bf16_t* bp = B + r * ldb + q * 8;
    for (int k0 = 0; k0 < K; k0 += 32) {
        const bf16x8 a = *(const LAS bf16x8*)(ap + k0);
        const bf16x8 b = *(const LAS bf16x8*)(bp + k0);
        acc = __builtin_amdgcn_mfma_f32_16x16x32_bf16(a, b, acc, 0, 0, 0);
    }
    return acc;
}

constexpr int BM = 256, BK = 64, HALF = 128, HTB = HALF * BK * 2;
__device__ __forceinline__ int lds_byte(int r, int c) { const int st = (r >> 4) * 2 + (c >> 5), rr = r & 15, cc = c & 31, ob = rr * 64 + cc * 2; return st * 1024 + (ob ^ (((ob >> 9) & 1) << 5)); }
__device__ __forceinline__ void stage_rc(int b, int& R, int& C) { const int st = b / 1024, sb = b % 1024, swz = sb ^ (((sb >> 9) & 1) << 5); R = (st >> 1) * 16 + swz / 64; C = (st & 1) * 32 + (swz % 64) / 2; }
__device__ __forceinline__ int perm32(int rho) { const int n = rho >> 4, i = rho & 15; return 8 * (i >> 2) + 4 * n + (i & 3); }

struct Unit { int pm, pn, z; };
struct GJob {
    const bf16_t* A; const bf16_t* Bt; int lda, ldb, K, nM, nN, nZ, zshift; long aZ1, aZ2, bZ1, bZ2;
    long rowZ;
};
__device__ __forceinline__ bool g_next(const GJob& g, int i, int G, int c, Unit& u) {
    const int per = g.nM * g.nN, tot = per * g.nZ;
    const long L = (long)i * G + c; if (L >= tot) return false;
    int wgid = (int)L; { const int q = tot / 8, r = tot % 8, xcd = wgid % 8, off = wgid / 8; wgid = (xcd < r ? xcd * (q + 1) : r * (q + 1) + (xcd - r) * q) + off; }
    u.z = wgid / per; const int w = wgid % per;
    const int nig = 8 * g.nN, gid = w / nig, fm = gid * 8, gsz = (g.nM - fm) < 8 ? (g.nM - fm) : 8;
    u.pm = fm + ((w % nig) % gsz); u.pn = (w % nig) / gsz; return true;
}
__device__ __forceinline__ const char* g_aptr(const GJob& g, const Unit& u) {
    const long z1 = u.z >> g.zshift, z2 = u.z & ((1 << g.zshift) - 1);
    return (const char*)(g.A + z1 * g.aZ1 + z2 * g.aZ2 + (long)u.pm * BM * g.lda);
}
__device__ __forceinline__ const char* g_bptr(const GJob& g, const Unit& u) {
    const long z1 = u.z >> g.zshift, z2 = u.z & ((1 << g.zshift) - 1);
    return (const char*)(g.Bt + z1 * g.bZ1 + z2 * g.bZ2 + (long)u.pn * BM * g.ldb);
}

typedef f32x4 AccT[2][2][4][2];

struct Epi {
    int mode; int ldo; int zshift; float scale; bf16_t* O; long oZ1, oZ2; const bf16_t* resb; LAS float* tab;
    long rowZ;
    const float* ss_in;
    float* ss_out;
};
__device__ __forceinline__ float row_rstd(const float* ss, long row) {
    const f32x4* sp = (const f32x4*)(ss + row * 16);
    const f32x4 a = (sp[0] + sp[1]) + (sp[2] + sp[3]);
    return rsqrtf(((a[0] + a[1]) + (a[2] + a[3])) * (1.0f / 1024.0f) + 1e-6f);
}
__device__ __forceinline__ void epi_swiglu(const Epi& E, AccT& acc, const Unit& u, int wr, int wc, int fr, int fq, const LAS float* rst) {
    const long row0 = (long)u.pm * BM + wr * 64 + fr; const int col0 = u.pn * 128 + wc * 32 + 8 * fq;
#pragma unroll
    for (int ai = 0; ai < 2; ++ai)
#pragma unroll
        for (int m = 0; m < 4; ++m) {
            const float rs = rst[ai * 128 + wr * 64 + m * 16 + fr];
            float o[8];
#pragma unroll
            for (int n = 0; n < 2; ++n)
#pragma unroll
                for (int j = 0; j < 4; ++j) o[n * 4 + j] = silu(acc[ai][0][m][n][j] * rs) * (acc[ai][1][m][n][j] * rs);
            u32x4 pk; pk[0] = pk2(o[0], o[1]); pk[1] = pk2(o[2], o[3]); pk[2] = pk2(o[4], o[5]); pk[3] = pk2(o[6], o[7]);
            *(u32x4*)(E.O + (row0 + ai * HALF + m * 16) * 2816 + col0) = pk;
        }
}
#define RESID_LOAD(ai, rv) _Pragma("unroll") for (int m = 0; m < 4; ++m) _Pragma("unroll") for (int bj = 0; bj < 2; ++bj) rv[m][bj] = *(const u32x4*)(E.resb + (row0 + (ai) * HALF + m * 16) * 1024 + col0 + bj * HALF)
#define RESID_COMP(ai, rv, pk) _Pragma("unroll") for (int m = 0; m < 4; ++m) { float sl = 0.f; _Pragma("unroll") for (int bj = 0; bj < 2; ++bj) { \
        float rf[8]; UNPACK8(rv[m][bj], rf); float v[8]; \
        _Pragma("unroll") for (int j = 0; j < 4; ++j) { v[j] = rf[j] + acc[ai][bj][m][0][j] * E.scale; v[4 + j] = rf[4 + j] + acc[ai][bj][m][1][j] * E.scale; } \
        _Pragma("unroll") for (int j = 0; j < 8; ++j) sl += v[j] * v[j]; \
        pk[m][bj][0] = pk2(v[0], v[1]); pk[m][bj][1] = pk2(v[2], v[3]); pk[m][bj][2] = pk2(v[4], v[5]); pk[m][bj][3] = pk2(v[6], v[7]); } ssl[ai][m] = sl; }
#define RESID_STORE(ai, pk) _Pragma("unroll") for (int m = 0; m < 4; ++m) _Pragma("unroll") for (int bj = 0; bj < 2; ++bj) *(u32x4*)(E.O + (row0 + (ai) * HALF + m * 16) * 1024 + col0 + bj * HALF) = pk[m][bj]
__device__ __forceinline__ void epi_resid(const Epi& E, AccT& acc, const Unit& u, int wr, int wc, int fr, int fq) {
    const long row0 = (long)u.z * E.rowZ + (long)u.pm * BM + wr * 64 + fr; const int col0 = u.pn * BM + wc * 32 + 8 * fq;
    float ssl[2][4];
    u32x4 rvA[4][2], pkA[4][2];
    RESID_LOAD(0, rvA);
    asm volatile("" ::: "memory");
    RESID_COMP(0, rvA, pkA);
    u32x4 rvB[4][2];
    RESID_LOAD(1, rvB);
    asm volatile("" ::: "memory");
    RESID_STORE(0, pkA);
    asm volatile("" ::: "memory");
    u32x4 pkB[4][2];
    RESID_COMP(1, rvB, pkB);
    RESID_STORE(1, pkB);
#pragma unroll
    for (int ai = 0; ai < 2; ++ai)
#pragma unroll
        for (int m = 0; m < 4; ++m) {
            float sl = ssl[ai][m];
            sl += __shfl_xor(sl, 16); sl += __shfl_xor(sl, 32);
            if (fq == 0) E.ss_out[(row0 + ai * HALF + m * 16) * 16 + u.pn * 4 + wc] = sl;
        }
}
#undef RESID_LOAD
#undef RESID_COMP
#undef RESID_STORE
__device__ __forceinline__ void epi_bf16(const Epi& E, AccT& acc, const Unit& u, int wr, int wc, int fr, int fq, const LAS float* rst) {
    const long z1 = u.z >> E.zshift, z2 = u.z & ((1 << E.zshift) - 1);
    bf16_t* base = E.O + z1 * E.oZ1 + z2 * E.oZ2;
    const long row0 = (long)u.pm * BM + wr * 64 + fr; const int col0 = u.pn * BM + wc * 32 + 8 * fq;
    const long ldo = E.ldo;
#pragma unroll
    for (int ai = 0; ai < 2; ++ai)
#pragma unroll
        for (int m = 0; m < 4; ++m) {
            float scale = E.scale;
            if (E.ss_in != nullptr) scale *= rst[ai * 128 + wr * 64 + m * 16 + fr];
#pragma unroll
            for (int bj = 0; bj < 2; ++bj) {
                const f32x4 a0 = acc[ai][bj][m][0] * scale, a1 = acc[ai][bj][m][1] * scale;
                u32x4 pk; pk[0] = pk2(a0[0], a0[1]); pk[1] = pk2(a0[2], a0[3]); pk[2] = pk2(a1[0], a1[1]); pk[3] = pk2(a1[2], a1[3]);
                *(u32x4*)(base + (row0 + ai * HALF + m * 16) * ldo + col0 + bj * HALF) = pk;
            }
        }
}
__device__ __forceinline__ void epi_softmax(const Epi& E, AccT& acc, const Unit& u, int wr, int wc, int fr, int fq, const LAS float* rst) {
    bf16_t* base = E.O + (long)u.z * E.rowZ * 1024 + u.pn * 256;
    const long row0 = (long)u.pm * BM + wr * 64 + fr; const int col0 = wc * 32 + 8 * fq;
    LAS float* tab = E.tab; LAS float* tab2 = tab + 1024;
#pragma unroll
    for (int ai = 0; ai < 2; ++ai)
#pragma unroll
        for (int m = 0; m < 4; ++m) {
            const float rs = rst[ai * 128 + wr * 64 + m * 16 + fr];
            float v = -3.0e38f;
#pragma unroll
            for (int bj = 0; bj < 2; ++bj)
#pragma unroll
                for (int n = 0; n < 2; ++n)
#pragma unroll
                    for (int j = 0; j < 4; ++j) { acc[ai][bj][m][n][j] *= rs; v = fmaxf(v, acc[ai][bj][m][n][j]); }
            v = fmaxf(v, __shfl_xor(v, 16)); v = fmaxf(v, __shfl_xor(v, 32));
            if (fq == 0) tab[(ai * 128 + wr * 64 + m * 16 + fr) * 4 + wc] = v;
        }
    asm volatile("s_waitcnt lgkmcnt(0)" ::: "memory"); __builtin_amdgcn_s_barrier(); asm volatile("" ::: "memory");
#pragma unroll
    for (int ai = 0; ai < 2; ++ai)
#pragma unroll
        for (int m = 0; m < 4; ++m) {
            const int rl = ai * 128 + wr * 64 + m * 16 + fr;
            const f32x4 t4 = *(const LAS f32x4*)(tab + rl * 4);
            const float M = fmaxf(fmaxf(t4[0], t4[1]), fmaxf(t4[2], t4[3]));
            float sm = 0.f;
#pragma unroll
            for (int bj = 0; bj < 2; ++bj)
#pragma unroll
                for (int n = 0; n < 2; ++n)
#pragma unroll
                    for (int j = 0; j < 4; ++j) { const float e = __expf(acc[ai][bj][m][n][j] - M); acc[ai][bj][m][n][j] = e; sm += e; }
            sm += __shfl_xor(sm, 16); sm += __shfl_xor(sm, 32);
            if (fq == 0) tab2[rl * 4 + wc] = sm;
        }
    asm volatile("s_waitcnt lgkmcnt(0)" ::: "memory"); __builtin_amdgcn_s_barrier(); asm volatile("" ::: "memory");
#pragma unroll
    for (int ai = 0; ai < 2; ++ai)
#pragma unroll
        for (int m = 0; m < 4; ++m) {
            const int rl = ai * 128 + wr * 64 + m * 16 + fr;
            const f32x4 t4 = *(const LAS f32x4*)(tab2 + rl * 4);
            const float inv = 1.0f / (t4[0] + t4[1] + t4[2] + t4[3]);
#pragma unroll
            for (int bj = 0; bj < 2; ++bj) {
                const f32x4 a0 = acc[ai][bj][m][0] * inv, a1 = acc[ai][bj][m][1] * inv;
                u32x4 pk; pk[0] = pk2(a0[0], a0[1]); pk[1] = pk2(a0[2], a0[3]); pk[2] = pk2(a1[0], a1[1]); pk[3] = pk2(a1[2], a1[3]);
                *(u32x4*)(base + (row0 + ai * HALF + m * 16) * 1024 + col0 + bj * HALF) = pk;
            }
        }
}

template <int MODE>
__device__ __forceinline__ void gemm_phase(LAS unsigned char* lds, const GJob& g, const Epi& E, int G, int c) {
    const int tid = ltid();
    const int wid = __builtin_amdgcn_readfirstlane(tid >> 6), lane = tid & 63, wr = wid >> 2, wc = wid & 3, fr = lane & 15, fq = lane >> 4;
    const int K = g.K, nt = K / BK;
    unsigned voffA[2], voffB[2];
#pragma unroll
    for (int i = 0; i < 2; ++i) { int R, C; stage_rc(tid * 16 + i * 8192, R, C); const int Rb = (R & ~31) + perm32(R & 31);
        voffA[i] = (unsigned)(R * g.lda + C) * 2u; voffB[i] = (unsigned)(Rb * g.ldb + C) * 2u; }
    const size_t kstep = (size_t)(BK * 2);
    const size_t hstepA = (size_t)HALF * g.lda * 2, hstepB = (size_t)HALF * g.ldb * 2;
    const unsigned ldsw = (unsigned)wid * 1024u;
    const int aoff = lds_byte(wr * 64 + fr, fq * 8), boff = lds_byte(wc * 32 + fr, fq * 8);
#define PG8_SA(b, h) (((b) * 2 + (h)) * HTB)
#define PG8_SB(b, h) ((4 + (b) * 2 + (h)) * HTB)
#define PG8_STAGE(bufoff, gbase, voff) do { _Pragma("unroll") for (int _i = 0; _i < 2; ++_i) \
        __builtin_amdgcn_global_load_lds((const unsigned*)((const char*)(gbase) + (voff)[_i]), (LAS unsigned*)(lds + (bufoff) + ldsw + _i * 8192), 16, 0, 0); } while (0)
#define PG8_LDA(dst, b, h) do { _Pragma("unroll") for (int m = 0; m < 4; ++m) _Pragma("unroll") for (int k = 0; k < 2; ++k) dst[m][k] = *(const LAS bf16x8*)(lds + PG8_SA(b, h) + aoff + m * 2048 + k * 1024); } while (0)
#define PG8_LDB(dst, b, h) do { _Pragma("unroll") for (int n = 0; n < 2; ++n) _Pragma("unroll") for (int k = 0; k < 2; ++k) dst[n][k] = *(const LAS bf16x8*)(lds + PG8_SB(b, h) + boff + n * 2048 + k * 1024); } while (0)
#define PG8_MMA(ai, bj, At, Bt) do { __builtin_amdgcn_s_setprio(1); _Pragma("unroll") for (int m = 0; m < 4; ++m) _Pragma("unroll") for (int n = 0; n < 2; ++n) _Pragma("unroll") for (int k = 0; k < 2; ++k) \
        acc[ai][bj][m][n] = __builtin_amdgcn_mfma_f32_16x16x32_bf16(Bt[n][k], At[m][k], acc[ai][bj][m][n], 0, 0, 0); __builtin_amdgcn_s_setprio(0); } while (0)
#define PG8_WAIT_V(n) asm volatile("s_waitcnt vmcnt(" #n ")" ::: "memory")
#define PG8_WAIT_L(n) asm volatile("s_waitcnt lgkmcnt(" #n ")" ::: "memory")
#define PG8_BAR __builtin_amdgcn_s_barrier()
#define PG8_SCHED __builtin_amdgcn_sched_barrier(0)
    Unit cur, nxt; int ui = 0;
    LAS float* rstab = (LAS float*)(lds + 139264);
    if ((MODE == 0 || MODE == 2 || MODE == 3) && E.ss_in != nullptr) {
        for (int u0 = 0; u0 < 16; u0 += 2) {
            Unit uu; const int uidx = u0 + (tid >> 8);
            if (g_next(g, uidx, G, c, uu)) rstab[uidx * 256 + (tid & 255)] = row_rstd(E.ss_in, (long)(uu.z >> g.zshift) * g.rowZ + (long)uu.pm * BM + (tid & 255));
        }
        __syncthreads();
    }
    if (!g_next(g, 0, G, c, cur)) return;
    AccT acc;
#pragma unroll
    for (int a = 0; a < 2; ++a)
#pragma unroll
        for (int b = 0; b < 2; ++b)
#pragma unroll
            for (int m = 0; m < 4; ++m)
#pragma unroll
                for (int n = 0; n < 2; ++n) acc[a][b][m][n] = (f32x4){0.f, 0.f, 0.f, 0.f};
    bf16x8 At[4][2], B0[2][2], B1[2][2];
    const char* cA = g_aptr(g, cur); const char* cB = g_bptr(g, cur);
    PG8_STAGE(PG8_SB(0, 0), cB, voffB); PG8_STAGE(PG8_SA(0, 0), cA, voffA); PG8_STAGE(PG8_SB(0, 1), cB + hstepB, voffB); PG8_STAGE(PG8_SA(0, 1), cA + hstepA, voffA);
    if (wr == 1) PG8_BAR;
    PG8_WAIT_V(4); PG8_BAR;
    PG8_STAGE(PG8_SB(1, 0), cB + kstep, voffB); PG8_STAGE(PG8_SA(1, 0), cA + kstep, voffA); PG8_STAGE(PG8_SB(1, 1), cB + hstepB + kstep, voffB);
    PG8_WAIT_V(6); PG8_BAR;
    for (;;) {
        const bool has_next = g_next(g, ui + 1, G, c, nxt);
        const char* nA = has_next ? g_aptr(g, nxt) : cA; const char* nB = has_next ? g_bptr(g, nxt) : cB;
        for (int t = 0; t < nt; t += 2) {
            const bool last = (t == nt - 2);
            const char* a1 = cA + (size_t)(t + 1) * kstep;
            const char* a2 = last ? nA : cA + (size_t)(t + 2) * kstep; const char* b2 = last ? nB : cB + (size_t)(t + 2) * kstep;
            const char* a3 = a2 + kstep; const char* b3 = b2 + kstep;
            PG8_LDB(B0, 0, 0); PG8_SCHED; PG8_LDA(At, 0, 0); PG8_STAGE(PG8_SA(1, 1), a1 + hstepA, voffA);
            PG8_WAIT_L(8); PG8_BAR; PG8_WAIT_L(0); PG8_MMA(0, 0, At, B0); PG8_BAR; PG8_SCHED;
            PG8_LDB(B1, 0, 1); PG8_STAGE(PG8_SB(0, 0), b2, voffB);
            PG8_BAR; PG8_WAIT_L(0); PG8_MMA(0, 1, At, B1); PG8_BAR;
            PG8_LDA(At, 0, 1); PG8_STAGE(PG8_SA(0, 0), a2, voffA);
            PG8_BAR; PG8_WAIT_L(0); PG8_MMA(1, 0, At, B0); PG8_BAR; PG8_SCHED;
            PG8_STAGE(PG8_SB(0, 1), b2 + hstepB, voffB);
            PG8_WAIT_V(6); PG8_BAR; PG8_MMA(1, 1, At, B1); PG8_BAR;
            PG8_LDB(B0, 1, 0); PG8_SCHED; PG8_LDA(At, 1, 0); PG8_STAGE(PG8_SA(0, 1), a2 + hstepA, voffA);
            PG8_WAIT_L(8); PG8_BAR; PG8_WAIT_L(0); PG8_MMA(0, 0, At, B0); PG8_BAR; PG8_SCHED;
            PG8_LDB(B1, 1, 1); PG8_STAGE(PG8_SB(1, 0), b3, voffB);
            PG8_BAR; PG8_WAIT_L(0); PG8_MMA(0, 1, At, B1); PG8_BAR;
            PG8_LDA(At, 1, 1); PG8_STAGE(PG8_SA(1, 0), a3, voffA);
            PG8_BAR; PG8_WAIT_L(0); PG8_MMA(1, 0, At, B0); PG8_BAR; PG8_SCHED;
            PG8_STAGE(PG8_SB(1, 1), b3 + hstepB, voffB);
            PG8_WAIT_V(6); PG8_BAR; PG8_MMA(1, 1, At, B1); PG8_BAR;
        }
        if (MODE == 0) epi_swiglu(E, acc, cur, wr, wc, fr, fq, rstab + ui * 256); else if (MODE == 1) epi_resid(E, acc, cur, wr, wc, fr, fq);
        else if (MODE == 2) epi_bf16(E, acc, cur, wr, wc, fr, fq, rstab + ui * 256); else epi_softmax(E, acc, cur, wr, wc, fr, fq, rstab + ui * 256);
        if (!has_next) break;
#pragma unroll
        for (int a = 0; a < 2; ++a)
#pragma unroll
            for (int b = 0; b < 2; ++b)
#pragma unroll
                for (int m = 0; m < 4; ++m)
#pragma unroll
                    for (int n = 0; n < 2; ++n) acc[a][b][m][n] = (f32x4){0.f, 0.f, 0.f, 0.f};
        cur = nxt; cA = nA; cB = nB; ++ui;
    }
    PG8_WAIT_V(0);
    if (wr == 0) PG8_BAR;
    PG8_BAR;
#undef PG8_SA
#undef PG8_SB
#undef PG8_STAGE
#undef PG8_LDA
#undef PG8_LDB
#undef PG8_MMA
#undef PG8_WAIT_V
#undef PG8_WAIT_L
#undef PG8_BAR
#undef PG8_SCHED
}

__device__ __forceinline__ void phase_convert(int l, LAS unsigned char* lds, int t_lo, int t_hi) {
    LAS float* tl = (LAS float*)lds;
    const int tid = ltid();
    const long FW = 1024l * 2816;
    for (int tile = t_lo + blockIdx.x; tile < t_hi; tile += gridDim.x) {
        const float* src = nullptr; bf16_t* dst = nullptr; const float* gk = nullptr;
        int K = 64, N = 64, Gd = 64, rs = 0, roff = 0, local = 0;
        unsigned char* ws = WSP;
#define JOB(T0, NT, SRC, KK, NN, DST, GG, RS, RO, GK) if (tile >= (T0) && tile < (T0) + (NT)) { src = (SRC); K = (KK); N = (NN); dst = (bf16_t*)(DST); Gd = (GG); rs = (RS); roff = (RO); gk = (GK); local = tile - (T0); }
        JOB(0, 704, PIN(4) + l * FW, 1024, 2816, ws + WB_UP1, 128, 256, 0, PIN(3) + l * 1024)
        else JOB(704, 704, PIN(5) + l * FW, 1024, 2816, ws + WB_UP1, 128, 256, 128, PIN(3) + l * 1024)
        else JOB(1408, 704, PIN(6) + l * FW, 2816, 1024, ws + WB_DN1, 1024, 0, 0, nullptr)
        else JOB(2112, 960, PIN(8) + l * 1024l * 3840, 1024, 3840, ws + WB_IN, 3840, 0, 0, PIN(7) + l * 1024)
        else JOB(3072, 256, PIN(19) + l * 1024l * 1024, 1024, 1024, ws + WB_OUT, 1024, 0, 0, nullptr)
        else if (tile >= 3328 && tile < 3584) { continue; }
        else JOB(3584, 512, PIN(23) + l * 1024l * 2048, 1024, 2048, ws + WB_KV, 2048, 0, 0, nullptr)
        else JOB(4096, 256, PIN(24) + l * 1024l * 1024, 1024, 1024, ws + WB_O, 1024, 0, 0, nullptr)
        else JOB(4352, 704, PIN(26) + l * FW, 1024, 2816, ws + WB_UP2, 128, 256, 0, PIN(25) + l * 1024)
        else JOB(5056, 704, PIN(27) + l * FW, 1024, 2816, ws + WB_UP2, 128, 256, 128, PIN(25) + l * 1024)
        else JOB(5760, 704, PIN(28) + l * FW, 2816, 1024, ws + WB_DN2, 1024, 0, 0, nullptr)
        else if (tile < 6468) { const int nb = tile - 6464; src = PIN(14) + l * 16384 + nb * 4096; dst = (bf16_t*)(ws + WB_WA + nb * 8192); }
        else { const int nb = tile - 6468; src = PIN(16) + l * 16384 + nb * 4096; dst = (bf16_t*)(ws + WB_WX + nb * 8192); }
#undef JOB
        const int ntn = N / 64, k0 = (local / ntn) * 64, n0 = (local % ntn) * 64;
#pragma unroll
        for (int i = 0; i < 2; ++i) {
            const int idx = tid + i * 512, row = idx >> 4, c4 = idx & 15;
            f32x4 v = *(const f32x4*)(src + (long)(k0 + row) * N + n0 + c4 * 4);
            if (gk != nullptr) v = v * gk[k0 + row];
            tl[(c4 * 4 + 0) * 65 + row] = v[0]; tl[(c4 * 4 + 1) * 65 + row] = v[1]; tl[(c4 * 4 + 2) * 65 + row] = v[2]; tl[(c4 * 4 + 3) * 65 + row] = v[3];
        }
        __syncthreads();
        {
            const int n = tid >> 3, kk = (tid & 7) * 8, nn = n0 + n;
            const int drow = (nn / Gd) * rs + roff + (nn % Gd);
            u32x4 pk;
#pragma unroll
            for (int q = 0; q < 4; ++q) pk[q] = pk2(tl[n * 65 + kk + 2 * q], tl[n * 65 + kk + 2 * q + 1]);
            *(u32x4*)(dst + (long)drow * K + k0 + kk) = pk;
        }
        __syncthreads();
    }
}

__device__ __forceinline__ void phase_convert_straight(const float* src, const float* gk, bf16_t* dst) {
    const long gt = (long)blockIdx.x * NTHREADS + ltid();
    for (long v = gt; v < 131072; v += (long)gridDim.x * NTHREADS) {
        const int k = (int)(v >> 7);
        const f32x4 a = *(const f32x4*)(src + v * 8), b = *(const f32x4*)(src + v * 8 + 4);
        const float gg = gk[k];
        u32x4 pk; pk[0] = pk2(a[0] * gg, a[1] * gg); pk[1] = pk2(a[2] * gg, a[3] * gg); pk[2] = pk2(b[0] * gg, b[1] * gg); pk[3] = pk2(b[2] * gg, b[3] * gg);
        *(u32x4*)(dst + v * 8) = pk;
    }
}

__device__ __forceinline__ void phase_norm(const float* src, const float* g, bf16_t* dst, int nrows) {
    const int tid_ = ltid(); const int lane = tid_ & 63, gw = blockIdx.x * 8 + (tid_ >> 6), nw = gridDim.x * 8;
    for (int row = gw; row < nrows; row += nw) {
        const f32x4* pr = (const f32x4*)(src + (long)row * 1024);
        f32x4 v[4]; float ss = 0.f;
#pragma unroll
        for (int i = 0; i < 4; ++i) { v[i] = pr[lane + 64 * i]; ss += v[i][0] * v[i][0] + v[i][1] * v[i][1] + v[i][2] * v[i][2] + v[i][3] * v[i][3]; }
#pragma unroll
        for (int m = 32; m >= 1; m >>= 1) ss += __shfl_xor(ss, m);
        const float rstd = rsqrtf(ss * (1.0f / 1024.0f) + 1e-6f);
#pragma unroll
        for (int i = 0; i < 4; ++i) {
            const f32x4 gg = ((const f32x4*)g)[lane + 64 * i];
            u32x2 pk; pk[0] = pk2(v[i][0] * rstd * gg[0], v[i][1] * rstd * gg[1]); pk[1] = pk2(v[i][2] * rstd * gg[2], v[i][3] * rstd * gg[3]);
            *(u32x2*)(dst + (long)row * 1024 + (lane + 64 * i) * 4) = pk;
        }
    }
}
__device__ __forceinline__ void phase_prep(const float* src, bf16_t* dst, float* ss_out, int nrows) {
    const int tid_ = ltid(); const int lane = tid_ & 63, gw = blockIdx.x * 8 + (tid_ >> 6), nw = gridDim.x * 8;
    for (int row = gw; row < nrows; row += nw) {
        const f32x4* pr = (const f32x4*)(src + (long)row * 1024);
        f32x4 v[4]; float ss = 0.f;
#pragma unroll
        for (int i = 0; i < 4; ++i) { v[i] = pr[lane + 64 * i]; ss += v[i][0] * v[i][0] + v[i][1] * v[i][1] + v[i][2] * v[i][2] + v[i][3] * v[i][3]; }
#pragma unroll
        for (int m = 32; m >= 1; m >>= 1) ss += __shfl_xor(ss, m);
        if (lane < 16) ss_out[(long)row * 16 + lane] = (lane == 0) ? ss : 0.f;
#pragma unroll
        for (int i = 0; i < 4; ++i) { u32x2 pk; pk[0] = pk2(v[i][0], v[i][1]); pk[1] = pk2(v[i][2], v[i][3]); *(u32x2*)(dst + (long)row * 1024 + (lane + 64 * i) * 4) = pk; }
    }
}
__device__ __forceinline__ void phase_final_norm(const bf16_t* xb, float* out, const float* g, int nrows) {
    const int tid_ = ltid(); const int lane = tid_ & 63, gw = blockIdx.x * 8 + (tid_ >> 6), nw = gridDim.x * 8;
    for (int row = gw; row < nrows; row += nw) {
        float v[16]; float ss = 0.f;
#pragma unroll
        for (int i = 0; i < 2; ++i) {
            const u32x4 rv = *(const u32x4*)(xb + (long)row * 1024 + (lane + 64 * i) * 8);
#pragma unroll
            for (int q = 0; q < 4; ++q) { v[i * 8 + 2 * q] = lo16(rv[q]); v[i * 8 + 2 * q + 1] = hi16(rv[q]); }
        }
#pragma unroll
        for (int j = 0; j < 16; ++j) ss += v[j] * v[j];
#pragma unroll
        for (int m = 32; m >= 1; m >>= 1) ss += __shfl_xor(ss, m);
        const float rstd = rsqrtf(ss * (1.0f / 1024.0f) + 1e-6f);
#pragma unroll
        for (int i = 0; i < 2; ++i) {
            const f32x4 g0 = *(const f32x4*)(g + (lane + 64 * i) * 8), g1 = *(const f32x4*)(g + (lane + 64 * i) * 8 + 4);
            f32x4 o0, o1;
#pragma unroll
            for (int j = 0; j < 4; ++j) { o0[j] = v[i * 8 + j] * rstd * g0[j]; o1[j] = v[i * 8 + 4 + j] * rstd * g1[j]; }
            *(f32x4*)(out + (long)row * 1024 + (lane + 64 * i) * 8) = o0; *(f32x4*)(out + (long)row * 1024 + (lane + 64 * i) * 8 + 4) = o1;
        }
    }
}

__device__ __forceinline__ void lds_barrier() { asm volatile("s_waitcnt lgkmcnt(0)" ::: "memory"); __builtin_amdgcn_s_barrier(); asm volatile("" ::: "memory"); }
struct MixCtx {
    LAS unsigned char* lds;
    const bf16_t* proj;
    bf16_t* mix;
    bf16_t* sth; bf16_t* str; float* lasth;
    bf16_t* lrup; bf16_t* lruh; float* lrupe; float* lruhe; float* lruci;
    const bf16_t* waT; const bf16_t* wxT;
    const int* pos;
    const float* ret_gn_g; const float* hg_lb; const float* hg_norm_g;
    const float* conv_w; const float* conv_b; const float* ba; const float* bx; const float* lam;
    int l;
};

template <bool M3>
__device__ __forceinline__ void hg_unit(const MixCtx& c, int unit) {
    LAS unsigned char* lds = c.lds;
    const int tid = ltid(), wid = tid >> 6, lane = tid & 63;
    const int h = unit & 3; const long row0 = (long)(unit >> 2) * 64;
    LAS float* cum = (LAS float*)lds;
    LAS bf16_t* inpT = (LAS bf16_t*)(lds + (M3 ? 102400 : 51200));
    float kk[2][8], qq[2][8];
    u32x4 stv[3]; unsigned gwv[6];
    if (M3) {
#pragma unroll
        for (int i = 0; i < 3; ++i) { const int v = tid + 512 * i; stv[i] = *(const u32x4*)(c.sth + (long)unit * 12288 + (v >> 4) * 128 + (v & 15) * 8); }
        const bf16_t* gp = c.proj + (row0 + (tid >> 3)) * 3840 + 2944 + h * 96 + (tid & 7) * 12;
#pragma unroll
        for (int j = 0; j < 6; ++j) gwv[j] = *(const unsigned*)(gp + 2 * j);
    }
#pragma unroll
    for (int i = 0; i < 2; ++i) {
        const int e8 = tid + 512 * i, t = e8 >> 4, d0 = (e8 & 15) * 8;
        const bf16_t* pr = c.proj + (row0 + t) * 3840;
        const u32x4 vf = *(const u32x4*)(pr + 2048 + h * 128 + d0);
        float xf[8]; UNPACK8(vf, xf);
        float lbv[8];
        if (c.l == 0) {
#pragma unroll
            for (int j = 0; j < 8; ++j) lbv[j] = 0.f;
        } else {
            const f32x4 p0a = *(const f32x4*)(c.hg_lb + h * 128 + d0), p0b = *(const f32x4*)(c.hg_lb + h * 128 + d0 + 4);
            const f32x4 p1a = *(const f32x4*)(c.hg_lb + 512 + h * 128 + d0), p1b = *(const f32x4*)(c.hg_lb + 512 + h * 128 + d0 + 4);
#pragma unroll
            for (int j = 0; j < 4; ++j) { lbv[j] = 1.0f / (1.0f + __expf(p0a[j] - p1a[j])); lbv[4 + j] = 1.0f / (1.0f + __expf(p0b[j] - p1b[j])); }
        }
#pragma unroll
        for (int j = 0; j < 8; ++j) {
            const float s = 1.0f / (1.0f + __expf(-xf[j]));
            const float f = lbv[j] + (1.0f - lbv[j]) * s;
            kk[i][j] = 1.0f - f;
            cum[t * 128 + d0 + j] = __logf(f);
        }
        if (M3) {
            const u32x4 vq = *(const u32x4*)(pr + 1536 + h * 128 + d0);
            float xq[8]; UNPACK8(vq, xq);
#pragma unroll
            for (int j = 0; j < 8; ++j) qq[i][j] = silu(xq[j]);
        }
    }
    for (int v = tid; v < 768; v += 512) {
        const int t = v & 63, e0 = (v >> 6) * 8;
        const u32x4 vi = *(const u32x4*)(c.proj + (row0 + t) * 3840 + 2560 + h * 96 + e0);
#pragma unroll
        for (int j = 0; j < 4; ++j) { inpT[(e0 + 2 * j) * 72 + t] = (bf16_t)(vi[j] & 0xffffu); inpT[(e0 + 2 * j + 1) * 72 + t] = (bf16_t)(vi[j] >> 16); }
    }
    lds_barrier();
    {
        LAS float* ptot = (LAS float*)(lds + 152064);
        const int d = tid & 127, part = tid >> 7;
        float v[16]; float run = 0.f;
#pragma unroll
        for (int t = 0; t < 16; ++t) { v[t] = cum[(part * 16 + t) * 128 + d]; run += v[t]; }
        ptot[part * 128 + d] = run;
        lds_barrier();
        float base = 0.f;
#pragma unroll
        for (int pp = 0; pp < 3; ++pp) base += (pp < part) ? ptot[pp * 128 + d] : 0.f;
#pragma unroll
        for (int t = 0; t < 16; ++t) { base += v[t]; cum[(part * 16 + t) * 128 + d] = base; }
    }
    lds_barrier();
    if (!M3) {
        LAS bf16_t* KlT = (LAS bf16_t*)(lds + 32768);
        LAS float* Eb = (LAS float*)(lds + 65536);
        LAS bf16_t* kvs = (LAS bf16_t*)(lds + 99328);
#pragma unroll
        for (int i = 0; i < 2; ++i) {
            const int e8 = tid + 512 * i, t = e8 >> 4, d0 = (e8 & 15) * 8;
#pragma unroll
            for (int j = 0; j < 8; ++j) { const int d = d0 + j; Eb[t * 129 + d] = kk[i][j] * __expf(cum[63 * 128 + d] - cum[t * 128 + d]); }
        }
        if (tid < 128) c.lasth[(long)unit * 128 + tid] = cum[63 * 128 + tid];
        lds_barrier();
#pragma unroll
        for (int i = 0; i < 2; ++i) {
            const int v = tid + 512 * i, d = v & 127, t0 = (v >> 7) * 8;
            u32x4 pk;
#pragma unroll
            for (int q2 = 0; q2 < 4; ++q2) pk[q2] = pk2(Eb[(t0 + 2 * q2) * 129 + d], Eb[(t0 + 2 * q2 + 1) * 129 + d]);
            *(LAS u32x4*)(KlT + d * 72 + t0) = pk;
        }
        lds_barrier();
        const int r = lane & 15, q = lane >> 4;
        for (int i = 0; i < 6; ++i) {
            const int idx = wid + 8 * i, et = idx >> 3, dt = idx & 7;
            f32x4 acc = (f32x4){0.f, 0.f, 0.f, 0.f};
            acc = mma16(inpT + et * 16 * 72, 72, KlT + dt * 16 * 72, 72, 64, acc, lane);
#pragma unroll
            for (int j = 0; j < 4; ++j) kvs[(et * 16 + q * 4 + j) * 136 + dt * 16 + r] = f2bf(acc[j]);
        }
        lds_barrier();
#pragma unroll
        for (int i = 0; i < 3; ++i) {
            const int v = tid + 512 * i, e = v >> 4, d0 = (v & 15) * 8;
            *(u32x4*)(c.sth + (long)unit * 12288 + e * 128 + d0) = *(const LAS u32x4*)(kvs + e * 136 + d0);
        }
        lds_barrier();
    } else {
        LAS bf16_t* Qp = (LAS bf16_t*)(lds + 32768); LAS bf16_t* Qm = (LAS bf16_t*)(lds + 50176);
        LAS bf16_t* Kp = (LAS bf16_t*)(lds + 67584); LAS bf16_t* Km = (LAS bf16_t*)(lds + 84992);
        LAS bf16_t* stT = (LAS bf16_t*)(lds + 116224); LAS bf16_t* S = (LAS bf16_t*)(lds + 142336);
        LAS float* O = (LAS float*)lds;
#pragma unroll
        for (int i = 0; i < 2; ++i) {
            const int e8 = tid + 512 * i, t = e8 >> 4, d0 = (e8 & 15) * 8;
            float qp[8], qm[8], kp[8], km[8];
#pragma unroll
            for (int j = 0; j < 8; ++j) {
                const float cref = cum[31 * 128 + d0 + j], cc = cum[t * 128 + d0 + j];
                const float ep = __expf(cc - cref), em = __expf(cref - cc);
                qp[j] = qq[i][j] * ep; qm[j] = qq[i][j] * em; kp[j] = kk[i][j] * ep; km[j] = kk[i][j] * em;
            }
            u32x4 a, b, cc4, d;
#pragma unroll
            for (int j = 0; j < 4; ++j) { a[j] = pk2(qp[2 * j], qp[2 * j + 1]); b[j] = pk2(qm[2 * j], qm[2 * j + 1]); cc4[j] = pk2(kp[2 * j], kp[2 * j + 1]); d[j] = pk2(km[2 * j], km[2 * j + 1]); }
            *(LAS u32x4*)(Qp + t * 136 + d0) = a; *(LAS u32x4*)(Qm + t * 136 + d0) = b; *(LAS u32x4*)(Kp + t * 136 + d0) = cc4; *(LAS u32x4*)(Km + t * 136 + d0) = d;
        }
#pragma unroll
        for (int i = 0; i < 3; ++i) {
            const int v = tid + 512 * i, e = v >> 4, d0 = (v & 15) * 8;
            const u32x4 s = stv[i];
            float sf[8]; UNPACK8(s, sf);
            u32x4 o;
#pragma unroll
            for (int j = 0; j < 4; ++j) o[j] = pk2(sf[2 * j] * __expf(cum[31 * 128 + d0 + 2 * j]), sf[2 * j + 1] * __expf(cum[31 * 128 + d0 + 2 * j + 1]));
            *(LAS u32x4*)(stT + e * 136 + d0) = o;
        }
        lds_barrier();
        const int r = lane & 15, q = lane >> 4;
        for (int i = 0; i < 2; ++i) {
            const int idx = wid * 2 + i, ti = idx >> 2, tj = idx & 3;
            f32x4 s1 = (f32x4){0.f, 0.f, 0.f, 0.f}, s2 = (f32x4){0.f, 0.f, 0.f, 0.f};
            if (ti >= tj) s1 = mma16(Qp + ti * 16 * 136, 136, Km + tj * 16 * 136, 136, 128, s1, lane);
            if (ti <= tj) s2 = mma16(Qm + ti * 16 * 136, 136, Kp + tj * 16 * 136, 136, 128, s2, lane);
#pragma unroll
            for (int j = 0; j < 4; ++j) {
                const int t = ti * 16 + q * 4 + j, jj = tj * 16 + r;
                S[t * 72 + jj] = f2bf(t >= jj ? s1[j] : s2[j]);
            }
        }
        lds_barrier();
        for (int i = 0; i < 3; ++i) {
            const int idx = wid * 3 + i, tt = idx / 6, et = idx % 6;
            f32x4 acc = (f32x4){0.f, 0.f, 0.f, 0.f};
            acc = mma16(S + tt * 16 * 72, 72, inpT + et * 16 * 72, 72, 64, acc, lane);
            acc = mma16(Qp + tt * 16 * 136, 136, stT + et * 16 * 136, 136, 128, acc, lane);
#pragma unroll
            for (int j = 0; j < 4; ++j) O[(tt * 16 + q * 4 + j) * 100 + et * 16 + r] = acc[j];
        }
        lds_barrier();
        {
            const int t = tid >> 3, sub = tid & 7;
            float o[12], ss = 0.f;
#pragma unroll
            for (int j = 0; j < 12; ++j) { o[j] = O[t * 100 + sub * 12 + j]; ss += o[j] * o[j]; }
            ss += __shfl_xor(ss, 1); ss += __shfl_xor(ss, 2); ss += __shfl_xor(ss, 4);
            const float rstd = rsqrtf(ss * (1.0f / 96.0f) + 1e-6f);
            bf16_t* op = c.mix + (row0 + t) * 1024 + 384 + h * 96 + sub * 12;
            const float* gg = c.hg_norm_g + h * 96 + sub * 12;
#pragma unroll
            for (int j = 0; j < 6; ++j) {
                const unsigned gw = gwv[j];
                const float y0 = o[2 * j] * rstd * gg[2 * j] * silu(lo16(gw)), y1 = o[2 * j + 1] * rstd * gg[2 * j + 1] * silu(hi16(gw));
                *(unsigned*)(op + 2 * j) = pk2(y0, y1);
            }
        }
        lds_barrier();
    }
}

__device__ __forceinline__ void rope_tables(const MixCtx& c, long row0, LAS float* cs, LAS float* sn) {
    for (int p = ltid(); p < 3072; p += 512) {
        const int t = p / 48, i = p % 48;
        const float inv_freq = __expf(-9.210340371976184f * (float)i * (1.0f / 48.0f));
        const float ang = (float)c.pos[row0 + t] * inv_freq;
        const float k = rintf(ang * 0.15915494309189535f);
        float r = fmaf(-k, 6.28125f, ang); r = fmaf(-k, 1.9353071795864769e-3f, r);
        cs[p] = __cosf(r); sn[p] = __sinf(r);
    }
}
template <bool M3>
__device__ __forceinline__ void ret_unit(const MixCtx& c, int unit) {
    LAS unsigned char* lds = c.lds;
    const int tid = ltid(), wid = tid >> 6, lane = tid & 63;
    const int h = unit & 3; const long row0 = (long)(unit >> 2) * 64;
    const float lg = log1pf(-exp2f(-5.0f - (float)h));
    LAS float* cs = (LAS float*)lds; LAS float* sn = (LAS float*)(lds + 12288);
    u32x4 stv[3]; unsigned gwv[6];
    if (M3) {
#pragma unroll
        for (int i = 0; i < 3; ++i) { const int v = tid + 512 * i; if (v < 1152) stv[i] = *(const u32x4*)(c.str + (long)unit * 9216 + (v / 12) * 96 + (v % 12) * 8); }
        const bf16_t* gp = c.proj + (row0 + (tid >> 3)) * 3840 + 1152 + h * 96 + (tid & 7) * 12;
#pragma unroll
        for (int j = 0; j < 6; ++j) gwv[j] = *(const unsigned*)(gp + 2 * j);
    }
    rope_tables(c, row0, cs, sn);
    LAS bf16_t* vT = (LAS bf16_t*)(lds + 51200);
    for (int v = tid; v < 768; v += 512) {
        const int t = v & 63, e0 = (v >> 6) * 8;
        const u32x4 vi = *(const u32x4*)(c.proj + (row0 + t) * 3840 + 768 + h * 96 + e0);
#pragma unroll
        for (int j = 0; j < 4; ++j) { vT[(e0 + 2 * j) * 72 + t] = (bf16_t)(vi[j] & 0xffffu); vT[(e0 + 2 * j + 1) * 72 + t] = (bf16_t)(vi[j] >> 16); }
    }
    lds_barrier();
    const int r = lane & 15, q = lane >> 4;
    if (!M3) {
        LAS bf16_t* KdT = (LAS bf16_t*)(lds + 24576);
        if (tid < 384) {
            const int j = tid & 63, i0 = (tid >> 6) * 8;
            const bf16_t* kp = c.proj + (row0 + j) * 3840 + 384 + h * 96;
            const u32x4 v1 = *(const u32x4*)(kp + i0), v2 = *(const u32x4*)(kp + 48 + i0);
            float k1[8], k2[8]; UNPACK8(v1, k1); UNPACK8(v2, k2);
            const float dec = __expf(lg * (float)(63 - j));
#pragma unroll
            for (int e = 0; e < 8; ++e) {
                const float co = cs[j * 48 + i0 + e], si = sn[j * 48 + i0 + e];
                KdT[(i0 + e) * 72 + j] = f2bf((k1[e] * co - k2[e] * si) * dec);
                KdT[(48 + i0 + e) * 72 + j] = f2bf((k1[e] * si + k2[e] * co) * dec);
            }
        }
        lds_barrier();
        LAS bf16_t* kvs = (LAS bf16_t*)(lds + 65536);
        for (int i = 0; i < 5; ++i) {
            const int idx = wid + 8 * i;
            if (idx < 36) {
                const int et = idx / 6, dt = idx % 6;
                f32x4 acc = (f32x4){0.f, 0.f, 0.f, 0.f};
                acc = mma16(vT + et * 16 * 72, 72, KdT + dt * 16 * 72, 72, 64, acc, lane);
#pragma unroll
                for (int j = 0; j < 4; ++j) kvs[(et * 16 + q * 4 + j) * 104 + dt * 16 + r] = f2bf(acc[j]);
            }
        }
        lds_barrier();
#pragma unroll
        for (int i = 0; i < 3; ++i) { const int v = tid + 512 * i; if (v < 1152) *(u32x4*)(c.str + (long)unit * 9216 + (v / 12) * 96 + (v % 12) * 8) = *(const LAS u32x4*)(kvs + (v / 12) * 104 + (v % 12) * 8); }
        lds_barrier();
    } else {
        LAS bf16_t* Qr = (LAS bf16_t*)(lds + 24576); LAS bf16_t* Kr = (LAS bf16_t*)(lds + 37888);
        LAS bf16_t* stT = (LAS bf16_t*)(lds + 65024);
        LAS bf16_t* S = (LAS bf16_t*)(lds + 84992);
        LAS float* O = (LAS float*)(lds + 94208);
        if (tid < 384) {
            const int j = tid / 6, i0 = (tid % 6) * 8;
            const bf16_t* qp = c.proj + (row0 + j) * 3840 + h * 96;
            const bf16_t* kp = qp + 384;
            const u32x4 vq1 = *(const u32x4*)(qp + i0), vq2 = *(const u32x4*)(qp + 48 + i0), vk1 = *(const u32x4*)(kp + i0), vk2 = *(const u32x4*)(kp + 48 + i0);
            float q1[8], q2[8], k1[8], k2[8]; UNPACK8(vq1, q1); UNPACK8(vq2, q2); UNPACK8(vk1, k1); UNPACK8(vk2, k2);
            const float sc = 0.10206207261596575f;
            float qa[8], qb[8], ka[8], kb[8];
#pragma unroll
            for (int e = 0; e < 8; ++e) {
                const float co = cs[j * 48 + i0 + e], si = sn[j * 48 + i0 + e];
                qa[e] = (q1[e] * co - q2[e] * si) * sc; qb[e] = (q1[e] * si + q2[e] * co) * sc;
                ka[e] = k1[e] * co - k2[e] * si; kb[e] = k1[e] * si + k2[e] * co;
            }
            u32x4 o1, o2, o3, o4;
#pragma unroll
            for (int e = 0; e < 4; ++e) { o1[e] = pk2(qa[2 * e], qa[2 * e + 1]); o2[e] = pk2(qb[2 * e], qb[2 * e + 1]); o3[e] = pk2(ka[2 * e], ka[2 * e + 1]); o4[e] = pk2(kb[2 * e], kb[2 * e + 1]); }
            *(LAS u32x4*)(Qr + j * 104 + i0) = o1; *(LAS u32x4*)(Qr + j * 104 + 48 + i0) = o2;
            *(LAS u32x4*)(Kr + j * 104 + i0) = o3; *(LAS u32x4*)(Kr + j * 104 + 48 + i0) = o4;
        }
#pragma unroll
        for (int i = 0; i < 3; ++i) { const int v = tid + 512 * i; if (v < 1152) *(LAS u32x4*)(stT + (v / 12) * 104 + (v % 12) * 8) = stv[i]; }
        lds_barrier();
        for (int i = 0; i < 2; ++i) {
            const int idx = wid * 2 + i, ti = idx >> 2, tj = idx & 3;
            f32x4 s = (f32x4){0.f, 0.f, 0.f, 0.f};
            s = mma16(Qr + ti * 16 * 104, 104, Kr + tj * 16 * 104, 104, 96, s, lane);
#pragma unroll
            for (int j = 0; j < 4; ++j) {
                const int t = ti * 16 + q * 4 + j, jj = tj * 16 + r;
                const int dd = t > jj ? t - jj : jj - t;
                S[t * 72 + jj] = f2bf(s[j] * __expf(lg * (float)dd));
            }
        }
        lds_barrier();
        for (int i = 0; i < 3; ++i) {
            const int idx = wid * 3 + i, tt = idx / 6, et = idx % 6;
            f32x4 a1 = (f32x4){0.f, 0.f, 0.f, 0.f}, a2 = (f32x4){0.f, 0.f, 0.f, 0.f};
            a1 = mma16(S + tt * 16 * 72, 72, vT + et * 16 * 72, 72, 64, a1, lane);
            a2 = mma16(Qr + tt * 16 * 104, 104, stT + et * 16 * 104, 104, 96, a2, lane);
#pragma unroll
            for (int j = 0; j < 4; ++j) { const int t = tt * 16 + q * 4 + j; O[t * 100 + et * 16 + r] = a1[j] + __expf(lg * (float)(t + 1)) * a2[j]; }
        }
        lds_barrier();
        {
            const int t = tid >> 3, sub = tid & 7;
            float o[12], sm = 0.f;
#pragma unroll
            for (int j = 0; j < 12; ++j) { o[j] = O[t * 100 + sub * 12 + j]; sm += o[j]; }
            sm += __shfl_xor(sm, 1); sm += __shfl_xor(sm, 2); sm += __shfl_xor(sm, 4);
            const float mean = sm * (1.0f / 96.0f);
            float ss = 0.f;
#pragma unroll
            for (int j = 0; j < 12; ++j) { o[j] -= mean; ss += o[j] * o[j]; }
            ss += __shfl_xor(ss, 1); ss += __shfl_xor(ss, 2); ss += __shfl_xor(ss, 4);
            const float rstd = rsqrtf(ss * (1.0f / 96.0f) + 1e-6f);
            bf16_t* op = c.mix + (row0 + t) * 1024 + h * 96 + sub * 12;
            const float* gg = c.ret_gn_g + h * 96 + sub * 12;
#pragma unroll
            for (int j = 0; j < 6; ++j) {
                const unsigned gw = gwv[j];
                const float y0 = o[2 * j] * rstd * gg[2 * j] * silu(lo16(gw)), y1 = o[2 * j + 1] * rstd * gg[2 * j + 1] * silu(hi16(gw));
                *(unsigned*)(op + 2 * j) = pk2(y0, y1);
            }
        }
        lds_barrier();
    }
}

__device__ __forceinline__ void lru_m1(const MixCtx& c, int unit) {
    LAS unsigned char* lds = c.lds;
    const int tid = ltid(), wid = tid >> 6, lane = tid & 63;
    const int hh = unit & 1, bn = unit >> 1, n = bn & 127; const long row0 = (long)bn * 64; const int c0 = hh * 128;
    LAS float* xc = (LAS float*)lds; LAS float* Aa = (LAS float*)(lds + 32768); LAS bf16_t* xcb = (LAS bf16_t*)(lds + 65536);
    LAS bf16_t* lxs = (LAS bf16_t*)(lds + 83968);
    for (int v = tid; v < 67 * 16; v += 512) {
        const int rr = v >> 4, cc = (v & 15) * 8, tt = rr - 3;
        u32x4 val = (u32x4){0u, 0u, 0u, 0u};
        if (n * 64 + tt >= 0) val = *(const u32x4*)(c.proj + (row0 + tt) * 3840 + 3328 + c0 + cc);
        *(LAS u32x4*)(lxs + rr * 128 + cc) = val;
    }
    LAS bf16_t* wsm = (LAS bf16_t*)(lds + 101376);
#pragma unroll
    for (int i = 0; i < 4; ++i) {
        const int v = tid + 512 * i, mat = v >> 10, nbl = (v >> 9) & 1, d = (v >> 3) & 63, c8 = (v & 7) * 8;
        const u32x4 val = *(const u32x4*)((mat ? c.wxT : c.waT) + (hh * 2 + nbl) * 4096 + d * 64 + c8);
        *(LAS u32x4*)(wsm + ((mat * 2 + nbl) * 64 + d) * 72 + c8) = val;
    }
    const int cc = tid & 127, ch = c0 + cc;
    const float cw0 = c.conv_w[ch], cw1 = c.conv_w[256 + ch], cw2 = c.conv_w[512 + ch], cw3 = c.conv_w[768 + ch], cbv = c.conv_b[ch];
    lds_barrier();
#pragma unroll
    for (int i = 0; i < 16; ++i) {
        const int t = (tid >> 7) + 4 * i;
        const float acc = cbv + cw0 * bf2f(lxs[t * 128 + cc]) + cw1 * bf2f(lxs[(t + 1) * 128 + cc]) + cw2 * bf2f(lxs[(t + 2) * 128 + cc]) + cw3 * bf2f(lxs[(t + 3) * 128 + cc]);
        xc[t * 128 + cc] = acc; xcb[t * 136 + cc] = f2bf(acc);
    }
    lds_barrier();
    const int r = lane & 15, q = lane >> 4;
    for (int i = 0; i < 4; ++i) {
        const int idx = wid * 4 + i, nbl = idx >> 4, tt = (idx >> 2) & 3, dt = idx & 3;
        f32x4 ar = (f32x4){0.f, 0.f, 0.f, 0.f}, ai = (f32x4){0.f, 0.f, 0.f, 0.f};
#pragma unroll
        for (int k0 = 0; k0 < 64; k0 += 32) {
            const bf16x8 a = *(const LAS bf16x8*)(xcb + (tt * 16 + r) * 136 + nbl * 64 + k0 + q * 8);
            const bf16x8 b1 = *(const LAS bf16x8*)(wsm + ((0 + nbl) * 64 + dt * 16 + r) * 72 + k0 + q * 8);
            const bf16x8 b2 = *(const LAS bf16x8*)(wsm + ((2 + nbl) * 64 + dt * 16 + r) * 72 + k0 + q * 8);
            ar = __builtin_amdgcn_mfma_f32_16x16x32_bf16(a, b1, ar, 0, 0, 0);
            ai = __builtin_amdgcn_mfma_f32_16x16x32_bf16(a, b2, ai, 0, 0, 0);
        }
        const int c2 = nbl * 64 + dt * 16 + r, ch2 = c0 + c2;
        const float sp = log1pf(expf(-c.lam[ch2])), bav = c.ba[ch2], bxv = c.bx[ch2];
#pragma unroll
        for (int j = 0; j < 4; ++j) {
            const int t = tt * 16 + q * 4 + j;
            const float rr = 1.0f / (1.0f + __expf(-(ar[j] + bav))), ii = 1.0f / (1.0f + __expf(-(ai[j] + bxv)));
            const float la = -8.0f * sp * rr;
            const float a = __expf(la);
            const float u = sqrtf(fmaxf(1.0f - a * a, 0.f)) * ii * xc[t * 128 + c2];
            Aa[t * 128 + c2] = a; xc[t * 128 + c2] = u;
        }
    }
    lds_barrier();
    {
        LAS float* pt = (LAS float*)(lds + 138240);
        const int part = tid >> 7;
        float hs = 0.f, P = 1.f;
#pragma unroll
        for (int t = part * 16; t < part * 16 + 16; ++t) {
            const float a = Aa[t * 128 + cc], u = xc[t * 128 + cc];
            hs = a * hs + u; P *= a;
            xc[t * 128 + cc] = hs; Aa[t * 128 + cc] = P;
        }
        pt[part * 128 + cc] = P; pt[512 + part * 128 + cc] = hs;
        lds_barrier();
        float ch_ = 0.f, cP = 1.f;
#pragma unroll
        for (int pp = 0; pp < 3; ++pp) if (pp < part) { const float Pp = pt[pp * 128 + cc], hp = pt[512 + pp * 128 + cc]; ch_ = Pp * ch_ + hp; cP *= Pp; }
        if (part > 0) {
#pragma unroll
            for (int t = part * 16; t < part * 16 + 16; ++t) {
                const float Pl = Aa[t * 128 + cc];
                xc[t * 128 + cc] += Pl * ch_; Aa[t * 128 + cc] = Pl * cP;
            }
        }
        if (part == 3) { c.lruhe[(long)bn * 256 + ch] = xc[63 * 128 + cc]; c.lrupe[(long)bn * 256 + ch] = Aa[63 * 128 + cc]; }
    }
    lds_barrier();
#pragma unroll
    for (int i = 0; i < 2; ++i) {
        const int v = tid + 512 * i, t = v >> 4, c8 = (v & 15) * 8;
        const f32x4 h0 = *(const LAS f32x4*)(xc + t * 128 + c8), h1 = *(const LAS f32x4*)(xc + t * 128 + c8 + 4);
        const f32x4 p0 = *(const LAS f32x4*)(Aa + t * 128 + c8), p1 = *(const LAS f32x4*)(Aa + t * 128 + c8 + 4);
        u32x4 ph, pp; ph[0] = pk2(h0[0], h0[1]); ph[1] = pk2(h0[2], h0[3]); ph[2] = pk2(h1[0], h1[1]); ph[3] = pk2(h1[2], h1[3]);
        pp[0] = pk2(p0[0], p0[1]); pp[1] = pk2(p0[2], p0[3]); pp[2] = pk2(p1[0], p1[1]); pp[3] = pk2(p1[2], p1[3]);
        *(u32x4*)(c.lruh + (row0 + t) * 256 + c0 + c8) = ph; *(u32x4*)(c.lrup + (row0 + t) * 256 + c0 + c8) = pp;
    }
    lds_barrier();
}
__device__ __forceinline__ void lru_m3(const MixCtx& c, int bn) {
    const int tid = ltid(); const long row0 = (long)bn * 64;
#pragma unroll
    for (int i = 0; i < 4; ++i) {
        const int v = tid + 512 * i, t = v >> 5, cc = (v & 31) * 8;
        const u32x4 hv = *(const u32x4*)(c.lruh + (row0 + t) * 256 + cc);
        const u32x4 pv = *(const u32x4*)(c.lrup + (row0 + t) * 256 + cc);
        const u32x4 gv = *(const u32x4*)(c.proj + (row0 + t) * 3840 + 3584 + cc);
        const f32x4 ca = *(const f32x4*)(c.lruci + (long)bn * 256 + cc), cb = *(const f32x4*)(c.lruci + (long)bn * 256 + cc + 4);
        float hf[8], pf[8], gf[8]; UNPACK8(hv, hf); UNPACK8(pv, pf); UNPACK8(gv, gf);
        float o[8];
#pragma unroll
        for (int j = 0; j < 4; ++j) { o[j] = (hf[j] + pf[j] * ca[j]) * gelu_tanh(gf[j]); o[4 + j] = (hf[4 + j] + pf[4 + j] * cb[j]) * gelu_tanh(gf[4 + j]); }
        u32x4 pk; pk[0] = pk2(o[0], o[1]); pk[1] = pk2(o[2], o[3]); pk[2] = pk2(o[4], o[5]); pk[3] = pk2(o[6], o[7]);
        *(u32x4*)(c.mix + (row0 + t) * 1024 + 768 + cc) = pk;
    }
}

__device__ __forceinline__ void phase_scan(const MixCtx& c) {
    const long gt = (long)blockIdx.x * NTHREADS + ltid();
    if (gt < 49152) {
        const int bh = (int)(gt / 3072), g4 = (int)(gt % 3072), b = bh >> 2, h = bh & 3, d0 = (g4 * 4) & 127;
        float s0 = 0.f, s1 = 0.f, s2 = 0.f, s3 = 0.f;
        for (int n0 = 0; n0 < 128; n0 += 8) {
            u32x2 kv[8]; f32x4 la[8];
#pragma unroll
            for (int i = 0; i < 8; ++i) {
                const long unit = ((long)(b * 128 + n0 + i)) * 4 + h;
                kv[i] = *(const u32x2*)(c.sth + unit * 12288 + g4 * 4);
                la[i] = *(const f32x4*)(c.lasth + unit * 128 + d0);
            }
#pragma unroll
            for (int i = 0; i < 8; ++i) {
                const long unit = ((long)(b * 128 + n0 + i)) * 4 + h;
                u32x2 o; o[0] = pk2(s0, s1); o[1] = pk2(s2, s3); *(u32x2*)(c.sth + unit * 12288 + g4 * 4) = o;
                s0 = __expf(la[i][0]) * s0 + lo16(kv[i][0]); s1 = __expf(la[i][1]) * s1 + hi16(kv[i][0]);
                s2 = __expf(la[i][2]) * s2 + lo16(kv[i][1]); s3 = __expf(la[i][3]) * s3 + hi16(kv[i][1]);
            }
        }
    } else if (gt < 49152 + 36864) {
        const long g = gt - 49152; const int bh = (int)(g / 2304), g4 = (int)(g % 2304), b = bh >> 2, h = bh & 3;
        const float dec = expf(64.0f * log1pf(-exp2f(-5.0f - (float)h)));
        float s0 = 0.f, s1 = 0.f, s2 = 0.f, s3 = 0.f;
        for (int n0 = 0; n0 < 128; n0 += 8) {
            u32x2 kv[8];
#pragma unroll
            for (int i = 0; i < 8; ++i) { const long unit = ((long)(b * 128 + n0 + i)) * 4 + h; kv[i] = *(const u32x2*)(c.str + unit * 9216 + g4 * 4); }
#pragma unroll
            for (int i = 0; i < 8; ++i) {
                const long unit = ((long)(b * 128 + n0 + i)) * 4 + h;
                u32x2 o; o[0] = pk2(s0, s1); o[1] = pk2(s2, s3); *(u32x2*)(c.str + unit * 9216 + g4 * 4) = o;
                s0 = dec * s0 + lo16(kv[i][0]); s1 = dec * s1 + hi16(kv[i][0]); s2 = dec * s2 + lo16(kv[i][1]); s3 = dec * s3 + hi16(kv[i][1]);
            }
        }
    } else if (gt < 49152 + 36864 + 1024) {
        const int g = (int)(gt - 49152 - 36864), b = g >> 8, ch = g & 255;
        float carry = 0.f;
        for (int n0 = 0; n0 < 128; n0 += 8) {
            float pe[8], he[8];
#pragma unroll
            for (int i = 0; i < 8; ++i) { const long o = (long)(b * 128 + n0 + i) * 256 + ch; pe[i] = c.lrupe[o]; he[i] = c.lruhe[o]; }
#pragma unroll
            for (int i = 0; i < 8; ++i) { const long o = (long)(b * 128 + n0 + i) * 256 + ch; c.lruci[o] = carry; carry = pe[i] * carry + he[i]; }
        }
    }
}

#define XB_TMO      128
#define XB_XCNT(j)  (256  + 64 * (j))
#define XB_XSUB(j)  (1280 + 64 * (j))
#define XB_XGEN(j)  (2304 + 64 * (j))
#define XB_TOP      3328
#define XB_TOPGEN   3392
#define XCD_BAR_WORDS 3456
#define XB_SPIN_CAP (1u << 18)
__device__ __forceinline__ unsigned xb_ld(unsigned* p)              { return __hip_atomic_load(p, __ATOMIC_RELAXED, __HIP_MEMORY_SCOPE_AGENT); }
__device__ __forceinline__ unsigned xb_add(unsigned* p, unsigned v) { return __hip_atomic_fetch_add(p, v, __ATOMIC_RELAXED, __HIP_MEMORY_SCOPE_AGENT); }
__device__ __forceinline__ unsigned xb_xcc_id() { return (unsigned)__builtin_amdgcn_s_getreg((3 << 11) | 20) & 0xFu; }
#define XB_SPIN(cond, bar) do { unsigned _sp = 0; while (cond) { __builtin_amdgcn_s_sleep(1); \
    if ((++_sp & 255u) == 0u) { if (xb_ld(&(bar)[XB_TMO])) break; if (_sp > XB_SPIN_CAP) { atomicAdd(&(bar)[XB_TMO], 1u); break; } } } } while (0)
struct XcdBarrier { unsigned* bar; unsigned x; volatile LAS unsigned* st; };
__device__ __forceinline__ XcdBarrier xcd_barrier_post(unsigned* bar, volatile LAS unsigned* st) {
    XcdBarrier b; b.bar = bar; b.x = xb_xcc_id(); b.st = st;
    if (threadIdx.x == 0) (void)xb_add(&bar[XB_XCNT(b.x)], 1u);
    return b;
}
__device__ __forceinline__ void xcd_barrier_complete(unsigned* bar, unsigned x, unsigned& nloc, unsigned& nx) {
    const unsigned G = gridDim.x * gridDim.y * gridDim.z;
    unsigned sum, cnt, mine, sp = 0u;
    for (;;) {
        sum = 0u; cnt = 0u; mine = 0u;
#pragma unroll
        for (unsigned j = 0; j < 16; ++j) { const unsigned c = xb_ld(&bar[XB_XCNT(j)]); sum += c; cnt += (c > 0u) ? 1u : 0u; mine = (j == x) ? c : mine; }
        if (sum == G) break;
        __builtin_amdgcn_s_sleep(1);
        if ((++sp & 255u) == 0u) { if (xb_ld(&bar[XB_TMO])) break; if (sp > XB_SPIN_CAP) { atomicAdd(&bar[XB_TMO], 1u); break; } }
    }
    nloc = mine > 0u ? mine : 1u; nx = cnt > 0u ? cnt : 1u;
}
__device__ __forceinline__ void xcd_barrier(const XcdBarrier& b) {
    asm volatile("s_waitcnt vmcnt(0)" ::: "memory");
    __syncthreads();
    if (threadIdx.x == 0) {
        unsigned* bar = b.bar;
        __builtin_amdgcn_s_waitcnt(0);
        unsigned nloc = b.st[0], nx = b.st[1];
        if (nloc == 0u) { xcd_barrier_complete(bar, b.x, nloc, nx); b.st[0] = nloc; b.st[1] = nx; }
        const unsigned old = xb_add(&bar[XB_XSUB(b.x)], 1u);
        const unsigned gen = old / nloc;
        if (old + 1u == (gen + 1u) * nloc) {
            __builtin_amdgcn_fence(__ATOMIC_RELEASE, "agent");
            asm volatile("s_waitcnt vmcnt(0)" ::: "memory");
            const unsigned og = xb_add(&bar[XB_TOP], 1u);
            const unsigned tg = og / nx;
            if (og + 1u == (tg + 1u) * nx) xb_add(&bar[XB_TOPGEN], 1u);
            else XB_SPIN(xb_ld(&bar[XB_TOPGEN]) == tg, bar);
            __builtin_amdgcn_fence(__ATOMIC_ACQUIRE, "agent");
            xb_add(&bar[XB_XGEN(b.x)], 1u);
            asm volatile("s_waitcnt vmcnt(0)" ::: "memory");
        } else {
            XB_SPIN(xb_ld(&bar[XB_XGEN(b.x)]) == gen, bar);
            __builtin_amdgcn_fence(__ATOMIC_ACQUIRE, "agent");
            asm volatile("s_waitcnt vmcnt(0)" ::: "memory");
        }
    }
    __syncthreads();
}

__global__ void __launch_bounds__(NTHREADS) mega(Params p) {
    extern __shared__ __attribute__((aligned(16))) unsigned char shm[];
    LAS unsigned char* lds = (LAS unsigned char*)shm;
    cg::grid_group grid = cg::this_grid();
    const int G = gridDim.x, cb = blockIdx.x;
    volatile LAS unsigned* xst = (volatile LAS unsigned*)(lds + LDS_BYTES - 16);
    if (threadIdx.x < 2) xst[threadIdx.x] = 0u;
    __syncthreads();
    const XcdBarrier xb = xcd_barrier_post((unsigned*)(WSP + WS_BAR), xst);
#define ws WSP
#define BIG ((bf16_t*)(WSP + WS_BIG))
#define Hb ((bf16_t*)XOUT)
#define XB ((bf16_t*)(WSP + WS_H))
#define MEMN ((bf16_t*)(WSP + WS_MEMN))
#define KMEM ((bf16_t*)(WSP + WS_KMEM))
#define KV ((bf16_t*)(WSP + WS_KMEM))
#define MBT ((bf16_t*)(WSP + WS_MBT))
#define VWT ((bf16_t*)(WSP + WS_VWT))
#define VT ((bf16_t*)(WSP + WS_VT))
#define Qb (BIG + 32768l * 1024)
#define Pb (BIG + 2 * 32768l * 1024)
#define SSP(i) ((float*)(WSP + WS_SS) + (long)((i) & 1) * 32768 * 16)
#define X XOUT

    for (int ph = 0; ph < 38; ++ph) {
        const int l = ph / 19, k = ph % 19;

        GJob g{}; Epi E{}; bool is_gemm = true;
        g.lda = 1024; g.ldb = 1024; g.K = 1024; g.nM = 128; g.nN = 4; g.nZ = 1; E.scale = 1.0f; E.ldo = 1024;
        const float* ng = nullptr;
        switch (k) {
            case 1: g.A = XB; g.Bt = (const bf16_t*)(ws + WB_UP1); g.nN = 22; E.O = BIG; E.ss_in = SSP(l * 4 + 0); for (int rr = 0; rr < REP_GEMM; ++rr) { PH(2) gemm_phase<0>(lds, g, E, G, cb); } break;
            case 17: g.A = XB; g.Bt = (const bf16_t*)(ws + WB_UP2); g.nN = 22; E.O = BIG; E.ss_in = SSP(l * 4 + 3); for (int rr = 0; rr < REP_GEMM; ++rr) { PH(18) gemm_phase<0>(lds, g, E, G, cb); } break;
            case 2: case 3: continue;
            case 4: g.A = BIG; g.Bt = (const bf16_t*)(ws + WB_DN1); g.lda = 2816; g.ldb = 2816; g.K = 2816; E.resb = XB; E.scale = 0.5f; E.ss_out = SSP(l * 4 + 1); for (int rr = 0; rr < REP_GEMM; ++rr) { E.O = (rr == REP_GEMM - 1) ? XB : Hb; PH(4) gemm_phase<1>(lds, g, E, G, cb); } break;
            case 18: g.A = BIG; g.Bt = (const bf16_t*)(ws + WB_DN2); g.lda = 2816; g.ldb = 2816; g.K = 2816; E.resb = XB; E.scale = 0.5f; E.ss_out = SSP(l * 4 + 4); for (int rr = 0; rr < REP_GEMM; ++rr) { E.O = (rr == REP_GEMM - 1) ? XB : Hb; PH(19) gemm_phase<1>(lds, g, E, G, cb); } break;
            case 6: g.A = XB; g.Bt = (const bf16_t*)(ws + WB_IN); g.nN = 15; E.O = BIG; E.ldo = 3840; E.ss_in = SSP(l * 4 + 1); for (int rr = 0; rr < REP_GEMM; ++rr) { PH(5) gemm_phase<2>(lds, g, E, G, cb); }
                {
                GJob g2{}; Epi E2{}; g2.lda = 1024; g2.ldb = 1024; g2.K = 1024; g2.nZ = 1; E2.scale = 1.0f;
                g2.A = MEMN; g2.Bt = (const bf16_t*)(ws + WB_KV); g2.nM = 4; g2.nN = 8; E2.O = KV; E2.ldo = 2048; gemm_phase<2>(lds, g2, E2, G, (cb + 128) % G);
                } break;
            case 10:
                g.A = Hb; g.Bt = (const bf16_t*)(ws + WB_OUT); E.resb = XB; E.ss_out = SSP(l * 4 + 2); for (int rr = 0; rr < REP_GEMM; ++rr) { E.O = (rr == REP_GEMM - 1) ? XB : BIG; PH(13) gemm_phase<1>(lds, g, E, G, cb); } break;
            case 12: continue;
            case 13: g.A = XB; g.aZ1 = 8192l * 1024; g.Bt = MBT; g.bZ1 = 1024l * 1024; g.nM = 32; g.nN = 4; g.nZ = 4; g.rowZ = 8192;
                     E.O = Pb; E.rowZ = 8192; E.ss_in = SSP(l * 4 + 2); E.tab = (LAS float*)(lds + 131072); for (int rr = 0; rr < REP_GEMM; ++rr) { PH(15) gemm_phase<3>(lds, g, E, G, cb); } break;
            case 14: continue;
            case 15: g.A = Pb; g.aZ1 = 8192l * 1024; g.Bt = VWT; g.bZ1 = 1024l * 1024; g.nM = 32; g.nN = 4; g.nZ = 4; E.rowZ = 8192;
                     E.resb = XB; E.ss_out = SSP(l * 4 + 3); for (int rr = 0; rr < REP_GEMM; ++rr) { E.O = (rr == REP_GEMM - 1) ? XB : BIG; PH(17) gemm_phase<1>(lds, g, E, G, cb); } break;
            case 0: is_gemm = false; ng = PIN(3); break;
            case 5: case 11: case 16: continue;
            default: is_gemm = false; break;
        }
        if (is_gemm) {
        } else if (ng != nullptr) {
            for (int rr = 0; rr < REP_EW; ++rr) {
            if (k == 0) { PH(0) phase_convert(l, lds, 0, 3072); PH(0) phase_convert(l, lds, 3584, 4352); PH(0) phase_convert(l, lds, 6464, 6472);
                          PH(0) phase_convert_straight(PIN(22) + l * 1024l * 1024, PIN(20) + l * 1024, (bf16_t*)(ws + WB_Q)); }
            if (l == 0) { PH(1) phase_prep(PIN(0), XB, SSP(0), 32768); }
            PH(1) phase_norm(PIN(1), PIN(21) + l * 1024, MEMN, 1024);
            }
        } else {
        MixCtx mc;
            mc.lds = lds; mc.proj = BIG; mc.mix = Hb; mc.sth = (bf16_t*)(ws + WS_STH); mc.str = (bf16_t*)(ws + WS_STR); mc.lasth = (float*)(ws + WS_LASTH);
            mc.lrup = (bf16_t*)(ws + WS_LRUP); mc.lruh = (bf16_t*)(ws + WS_LRUH); mc.lrupe = (float*)(ws + WS_LRUPE); mc.lruhe = (float*)(ws + WS_LRUHE); mc.lruci = (float*)(ws + WS_LRUCI);
            mc.waT = (const bf16_t*)(ws + WB_WA); mc.wxT = (const bf16_t*)(ws + WB_WX);
            mc.pos = (const int*)PIN(2); mc.hg_lb = PIN(10);
            mc.ret_gn_g = PIN(9) + l * 384; mc.hg_norm_g = PIN(11) + l * 384;
            mc.conv_w = PIN(12) + l * 1024; mc.conv_b = PIN(13) + l * 256; mc.ba = PIN(15) + l * 256; mc.bx = PIN(17) + l * 256; mc.lam = PIN(18) + l * 256;
            mc.l = l;
            if (k == 7) {
                for (int rr = 0; rr < REP_MIX; ++rr) for (int idx = cb; idx < 5120; idx += G) {
                    const int kk5 = idx % 5, u = idx / 5;
                    if (kk5 < 2) { RMT(0) ret_unit<false>(mc, 2 * u + kk5); }
                    else if (kk5 < 4) { RMT(1) hg_unit<false>(mc, 2 * u + (kk5 - 2)); }
                    else { RMT(2) lru_m1(mc, u); }
                }
                {
                GJob g2{}; Epi E2{}; g2.A = KV; g2.lda = 2048; g2.aZ1 = 256l * 2048; g2.aZ2 = 256; g2.Bt = (const bf16_t*)(ws + WB_Q); g2.ldb = 1024; g2.bZ2 = 256; g2.K = 256; g2.nM = 1; g2.nN = 4; g2.nZ = 16; g2.zshift = 2;
                E2.O = MBT; E2.ldo = 1024; E2.oZ1 = 1024l * 1024; E2.oZ2 = 256l * 1024; E2.zshift = 2; E2.scale = 0.0625f; gemm_phase<2>(lds, g2, E2, G, cb);
                GJob g3{}; Epi E3{}; g3.A = (const bf16_t*)(ws + WB_O); g3.lda = 1024; g3.aZ2 = 256; g3.Bt = KV + 1024; g3.ldb = 2048; g3.bZ1 = 256l * 2048; g3.bZ2 = 256; g3.K = 256; g3.nM = 4; g3.nN = 1; g3.nZ = 16; g3.zshift = 2;
                E3.O = VWT; E3.ldo = 1024; E3.oZ1 = 1024l * 1024; E3.oZ2 = 256; E3.zshift = 2; E3.scale = 1.0f; gemm_phase<2>(lds, g3, E3, G, (cb + 64) % G);
                                }
            } else if (k == 8) {
                PH(9) phase_scan(mc);
                PH(0) phase_convert(l, lds, 3072, 3328);
                PH(0) phase_convert(l, lds, 4352, 6464);
            } else {
                for (int rr = 0; rr < REP_MIX; ++rr) for (int idx = cb; idx < 4608; idx += G) {
                    const int kk9 = idx % 9, u = idx / 9;
                    if (kk9 < 4) { RMT(3) ret_unit<true>(mc, 4 * u + kk9); }
                    else if (kk9 < 8) { RMT(4) hg_unit<true>(mc, 4 * u + (kk9 - 4)); }
                    else { RMT(5) lru_m3(mc, u); }
                }
            }
        }
        if (ph == 0) grid.sync(); else xcd_barrier(xb);
    }
    PH(20) phase_final_norm(XB, X, PIN(29), 32768);
}

#undef ws
#undef BIG
#undef Hb
#undef XB
#undef MEMN
#undef KMEM
#undef KV
#undef MBT
#undef VWT
#undef VT
#undef Qb
#undef SSP
#undef Pb
#undef X
extern "C" void kernel_launch(void* const* d_in, const int* in_sizes, int n_in, void* d_out, int out_size, void* d_ws, size_t ws_size, hipStream_t stream) {
    static int grid = 0;
    if (grid == 0) {
        int dev = 0, cus = 0, per_cu = 0;
        (void)hipGetDevice(&dev);
        (void)hipDeviceGetAttribute(&cus, hipDeviceAttributeMultiprocessorCount, dev);
        if (hipFuncSetAttribute((const void*)mega, hipFuncAttributeMaxDynamicSharedMemorySize, LDS_BYTES) != hipSuccess) fprintf(stderr, "kernel_launch: hipFuncSetAttribute failed\n");
        if (hipOccupancyMaxActiveBlocksPerMultiprocessor(&per_cu, (const void*)mega, NTHREADS, LDS_BYTES) != hipSuccess || per_cu < 1) { fprintf(stderr, "kernel_launch: occupancy query says %d\n", per_cu); per_cu = 1; }
        (void)hipGetLastError();
        grid = cus * 1;
        if (ws_size < WS_END) fprintf(stderr, "kernel_launch: workspace too small: %zu < %zu\n", ws_size, (size_t)WS_END);
    }
    Params p{};
    for (int i = 0; i < 30; ++i) p.in[i] = (const float*)d_in[i];
    p.outp_ = (float*)d_out; p.wsp_ = (unsigned char*)d_ws;
    if (hipMemsetAsync((char*)d_ws + WS_BAR, 0, 16384, stream) != hipSuccess) fprintf(stderr, "kernel_launch: memset of barrier words failed\n");
    void* args[] = {&p};
    hipError_t e = hipLaunchCooperativeKernel((const void*)mega, dim3(grid), dim3(NTHREADS), args, LDS_BYTES, stream);
    if (e != hipSuccess) fprintf(stderr, "cooperative launch failed: %s (grid %d)\n", hipGetErrorString(e), grid);
}
```

```cpp
#include <hip/hip_runtime.h>
#include <hip/hip_cooperative_groups.h>
#include <cstdio>
namespace cg = cooperative_groups;

#define LAS __attribute__((address_space(3)))
typedef unsigned short bf16_t;
typedef short bf16x8 __attribute__((ext_vector_type(8)));
typedef float f32x4 __attribute__((ext_vector_type(4)));
typedef unsigned u32x4 __attribute__((ext_vector_type(4)));
typedef unsigned u32x2 __attribute__((ext_vector_type(2)));

constexpr int LDS_BYTES = 155648;
constexpr int NTHREADS = 512;
constexpr long T_TOK = 32768;
#ifndef PHMASK
#define PHMASK 0xffffffffu
#endif
#define PH(n) if ((PHMASK >> (n)) & 1u)
#ifndef REPK
#define REPK 0u
#endif
#define REP_GEMM (((REPK >> k) & 1u) ? 2 : 1)
#ifndef REP_MIX
#define REP_MIX 1
#endif
#ifndef REP_MT
#define REP_MT 0u
#endif
#define RMT(b) for (int r2 = 0; r2 < (((REP_MT >> (b)) & 1u) ? 2 : 1); ++r2)
#ifndef REP_EW
#define REP_EW 1
#endif

constexpr size_t WB_UP1 = 0;
constexpr size_t WB_DN1 = WB_UP1 + 5632ull * 1024 * 2;
constexpr size_t WB_IN = WB_DN1 + 1024ull * 2816 * 2;
constexpr size_t WB_OUT = WB_IN + 3840ull * 1024 * 2;
constexpr size_t WB_Q = WB_OUT + 1024ull * 1024 * 2;
constexpr size_t WB_KV = WB_Q + 1024ull * 1024 * 2;
constexpr size_t WB_O = WB_KV + 2048ull * 1024 * 2;
constexpr size_t WB_UP2 = WB_O + 1024ull * 1024 * 2;
constexpr size_t WB_DN2 = WB_UP2 + 5632ull * 1024 * 2;
constexpr size_t WB_WA = WB_DN2 + 1024ull * 2816 * 2;
constexpr size_t WB_WX = WB_WA + 16384ull * 2;
constexpr size_t WS_BIG = WB_WX + 16384ull * 2;
constexpr size_t WS_H = WS_BIG + 32768ull * 3840 * 2;
constexpr size_t WS_STH = WS_H + 32768ull * 1024 * 2;
constexpr size_t WS_STR = WS_STH + 2048ull * 96 * 128 * 2;
constexpr size_t WS_LASTH = WS_STR + 2048ull * 96 * 96 * 2;
constexpr size_t WS_LRUP = WS_LASTH + 2048ull * 128 * 4;
constexpr size_t WS_LRUH = WS_LRUP + 32768ull * 256 * 2;
constexpr size_t WS_LRUPE = WS_LRUH + 32768ull * 256 * 2;
constexpr size_t WS_LRUHE = WS_LRUPE + 512ull * 256 * 4;
constexpr size_t WS_LRUCI = WS_LRUHE + 512ull * 256 * 4;
constexpr size_t WS_MEMN = WS_LRUCI + 512ull * 256 * 4;
constexpr size_t WS_KMEM = WS_MEMN + 1024ull * 1024 * 2;
constexpr size_t WS_VT = WS_KMEM + 1024ull * 1024 * 2;
constexpr size_t WS_BAR = WS_VT + 1024ull * 1024 * 2;
constexpr size_t WS_SS = WS_BAR + 16384;
constexpr size_t WS_MBT = WS_SS + 2ull * 32768 * 16 * 4;
constexpr size_t WS_VWT = WS_MBT + 4ull * 1024 * 1024 * 2;
constexpr size_t WS_END = WS_VWT + 4ull * 1024 * 1024 * 2;

struct Params {
    const float* in[30];
    float* outp_;
    unsigned char* wsp_;
};

typedef const __attribute__((address_space(4))) Params* KArgP;
__device__ __forceinline__ KArgP kargs() { auto q = __builtin_amdgcn_kernarg_segment_ptr(); asm volatile("" : "+s"(q)); return (KArgP)q; }
#define PIN(i) (kargs()->in[i])
#define WSP (kargs()->wsp_)
#define XOUT (kargs()->outp_)
__device__ __forceinline__ int ltid() { int t = threadIdx.x; asm volatile("" : "+v"(t)); return t; }
__device__ __forceinline__ float bf2f(bf16_t b) { return __uint_as_float(((unsigned)b) << 16); }
typedef float f32x2_t __attribute__((ext_vector_type(2)));
typedef __bf16 bf16x2_t __attribute__((ext_vector_type(2)));
__device__ __forceinline__ unsigned pk2(float lo, float hi) { const f32x2_t f = {lo, hi}; const bf16x2_t b = __builtin_convertvector(f, bf16x2_t); return __builtin_bit_cast(unsigned, b); }
__device__ __forceinline__ bf16_t f2bf(float f) { return (bf16_t)(pk2(f, f) & 0xffffu); }
__device__ __forceinline__ float lo16(unsigned w) { return __uint_as_float(w << 16); }
__device__ __forceinline__ float hi16(unsigned w) { return __uint_as_float(w & 0xffff0000u); }
__device__ __forceinline__ float sigm(float x) { return __builtin_amdgcn_rcpf(1.0f + __expf(-x)); }
__device__ __forceinline__ float silu(float x) { return x * sigm(x); }
__device__ __forceinline__ float gelu_tanh(float x) { return x * sigm(1.5957691216f * (x + 0.044715f * x * x * x)); }
#define UNPACK8(v, f) do { _Pragma("unroll") for (int _i = 0; _i < 4; ++_i) { f[2 * _i] = lo16(v[_i]); f[2 * _i + 1] = hi16(v[_i]); } } while (0)

__device__ __forceinline__ f32x4 mma16(const LAS bf16_t* A, int lda, const LAS bf16_t* B, int ldb, int K, f32x4 acc, int lane) {
    const int r = lane & 15, q = lane >> 4;
    const LAS bf16_t* ap = A + r * lda + q * 8;
    const LAS bf16_t* bp = B + r * ldb + q * 8;
    for (int k0 = 0; k0 < K; k0 += 32) {
        const bf16x8 a = *(const LAS bf16x8*)(ap + k0);
        const bf16x8 b = *(const LAS bf16x8*)(bp + k0);
        acc = __builtin_amdgcn_mfma_f32_16x16x32_bf16(a, b, acc, 0, 0, 0);
    }
    return acc;
}

constexpr int BM = 256, BK = 64, HALF = 128, HTB = HALF * BK * 2;
__device__ __forceinline__ int lds_byte(int r, int c) { const int st = (r >> 4) * 2 + (c >> 5), rr = r & 15, cc = c & 31, ob = rr * 64 + cc * 2; return st * 1024 + (ob ^ (((ob >> 9) & 1) << 5)); }
__device__ __forceinline__ void stage_rc(int b, int& R, int& C) { const int st = b / 1024, sb = b % 1024, swz = sb ^ (((sb >> 9) & 1) << 5); R = (st >> 1) * 16 + swz / 64; C = (st & 1) * 32 + (swz % 64) / 2; }
__device__ __forceinline__ int perm32(int rho) { const int n = rho >> 4, i = rho & 15; return 8 * (i >> 2) + 4 * n + (i & 3); }

struct Unit { int pm, pn, z; };
struct GJob {
    const bf16_t* A; const bf16_t* Bt; int lda, ldb, K, nM, nN, nZ, zshift; long aZ1, aZ2, bZ1, bZ2;
    long rowZ;
};
__device__ __forceinline__ bool g_next(const GJob& g, int i, int G, int c, Unit& u) {
    const int per = g.nM * g.nN, tot = per * g.nZ;
    const long L = (long)i * G + c; if (L >= tot) return false;
    int wgid = (int)L; { const int q = tot / 8, r = tot % 8, xcd = wgid % 8, off = wgid / 8; wgid = (xcd < r ? xcd * (q + 1) : r * (q + 1) + (xcd - r) * q) + off; }
    u.z = wgid / per; const int w = wgid % per;
    const int nig = 8 * g.nN, gid = w / nig, fm = gid * 8, gsz = (g.nM - fm) < 8 ? (g.nM - fm) : 8;
    u.pm = fm + ((w % nig) % gsz); u.pn = (w % nig) / gsz; return true;
}
__device__ __forceinline__ const char* g_aptr(const GJob& g, const Unit& u) {
    const long z1 = u.z >> g.zshift, z2 = u.z & ((1 << g.zshift) - 1);
    return (const char*)(g.A + z1 * g.aZ1 + z2 * g.aZ2 + (long)u.pm * BM * g.lda);
}
__device__ __forceinline__ const char* g_bptr(const GJob& g, const Unit& u) {
    const long z1 = u.z >> g.zshift, z2 = u.z & ((1 << g.zshift) - 1);
    return (const char*)(g.Bt + z1 * g.bZ1 + z2 * g.bZ2 + (long)u.pn * BM * g.ldb);
}

typedef f32x4 AccT[2][2][4][2];

struct Epi {
    int mode; int ldo; int zshift; float scale; bf16_t* O; long oZ1, oZ2; const bf16_t* resb; LAS float* tab;
    long rowZ;
    const float* ss_in;
    float* ss_out;
};
__device__ __forceinline__ float row_rstd(const float* ss, long row) {
    const f32x4* sp = (const f32x4*)(ss + row * 16);
    const f32x4 a = (sp[0] + sp[1]) + (sp[2] + sp[3]);
    return rsqrtf(((a[0] + a[1]) + (a[2] + a[3])) * (1.0f / 1024.0f) + 1e-6f);
}
__device__ __forceinline__ void epi_swiglu(const Epi& E, AccT& acc, const Unit& u, int wr, int wc, int fr, int fq, const LAS float* rst) {
    const long row0 = (long)u.pm * BM + wr * 64 + fr; const int col0 = u.pn * 128 + wc * 32 + 8 * fq;
#pragma unroll
    for (int ai = 0; ai < 2; ++ai)
#pragma unroll
        for (int m = 0; m < 4; ++m) {
            const float rs = rst[ai * 128 + wr * 64 + m * 16 + fr];
            float o[8];
#pragma unroll
            for (int n = 0; n < 2; ++n)
#pragma unroll
                for (int j = 0; j < 4; ++j) o[n * 4 + j] = silu(acc[ai][0][m][n][j] * rs) * (acc[ai][1][m][n][j] * rs);
            u32x4 pk; pk[0] = pk2(o[0], o[1]); pk[1] = pk2(o[2], o[3]); pk[2] = pk2(o[4], o[5]); pk[3] = pk2(o[6], o[7]);
            *(u32x4*)(E.O + (row0 + ai * HALF + m * 16) * 2816 + col0) = pk;
        }
}
#define RESID_LOAD(ai, rv) _Pragma("unroll") for (int m = 0; m < 4; ++m) _Pragma("unroll") for (int bj = 0; bj < 2; ++bj) rv[m][bj] = *(const u32x4*)(E.resb + (row0 + (ai) * HALF + m * 16) * 1024 + col0 + bj * HALF)
#define RESID_COMP(ai, rv, pk) _Pragma("unroll") for (int m = 0; m < 4; ++m) { float sl = 0.f; _Pragma("unroll") for (int bj = 0; bj < 2; ++bj) { \
        float rf[8]; UNPACK8(rv[m][bj], rf); float v[8]; \
        _Pragma("unroll") for (int j = 0; j < 4; ++j) { v[j] = rf[j] + acc[ai][bj][m][0][j] * E.scale; v[4 + j] = rf[4 + j] + acc[ai][bj][m][1][j] * E.scale; } \
        _Pragma("unroll") for (int j = 0; j < 8; ++j) sl += v[j] * v[j]; \
        pk[m][bj][0] = pk2(v[0], v[1]); pk[m][bj][1] = pk2(v[2], v[3]); pk[m][bj][2] = pk2(v[4], v[5]); pk[m][bj][3] = pk2(v[6], v[7]); } ssl[ai][m] = sl; }
#define RESID_STORE(ai, pk) _Pragma("unroll") for (int m = 0; m < 4; ++m) _Pragma("unroll") for (int bj = 0; bj < 2; ++bj) *(u32x4*)(E.O + (row0 + (ai) * HALF + m * 16) * 1024 + col0 + bj * HALF) = pk[m][bj]
__device__ __forceinline__ void epi_resid(const Epi& E, AccT& acc, const Unit& u, int wr, int wc, int fr, int fq) {
    const long row0 = (long)u.z * E.rowZ + (long)u.pm * BM + wr * 64 + fr; const int col0 = u.pn * BM + wc * 32 + 8 * fq;
    float ssl[2][4];
    u32x4 rvA[4][2], pkA[4][2];
    RESID_LOAD(0, rvA);
    asm volatile("" ::: "memory");
    RESID_COMP(0, rvA, pkA);
    u32x4 rvB[4][2];
    RESID_LOAD(1, rvB);
    asm volatile("" ::: "memory");
    RESID_STORE(0, pkA);
    asm volatile("" ::: "memory");
    u32x4 pkB[4][2];
    RESID_COMP(1, rvB, pkB);
    RESID_STORE(1, pkB);
#pragma unroll
    for (int ai = 0; ai < 2; ++ai)
#pragma unroll
        for (int m = 0; m < 4; ++m) {
            float sl = ssl[ai][m];
            sl += __shfl_xor(sl, 16); sl += __shfl_xor(sl, 32);
            if (fq == 0) E.ss_out[(row0 + ai * HALF + m * 16) * 16 + u.pn * 4 + wc] = sl;
        }
}
#undef RESID_LOAD
#undef RESID_COMP
#undef RESID_STORE
__device__ __forceinline__ void epi_bf16(const Epi& E, AccT& acc, const Unit& u, int wr, int wc, int fr, int fq, const LAS float* rst) {
    const long z1 = u.z >> E.zshift, z2 = u.z & ((1 << E.zshift) - 1);
    bf16_t* base = E.O + z1 * E.oZ1 + z2 * E.oZ2;
    const long row0 = (long)u.pm * BM + wr * 64 + fr; const int col0 = u.pn * BM + wc * 32 + 8 * fq;
    const long ldo = E.ldo;
#pragma unroll
    for (int ai = 0; ai < 2; ++ai)
#pragma unroll
        for (int m = 0; m < 4; ++m) {
            float scale = E.scale;
            if (E.ss_in != nullptr) scale *= rst[ai * 128 + wr * 64 + m * 16 + fr];
#pragma unroll
            for (int bj = 0; bj < 2; ++bj) {
                const f32x4 a0 = acc[ai][bj][m][0] * scale, a1 = acc[ai][bj][m][1] * scale;
                u32x4 pk; pk[0] = pk2(a0[0], a0[1]); pk[1] = pk2(a0[2], a0[3]); pk[2] = pk2(a1[0], a1[1]); pk[3] = pk2(a1[2], a1[3]);
                *(u32x4*)(base + (row0 + ai * HALF + m * 16) * ldo + col0 + bj * HALF) = pk;
            }
        }
}
__device__ __forceinline__ void epi_softmax(const Epi& E, AccT& acc, const Unit& u, int wr, int wc, int fr, int fq, const LAS float* rst) {
    bf16_t* base = E.O + (long)u.z * E.rowZ * 1024 + u.pn * 256;
    const long row0 = (long)u.pm * BM + wr * 64 + fr; const int col0 = wc * 32 + 8 * fq;
    LAS float* tab = E.tab; LAS float* tab2 = tab + 1024;
#pragma unroll
    for (int ai = 0; ai < 2; ++ai)
#pragma unroll
        for (int m = 0; m < 4; ++m) {
            const float rs = rst[ai * 128 + wr * 64 + m * 16 + fr];
            float v = -3.0e38f;
#pragma unroll
            for (int bj = 0; bj < 2; ++bj)
#pragma unroll
                for (int n = 0; n < 2; ++n)
#pragma unroll
                    for (int j = 0; j < 4; ++j) { acc[ai][bj][m][n][j] *= rs; v = fmaxf(v, acc[ai][bj][m][n][j]); }
            v = fmaxf(v, __shfl_xor(v, 16)); v = fmaxf(v, __shfl_xor(v, 32));
            if (fq == 0) tab[(ai * 128 + wr * 64 + m * 16 + fr) * 4 + wc] = v;
        }
    asm volatile("s_waitcnt lgkmcnt(0)" ::: "memory"); __builtin_amdgcn_s_barrier(); asm volatile("" ::: "memory");
#pragma unroll
    for (int ai = 0; ai < 2; ++ai)
#pragma unroll
        for (int m = 0; m < 4; ++m) {
            const int rl = ai * 128 + wr * 64 + m * 16 + fr;
            const f32x4 t4 = *(const LAS f32x4*)(tab + rl * 4);
            const float M = fmaxf(fmaxf(t4[0], t4[1]), fmaxf(t4[2], t4[3]));
            float sm = 0.f;
#pragma unroll
            for (int bj = 0; bj < 2; ++bj)
#pragma unroll
                for (int n = 0; n < 2; ++n)
#pragma unroll
                    for (int j = 0; j < 4; ++j) { const float e = __expf(acc[ai][bj][m][n][j] - M); acc[ai][bj][m][n][j] = e; sm += e; }
            sm += __shfl_xor(sm, 16); sm += __shfl_xor(sm, 32);
            if (fq == 0) tab2[rl * 4 + wc] = sm;
        }
    asm volatile("s_waitcnt lgkmcnt(0)" ::: "memory"); __builtin_amdgcn_s_barrier(); asm volatile("" ::: "memory");
#pragma unroll
    for (int ai = 0; ai < 2; ++ai)
#pragma unroll
        for (int m = 0; m < 4; ++m) {
            const int rl = ai * 128 + wr * 64 + m * 16 + fr;
            const f32x4 t4 = *(const LAS f32x4*)(tab2 + rl * 4);
            const float inv = 1.0f / (t4[0] + t4[1] + t4[2] + t4[3]);
#pragma unroll
            for (int bj = 0; bj < 2; ++bj) {
                const f32x4 a0 = acc[ai][bj][m][0] * inv, a1 = acc[ai][bj][m][1] * inv;
                u32x4 pk; pk[0] = pk2(a0[0], a0[1]); pk[1] = pk2(a0[2], a0[3]); pk[2] = pk2(a1[0], a1[1]); pk[3] = pk2(a1[2], a1[3]);
                *(u32x4*)(base + (row0 + ai * HALF + m * 16) * 1024 + col0 + bj * HALF) = pk;
            }
        }
}

template <int MODE>
__device__ __forceinline__ void gemm_phase(LAS unsigned char* lds, const GJob& g, const Epi& E, int G, int c) {
    const int tid = ltid();
    const int wid = __builtin_amdgcn_readfirstlane(tid >> 6), lane = tid & 63, wr = wid >> 2, wc = wid & 3, fr = lane & 15, fq = lane >> 4;
    const int K = g.K, nt = K / BK;
    unsigned voffA[2], voffB[2];
#pragma unroll
    for (int i = 0; i < 2; ++i) { int R, C; stage_rc(tid * 16 + i * 8192, R, C); const int Rb = (R & ~31) + perm32(R & 31);
        voffA[i] = (unsigned)(R * g.lda + C) * 2u; voffB[i] = (unsigned)(Rb * g.ldb + C) * 2u; }
    const size_t kstep = (size_t)(BK * 2);
    const size_t hstepA = (size_t)HALF * g.lda * 2, hstepB = (size_t)HALF * g.ldb * 2;
    const unsigned ldsw = (unsigned)wid * 1024u;
    const int aoff = lds_byte(wr * 64 + fr, fq * 8), boff = lds_byte(wc * 32 + fr, fq * 8);
#define PG8_SA(b, h) (((b) * 2 + (h)) * HTB)
#define PG8_SB(b, h) ((4 + (b) * 2 + (h)) * HTB)
#define PG8_STAGE(bufoff, gbase, voff) do { _Pragma("unroll") for (int _i = 0; _i < 2; ++_i) \
        __builtin_amdgcn_global_load_lds((const unsigned*)((const char*)(gbase) + (voff)[_i]), (LAS unsigned*)(lds + (bufoff) + ldsw + _i * 8192), 16, 0, 0); } while (0)
#define PG8_LDA(dst, b, h) do { _Pragma("unroll") for (int m = 0; m < 4; ++m) _Pragma("unroll") for (int k = 0; k < 2; ++k) dst[m][k] = *(const LAS bf16x8*)(lds + PG8_SA(b, h) + aoff + m * 2048 + k * 1024); } while (0)
#define PG8_LDB(dst, b, h) do { _Pragma("unroll") for (int n = 0; n < 2; ++n) _Pragma("unroll") for (int k = 0; k < 2; ++k) dst[n][k] = *(const LAS bf16x8*)(lds + PG8_SB(b, h) + boff + n * 2048 + k * 1024); } while (0)
#define PG8_MMA(ai, bj, At, Bt) do { __builtin_amdgcn_s_setprio(1); _Pragma("unroll") for (int m = 0; m < 4; ++m) _Pragma("unroll") for (int n = 0; n < 2; ++n) _Pragma("unroll") for (int k = 0; k < 2; ++k) \
        acc[ai][bj][m][n] = __builtin_amdgcn_mfma_f32_16x16x32_bf16(Bt[n][k], At[m][k], acc[ai][bj][m][n], 0, 0, 0); __builtin_amdgcn_s_setprio(0); } while (0)
#define PG8_WAIT_V(n) asm volatile("s_waitcnt vmcnt(" #n ")" ::: "memory")
#define PG8_WAIT_L(n) asm volatile("s_waitcnt lgkmcnt(" #n ")" ::: "memory")
#define PG8_BAR __builtin_amdgcn_s_barrier()
#define PG8_SCHED __builtin_amdgcn_sched_barrier(0)
    Unit cur, nxt; int ui = 0;
    LAS float* rstab = (LAS float*)(lds + 139264);
    if ((MODE == 0 || MODE == 2 || MODE == 3) && E.ss_in != nullptr) {
        for (int u0 = 0; u0 < 16; u0 += 2) {
            Unit uu; const int uidx = u0 + (tid >> 8);
            if (g_next(g, uidx, G, c, uu)) rstab[uidx * 256 + (tid & 255)] = row_rstd(E.ss_in, (long)(uu.z >> g.zshift) * g.rowZ + (long)uu.pm * BM + (tid & 255));
        }
        __syncthreads();
    }
    if (!g_next(g, 0, G, c, cur)) return;
    AccT acc;
#pragma unroll
    for (int a = 0; a < 2; ++a)
#pragma unroll
        for (int b = 0; b < 2; ++b)
#pragma unroll
            for (int m = 0; m < 4; ++m)
#pragma unroll
                for (int n = 0; n < 2; ++n) acc[a][b][m][n] = (f32x4){0.f, 0.f, 0.f, 0.f};
    bf16x8 At[4][2], B0[2][2], B1[2][2];
    const char* cA = g_aptr(g, cur); const char* cB = g_bptr(g, cur);
    PG8_STAGE(PG8_SB(0, 0), cB, voffB); PG8_STAGE(PG8_SA(0, 0), cA, voffA); PG8_STAGE(PG8_SB(0, 1), cB + hstepB, voffB); PG8_STAGE(PG8_SA(0, 1), cA + hstepA, voffA);
    if (wr == 1) PG8_BAR;
    PG8_WAIT_V(4); PG8_BAR;
    PG8_STAGE(PG8_SB(1, 0), cB + kstep, voffB); PG8_STAGE(PG8_SA(1, 0), cA + kstep, voffA); PG8_STAGE(PG8_SB(1, 1), cB + hstepB + kstep, voffB);
    PG8_WAIT_V(6); PG8_BAR;
    for (;;) {
        const bool has_next = g_next(g, ui + 1, G, c, nxt);
        const char* nA = has_next ? g_aptr(g, nxt) : cA; const char* nB = has_next ? g_bptr(g, nxt) : cB;
        for (int t = 0; t < nt; t += 2) {
            const bool last = (t == nt - 2);
            const char* a1 = cA + (size_t)(t + 1) * kstep;
            const char* a2 = last ? nA : cA + (size_t)(t + 2) * kstep; const char* b2 = last ? nB : cB + (size_t)(t + 2) * kstep;
            const char* a3 = a2 + kstep; const char* b3 = b2 + kstep;
            PG8_LDB(B0, 0, 0); PG8_SCHED; PG8_LDA(At, 0, 0); PG8_STAGE(PG8_SA(1, 1), a1 + hstepA, voffA);
            PG8_WAIT_L(8); PG8_BAR; PG8_WAIT_L(0); PG8_MMA(0, 0, At, B0); PG8_BAR; PG8_SCHED;
            PG8_LDB(B1, 0, 1); PG8_STAGE(PG8_SB(0, 0), b2, voffB);
            PG8_BAR; PG8_WAIT_L(0); PG8_MMA(0, 1, At, B1); PG8_BAR;
            PG8_LDA(At, 0, 1); PG8_STAGE(PG8_SA(0, 0), a2, voffA);
            PG8_BAR; PG8_WAIT_L(0); PG8_MMA(1, 0, At, B0); PG8_BAR; PG8_SCHED;
            PG8_STAGE(PG8_SB(0, 1), b2 + hstepB, voffB);
            PG8_WAIT_V(6); PG8_BAR; PG8_MMA(1, 1, At, B1); PG8_BAR;
            PG8_LDB(B0, 1, 0); PG8_SCHED; PG8_LDA(At, 1, 0); PG8_STAGE(PG8_SA(0, 1), a2 + hstepA, voffA);
            PG8_WAIT_L(8); PG8_BAR; PG8_WAIT_L(0); PG8_MMA(0, 0, At, B0); PG8_BAR; PG8_SCHED;
            PG8_LDB(B1, 1, 1); PG8_STAGE(PG8_SB(1, 0), b3, voffB);
            PG8_BAR; PG8_WAIT_L(0); PG8_MMA(0, 1, At, B1); PG8_BAR;
            PG8_LDA(At, 1, 1); PG8_STAGE(PG8_SA(1, 0), a3, voffA);
            PG8_BAR; PG8_WAIT_L(0); PG8_MMA(1, 0, At, B0); PG8_BAR; PG8_SCHED;
            PG8_STAGE(PG8_SB(1, 1), b3 + hstepB, voffB);
            PG8_WAIT_V(6); PG8_BAR; PG8_MMA(1, 1, At, B1); PG8_BAR;
        }
        if (MODE == 0) epi_swiglu(E, acc, cur, wr, wc, fr, fq, rstab + ui * 256); else if (MODE == 1) epi_resid(E, acc, cur, wr, wc, fr, fq);
        else if (MODE == 2) epi_bf16(E, acc, cur, wr, wc, fr, fq, rstab + ui * 256); else epi_softmax(E, acc, cur, wr, wc, fr, fq, rstab + ui * 256);
        if (!has_next) break;
#pragma unroll
        for (int a = 0; a < 2; ++a)
#pragma unroll
            for (int b = 0; b < 2; ++b)
#pragma unroll
                for (int m = 0; m < 4; ++m)
#pragma unroll
                    for (int n = 0; n < 2; ++n) acc[a][b][m][n] = (f32x4){0.f, 0.f, 0.f, 0.f};
        cur = nxt; cA = nA; cB = nB; ++ui;
    }
    PG8_WAIT_V(0);
    if (wr == 0) PG8_BAR;
    PG8_BAR;
#undef PG8_SA
#undef PG8_SB
#undef PG8_STAGE
#undef PG8_LDA
#undef PG8_LDB
#undef PG8_MMA
#undef PG8_WAIT_V
#undef PG8_WAIT_L
#undef PG8_BAR
#undef PG8_SCHED
}

__device__ __forceinline__ void phase_convert(int l, LAS unsigned char* lds, int t_lo, int t_hi) {
    LAS float* tl = (LAS float*)lds;
    const int tid = ltid();
    const long FW = 1024l * 2816;
    for (int tile = t_lo + blockIdx.x; tile < t_hi; tile += gridDim.x) {
        const float* src = nullptr; bf16_t* dst = nullptr; const float* gk = nullptr;
        int K = 64, N = 64, Gd = 64, rs = 0, roff = 0, local = 0;
        unsigned char* ws = WSP;
#define JOB(T0, NT, SRC, KK, NN, DST, GG, RS, RO, GK) if (tile >= (T0) && tile < (T0) + (NT)) { src = (SRC); K = (KK); N = (NN); dst = (bf16_t*)(DST); Gd = (GG); rs = (RS); roff = (RO); gk = (GK); local = tile - (T0); }
        JOB(0, 704, PIN(4) + l * FW, 1024, 2816, ws + WB_UP1, 128, 256, 0, PIN(3) + l * 1024)
        else JOB(704, 704, PIN(5) + l * FW, 1024, 2816, ws + WB_UP1, 128, 256, 128, PIN(3) + l * 1024)
        else JOB(1408, 704, PIN(6) + l * FW, 2816, 1024, ws + WB_DN1, 1024, 0, 0, nullptr)
        else JOB(2112, 960, PIN(8) + l * 1024l * 3840, 1024, 3840, ws + WB_IN, 3840, 0, 0, PIN(7) + l * 1024)
        else JOB(3072, 256, PIN(19) + l * 1024l * 1024, 1024, 1024, ws + WB_OUT, 1024, 0, 0, nullptr)
        else if (tile >= 3328 && tile < 3584) { continue; }
        else JOB(3584, 512, PIN(23) + l * 1024l * 2048, 1024, 2048, ws + WB_KV, 2048, 0, 0, nullptr)
        else JOB(4096, 256, PIN(24) + l * 1024l * 1024, 1024, 1024, ws + WB_O, 1024, 0, 0, nullptr)
        else JOB(4352, 704, PIN(26) + l * FW, 1024, 2816, ws + WB_UP2, 128, 256, 0, PIN(25) + l * 1024)
        else JOB(5056, 704, PIN(27) + l * FW, 1024, 2816, ws + WB_UP2, 128, 256, 128, PIN(25) + l * 1024)
        else JOB(5760, 704, PIN(28) + l * FW, 2816, 1024, ws + WB_DN2, 1024, 0, 0, nullptr)
        else if (tile < 6468) { const int nb = tile - 6464; src = PIN(14) + l * 16384 + nb * 4096; dst = (bf16_t*)(ws + WB_WA + nb * 8192); }
        else { const int nb = tile - 6468; src = PIN(16) + l * 16384 + nb * 4096; dst = (bf16_t*)(ws + WB_WX + nb * 8192); }
#undef JOB
        const int ntn = N / 64, k0 = (local / ntn) * 64, n0 = (local % ntn) * 64;
#pragma unroll
        for (int i = 0; i < 2; ++i) {
            const int idx = tid + i * 512, row = idx >> 4, c4 = idx & 15;
            f32x4 v = *(const f32x4*)(src + (long)(k0 + row) * N + n0 + c4 * 4);
            if (gk != nullptr) v = v * gk[k0 + row];
            tl[(c4 * 4 + 0) * 65 + row] = v[0]; tl[(c4 * 4 + 1) * 65 + row] = v[1]; tl[(c4 * 4 + 2) * 65 + row] = v[2]; tl[(c4 * 4 + 3) * 65 + row] = v[3];
        }
        __syncthreads();
        {
            const int n = tid >> 3, kk = (tid & 7) * 8, nn = n0 + n;
            const int drow = (nn / Gd) * rs + roff + (nn % Gd);
            u32x4 pk;
#pragma unroll
            for (int q = 0; q < 4; ++q) pk[q] = pk2(tl[n * 65 + kk + 2 * q], tl[n * 65 + kk + 2 * q + 1]);
            *(u32x4*)(dst + (long)drow * K + k0 + kk) = pk;
        }
        __syncthreads();
    }
}

__device__ __forceinline__ void phase_convert_straight(const float* src, const float* gk, bf16_t* dst) {
    const long gt = (long)blockIdx.x * NTHREADS + ltid();
    for (long v = gt; v < 131072; v += (long)gridDim.x * NTHREADS) {
        const int k = (int)(v >> 7);
        const f32x4 a = *(const f32x4*)(src + v * 8), b = *(const f32x4*)(src + v * 8 + 4);
        const float gg = gk[k];
        u32x4 pk; pk[0] = pk2(a[0] * gg, a[1] * gg); pk[1] = pk2(a[2] * gg, a[3] * gg); pk[2] = pk2(b[0] * gg, b[1] * gg); pk[3] = pk2(b[2] * gg, b[3] * gg);
        *(u32x4*)(dst + v * 8) = pk;
    }
}

__device__ __forceinline__ void phase_rope_table(const int* pos, float* cs, float* sn) {
    const long gt = (long)blockIdx.x * NTHREADS + ltid();
    for (long p = gt; p < 32768l * 48; p += (long)gridDim.x * NTHREADS) {
        const int t = (int)(p / 48), i = (int)(p % 48);
        const float inv_freq = __expf(-9.210340371976184f * (float)i * (1.0f / 48.0f));
        const float ang = (float)pos[t] * inv_freq;
        const float k = rintf(ang * 0.15915494309189535f);
        float r = fmaf(-k, 6.28125f, ang); r = fmaf(-k, 1.9353071795864769e-3f, r);
        cs[p] = __cosf(r); sn[p] = __sinf(r);
    }
}

__device__ __forceinline__ void phase_norm(const float* src, const float* g, bf16_t* dst, int nrows) {
    const int tid_ = ltid(); const int lane = tid_ & 63, gw = blockIdx.x * 8 + (tid_ >> 6), nw = gridDim.x * 8;
    for (int row = gw; row < nrows; row += nw) {
        const f32x4* pr = (const f32x4*)(src + (long)row * 1024);
        f32x4 v[4]; float ss = 0.f;
#pragma unroll
        for (int i = 0; i < 4; ++i) { v[i] = pr[lane + 64 * i]; ss += v[i][0] * v[i][0] + v[i][1] * v[i][1] + v[i][2] * v[i][2] + v[i][3] * v[i][3]; }
#pragma unroll
        for (int m = 32; m >= 1; m >>= 1) ss += __shfl_xor(ss, m);
        const float rstd = rsqrtf(ss * (1.0f / 1024.0f) + 1e-6f);
#pragma unroll
        for (int i = 0; i < 4; ++i) {
            const f32x4 gg = ((const f32x4*)g)[lane + 64 * i];
            u32x2 pk; pk[0] = pk2(v[i][0] * rstd * gg[0], v[i][1] * rstd * gg[1]); pk[1] = pk2(v[i][2] * rstd * gg[2], v[i][3] * rstd * gg[3]);
            *(u32x2*)(dst + (long)row * 1024 + (lane + 64 * i) * 4) = pk;
        }
    }
}
__device__ __forceinline__ void phase_prep(const float* src, bf16_t* dst, float* ss_out, int nrows) {
    const int tid_ = ltid(); const int lane = tid_ & 63, gw = blockIdx.x * 8 + (tid_ >> 6), nw = gridDim.x * 8;
    for (int row = gw; row < nrows; row += nw) {
        const f32x4* pr = (const f32x4*)(src + (long)row * 1024);
        f32x4 v[4]; float ss = 0.f;
#pragma unroll
        for (int i = 0; i < 4; ++i) { v[i] = pr[lane + 64 * i]; ss += v[i][0] * v[i][0] + v[i][1] * v[i][1] + v[i][2] * v[i][2] + v[i][3] * v[i][3]; }
#pragma unroll
        for (int m = 32; m >= 1; m >>= 1) ss += __shfl_xor(ss, m);
        if (lane < 16) ss_out[(long)row * 16 + lane] = (lane == 0) ? ss : 0.f;
#pragma unroll
        for (int i = 0; i < 4; ++i) { u32x2 pk; pk[0] = pk2(v[i][0], v[i][1]); pk[1] = pk2(v[i][2], v[i][3]); *(u32x2*)(dst + (long)row * 1024 + (lane + 64 * i) * 4) = pk; }
    }
}
__device__ __forceinline__ void phase_final_norm(const bf16_t* xb, float* out, const float* g, int nrows) {
    const int tid_ = ltid(); const int lane = tid_ & 63, gw = blockIdx.x * 8 + (tid_ >> 6), nw = gridDim.x * 8;
    for (int row = gw; row < nrows; row += nw) {
        float v[16]; float ss = 0.f;
#pragma unroll
        for (int i = 0; i < 2; ++i) {
            const u32x4 rv = *(const u32x4*)(xb + (long)row * 1024 + (lane + 64 * i) * 8);
#pragma unroll
            for (int q = 0; q < 4; ++q) { v[i * 8 + 2 * q] = lo16(rv[q]); v[i * 8 + 2 * q + 1] = hi16(rv[q]); }
        }
#pragma unroll
        for (int j = 0; j < 16; ++j) ss += v[j] * v[j];
#pragma unroll
        for (int m = 32; m >= 1; m >>= 1) ss += __shfl_xor(ss, m);
        const float rstd = rsqrtf(ss * (1.0f / 1024.0f) + 1e-6f);
#pragma unroll
        for (int i = 0; i < 2; ++i) {
            const f32x4 g0 = *(const f32x4*)(g + (lane + 64 * i) * 8), g1 = *(const f32x4*)(g + (lane + 64 * i) * 8 + 4);
            f32x4 o0, o1;
#pragma unroll
            for (int j = 0; j < 4; ++j) { o0[j] = v[i * 8 + j] * rstd * g0[j]; o1[j] = v[i * 8 + 4 + j] * rstd * g1[j]; }
            *(f32x4*)(out + (long)row * 1024 + (lane + 64 * i) * 8) = o0; *(f32x4*)(out + (long)row * 1024 + (lane + 64 * i) * 8 + 4) = o1;
        }
    }
}

__device__ __forceinline__ void lds_barrier() { asm volatile("s_waitcnt lgkmcnt(0)" ::: "memory"); __builtin_amdgcn_s_barrier(); asm volatile("" ::: "memory"); }
struct MixCtx {
    LAS unsigned char* lds;
    const bf16_t* proj;
    bf16_t* mix;
    bf16_t* sth; bf16_t* str; float* lasth;
    bf16_t* lrup; bf16_t* lruh; float* lrupe; float* lruhe; float* lruci;
    const bf16_t* waT; const bf16_t* wxT;
    const int* pos; const float* rcs; const float* rsn;
    const float* ret_gn_g; const float* hg_lb; const float* hg_norm_g;
    const float* conv_w; const float* conv_b; const float* ba; const float* bx; const float* lam;
    int l;
};

template <bool M3>
__device__ __forceinline__ void hg_unit(const MixCtx& c, int unit) {
    LAS unsigned char* lds = c.lds;
    const int tid = ltid(), wid = tid >> 6, lane = tid & 63;
    const int h = unit & 3; const long row0 = (long)(unit >> 2) * 64;
    LAS float* cum = (LAS float*)lds;
    LAS bf16_t* inpT = (LAS bf16_t*)(lds + (M3 ? 102400 : 51200));
    float kk[2][8], qq[2][8];
    u32x4 stv[3]; unsigned gwv[6];
    if (M3) {
#pragma unroll
        for (int i = 0; i < 3; ++i) { const int v = tid + 512 * i; stv[i] = *(const u32x4*)(c.sth + (long)unit * 12288 + (v >> 4) * 128 + (v & 15) * 8); }
        const bf16_t* gp = c.proj + (row0 + (tid >> 3)) * 3840 + 2944 + h * 96 + (tid & 7) * 12;
#pragma unroll
        for (int j = 0; j < 6; ++j) gwv[j] = *(const unsigned*)(gp + 2 * j);
    }
#pragma unroll
    for (int i = 0; i < 2; ++i) {
        const int e8 = tid + 512 * i, t = e8 >> 4, d0 = (e8 & 15) * 8;
        const bf16_t* pr = c.proj + (row0 + t) * 3840;
        const u32x4 vf = *(const u32x4*)(pr + 2048 + h * 128 + d0);
        float xf[8]; UNPACK8(vf, xf);
        float lbv[8];
        if (c.l == 0) {
#pragma unroll
            for (int j = 0; j < 8; ++j) lbv[j] = 0.f;
        } else {
            const f32x4 p0a = *(const f32x4*)(c.hg_lb + h * 128 + d0), p0b = *(const f32x4*)(c.hg_lb + h * 128 + d0 + 4);
            const f32x4 p1a = *(const f32x4*)(c.hg_lb + 512 + h * 128 + d0), p1b = *(const f32x4*)(c.hg_lb + 512 + h * 128 + d0 + 4);
#pragma unroll
            for (int j = 0; j < 4; ++j) { lbv[j] = 1.0f / (1.0f + __expf(p0a[j] - p1a[j])); lbv[4 + j] = 1.0f / (1.0f + __expf(p0b[j] - p1b[j])); }
        }
#pragma unroll
        for (int j = 0; j < 8; ++j) {
            const float s = 1.0f / (1.0f + __expf(-xf[j]));
            const float f = lbv[j] + (1.0f - lbv[j]) * s;
            kk[i][j] = 1.0f - f;
            cum[t * 128 + d0 + j] = __logf(f);
        }
        if (M3) {
            const u32x4 vq = *(const u32x4*)(pr + 1536 + h * 128 + d0);
            float xq[8]; UNPACK8(vq, xq);
#pragma unroll
            for (int j = 0; j < 8; ++j) qq[i][j] = silu(xq[j]);
        }
    }
    for (int v = tid; v < 768; v += 512) {
        const int t = v & 63, e0 = (v >> 6) * 8;
        const u32x4 vi = *(const u32x4*)(c.proj + (row0 + t) * 3840 + 2560 + h * 96 + e0);
#pragma unroll
        for (int j = 0; j < 4; ++j) { inpT[(e0 + 2 * j) * 72 + t] = (bf16_t)(vi[j] & 0xffffu); inpT[(e0 + 2 * j + 1) * 72 + t] = (bf16_t)(vi[j] >> 16); }
    }
    lds_barrier();
    {
        LAS float* ptot = (LAS float*)(lds + 152064);
        const int d = tid & 127, part = tid >> 7;
        float v[16]; float run = 0.f;
#pragma unroll
        for (int t = 0; t < 16; ++t) { v[t] = cum[(part * 16 + t) * 128 + d]; run += v[t]; }
        ptot[part * 128 + d] = run;
        lds_barrier();
        float base = 0.f;
#pragma unroll
        for (int pp = 0; pp < 3; ++pp) base += (pp < part) ? ptot[pp * 128 + d] : 0.f;
#pragma unroll
        for (int t = 0; t < 16; ++t) { base += v[t]; cum[(part * 16 + t) * 128 + d] = base; }
    }
    lds_barrier();
    if (!M3) {
        LAS bf16_t* KlT = (LAS bf16_t*)(lds + 32768);
        LAS float* Eb = (LAS float*)(lds + 65536);
        LAS bf16_t* kvs = (LAS bf16_t*)(lds + 99328);
#pragma unroll
        for (int i = 0; i < 2; ++i) {
            const int e8 = tid + 512 * i, t = e8 >> 4, d0 = (e8 & 15) * 8;
#pragma unroll
            for (int j = 0; j < 8; ++j) { const int d = d0 + j; Eb[t * 129 + d] = kk[i][j] * __expf(cum[63 * 128 + d] - cum[t * 128 + d]); }
        }
        if (tid < 128) c.lasth[(long)unit * 128 + tid] = cum[63 * 128 + tid];
        lds_barrier();
#pragma unroll
        for (int i = 0; i < 2; ++i) {
            const int v = tid + 512 * i, d = v & 127, t0 = (v >> 7) * 8;
            u32x4 pk;
#pragma unroll
            for (int q2 = 0; q2 < 4; ++q2) pk[q2] = pk2(Eb[(t0 + 2 * q2) * 129 + d], Eb[(t0 + 2 * q2 + 1) * 129 + d]);
            *(LAS u32x4*)(KlT + d * 72 + t0) = pk;
        }
        lds_barrier();
        const int r = lane & 15, q = lane >> 4;
        for (int i = 0; i < 6; ++i) {
            const int idx = wid + 8 * i, et = idx >> 3, dt = idx & 7;
            f32x4 acc = (f32x4){0.f, 0.f, 0.f, 0.f};
            acc = mma16(inpT + et * 16 * 72, 72, KlT + dt * 16 * 72, 72, 64, acc, lane);
#pragma unroll
            for (int j = 0; j < 4; ++j) kvs[(et * 16 + q * 4 + j) * 136 + dt * 16 + r] = f2bf(acc[j]);
        }
        lds_barrier();
#pragma unroll
        for (int i = 0; i < 3; ++i) {
            const int v = tid + 512 * i, e = v >> 4, d0 = (v & 15) * 8;
            *(u32x4*)(c.sth + (long)unit * 12288 + e * 128 + d0) = *(const LAS u32x4*)(kvs + e * 136 + d0);
        }
        lds_barrier();
    } else {
        LAS bf16_t* Qp = (LAS bf16_t*)(lds + 32768); LAS bf16_t* Qm = (LAS bf16_t*)(lds + 50176);
        LAS bf16_t* Kp = (LAS bf16_t*)(lds + 67584); LAS bf16_t* Km = (LAS bf16_t*)(lds + 84992);
        LAS bf16_t* stT = (LAS bf16_t*)(lds + 116224); LAS bf16_t* S = (LAS bf16_t*)(lds + 142336);
        LAS float* O = (LAS float*)lds;
#pragma unroll
        for (int i = 0; i < 2; ++i) {
            const int e8 = tid + 512 * i, t = e8 >> 4, d0 = (e8 & 15) * 8;
            float qp[8], qm[8], kp[8], km[8];
#pragma unroll
            for (int j = 0; j < 8; ++j) {
                const float cref = cum[31 * 128 + d0 + j], cc = cum[t * 128 + d0 + j];
                const float ep = __expf(cc - cref), em = __expf(cref - cc);
                qp[j] = qq[i][j] * ep; qm[j] = qq[i][j] * em; kp[j] = kk[i][j] * ep; km[j] = kk[i][j] * em;
            }
            u32x4 a, b, cc4, d;
#pragma unroll
            for (int j = 0; j < 4; ++j) { a[j] = pk2(qp[2 * j], qp[2 * j + 1]); b[j] = pk2(qm[2 * j], qm[2 * j + 1]); cc4[j] = pk2(kp[2 * j], kp[2 * j + 1]); d[j] = pk2(km[2 * j], km[2 * j + 1]); }
            *(LAS u32x4*)(Qp + t * 136 + d0) = a; *(LAS u32x4*)(Qm + t * 136 + d0) = b; *(LAS u32x4*)(Kp + t * 136 + d0) = cc4; *(LAS u32x4*)(Km + t * 136 + d0) = d;
        }
#pragma unroll
        for (int i = 0; i < 3; ++i) {
            const int v = tid + 512 * i, e = v >> 4, d0 = (v & 15) * 8;
            const u32x4 s = stv[i];
            float sf[8]; UNPACK8(s, sf);
            u32x4 o;
#pragma unroll
            for (int j = 0; j < 4; ++j) o[j] = pk2(sf[2 * j] * __expf(cum[31 * 128 + d0 + 2 * j]), sf[2 * j + 1] * __expf(cum[31 * 128 + d0 + 2 * j + 1]));
            *(LAS u32x4*)(stT + e * 136 + d0) = o;
        }
        lds_barrier();
        const int r = lane & 15, q = lane >> 4;
        for (int i = 0; i < 2; ++i) {
            const int idx = wid * 2 + i, ti = idx >> 2, tj = idx & 3;
            f32x4 s1 = (f32x4){0.f, 0.f, 0.f, 0.f}, s2 = (f32x4){0.f, 0.f, 0.f, 0.f};
            if (ti >= tj) s1 = mma16(Qp + ti * 16 * 136, 136, Km + tj * 16 * 136, 136, 128, s1, lane);
            if (ti <= tj) s2 = mma16(Qm + ti * 16 * 136, 136, Kp + tj * 16 * 136, 136, 128, s2, lane);
#pragma unroll
            for (int j = 0; j < 4; ++j) {
                const int t = ti * 16 + q * 4 + j, jj = tj * 16 + r;
                S[t * 72 + jj] = f2bf(t >= jj ? s1[j] : s2[j]);
            }
        }
        lds_barrier();
        for (int i = 0; i < 3; ++i) {
            const int idx = wid * 3 + i, tt = idx / 6, et = idx % 6;
            f32x4 acc = (f32x4){0.f, 0.f, 0.f, 0.f};
            acc = mma16(S + tt * 16 * 72, 72, inpT + et * 16 * 72, 72, 64, acc, lane);
            acc = mma16(Qp + tt * 16 * 136, 136, stT + et * 16 * 136, 136, 128, acc, lane);
#pragma unroll
            for (int j = 0; j < 4; ++j) O[(tt * 16 + q * 4 + j) * 100 + et * 16 + r] = acc[j];
        }
        lds_barrier();
        {
            const int t = tid >> 3, sub = tid & 7;
            float o[12], ss = 0.f;
#pragma unroll
            for (int j = 0; j < 12; ++j) { o[j] = O[t * 100 + sub * 12 + j]; ss += o[j] * o[j]; }
            ss += __shfl_xor(ss, 1); ss += __shfl_xor(ss, 2); ss += __shfl_xor(ss, 4);
            const float rstd = rsqrtf(ss * (1.0f / 96.0f) + 1e-6f);
            bf16_t* op = c.mix + (row0 + t) * 1024 + 384 + h * 96 + sub * 12;
            const float* gg = c.hg_norm_g + h * 96 + sub * 12;
#pragma unroll
            for (int j = 0; j < 6; ++j) {
                const unsigned gw = gwv[j];
                const float y0 = o[2 * j] * rstd * gg[2 * j] * silu(lo16(gw)), y1 = o[2 * j + 1] * rstd * gg[2 * j + 1] * silu(hi16(gw));
                *(unsigned*)(op + 2 * j) = pk2(y0, y1);
            }
        }
        lds_barrier();
    }
}

__device__ __forceinline__ void rope_tables(const MixCtx& c, long row0, LAS float* cs, LAS float* sn) {
    for (int p = ltid(); p < 3072; p += 512) {
        const int t = p / 48, i = p % 48;
        const float inv_freq = __expf(-9.210340371976184f * (float)i * (1.0f / 48.0f));
        const float ang = (float)c.pos[row0 + t] * inv_freq;
        const float k = rintf(ang * 0.15915494309189535f);
        float r = fmaf(-k, 6.28125f, ang); r = fmaf(-k, 1.9353071795864769e-3f, r);
        cs[p] = __cosf(r); sn[p] = __sinf(r);
    }
}
template <bool M3>
__device__ __forceinline__ void ret_unit(const MixCtx& c, int unit) {
    LAS unsigned char* lds = c.lds;
    const int tid = ltid(), wid = tid >> 6, lane = tid & 63;
    const int h = unit & 3; const long row0 = (long)(unit >> 2) * 64;
    const float lg = log1pf(-exp2f(-5.0f - (float)h));
    LAS float* cs = (LAS float*)lds; LAS float* sn = (LAS float*)(lds + 12288);
    u32x4 stv[3]; unsigned gwv[6];
    if (M3) {
#pragma unroll
        for (int i = 0; i < 3; ++i) { const int v = tid + 512 * i; if (v < 1152) stv[i] = *(const u32x4*)(c.str + (long)unit * 9216 + (v / 12) * 96 + (v % 12) * 8); }
        const bf16_t* gp = c.proj + (row0 + (tid >> 3)) * 3840 + 1152 + h * 96 + (tid & 7) * 12;
#pragma unroll
        for (int j = 0; j < 6; ++j) gwv[j] = *(const unsigned*)(gp + 2 * j);
    }
    LAS bf16_t* vT = (LAS bf16_t*)(lds + 51200);
    for (int v = tid; v < 768; v += 512) {
        const int t = v & 63, e0 = (v >> 6) * 8;
        const u32x4 vi = *(const u32x4*)(c.proj + (row0 + t) * 3840 + 768 + h * 96 + e0);
#pragma unroll
        for (int j = 0; j < 4; ++j) { vT[(e0 + 2 * j) * 72 + t] = (bf16_t)(vi[j] & 0xffffu); vT[(e0 + 2 * j + 1) * 72 + t] = (bf16_t)(vi[j] >> 16); }
    }
    const int r = lane & 15, q = lane >> 4;
    if (!M3) {
        LAS bf16_t* KdT = (LAS bf16_t*)(lds + 24576);
        if (tid < 384) {
            const int j = tid & 63, i0 = (tid >> 6) * 8;
            const bf16_t* kp = c.proj + (row0 + j) * 3840 + 384 + h * 96;
            const u32x4 v1 = *(const u32x4*)(kp + i0), v2 = *(const u32x4*)(kp + 48 + i0);
            float k1[8], k2[8]; UNPACK8(v1, k1); UNPACK8(v2, k2);
            const float dec = __expf(lg * (float)(63 - j));
            const f32x4 c0 = *(const f32x4*)(c.rcs + (row0 + j) * 48 + i0), c1 = *(const f32x4*)(c.rcs + (row0 + j) * 48 + i0 + 4);
            const f32x4 s0 = *(const f32x4*)(c.rsn + (row0 + j) * 48 + i0), s1 = *(const f32x4*)(c.rsn + (row0 + j) * 48 + i0 + 4);
#pragma unroll
            for (int e = 0; e < 8; ++e) {
                const float co = (e < 4) ? c0[e & 3] : c1[e & 3], si = (e < 4) ? s0[e & 3] : s1[e & 3];
                KdT[(i0 + e) * 72 + j] = f2bf((k1[e] * co - k2[e] * si) * dec);
                KdT[(48 + i0 + e) * 72 + j] = f2bf((k1[e] * si + k2[e] * co) * dec);
            }
        }
        lds_barrier();
        LAS bf16_t* kvs = (LAS bf16_t*)(lds + 65536);
        for (int i = 0; i < 5; ++i) {
            const int idx = wid + 8 * i;
            if (idx < 36) {
                const int et = idx / 6, dt = idx % 6;
                f32x4 acc = (f32x4){0.f, 0.f, 0.f, 0.f};
                acc = mma16(vT + et * 16 * 72, 72, KdT + dt * 16 * 72, 72, 64, acc, lane);
#pragma unroll
                for (int j = 0; j < 4; ++j) kvs[(et * 16 + q * 4 + j) * 104 + dt * 16 + r] = f2bf(acc[j]);
            }
        }
        lds_barrier();
#pragma unroll
        for (int i = 0; i < 3; ++i) { const int v = tid + 512 * i; if (v < 1152) *(u32x4*)(c.str + (long)unit * 9216 + (v / 12) * 96 + (v % 12) * 8) = *(const LAS u32x4*)(kvs + (v / 12) * 104 + (v % 12) * 8); }
        lds_barrier();
    } else {
        LAS bf16_t* Qr = (LAS bf16_t*)(lds + 24576); LAS bf16_t* Kr = (LAS bf16_t*)(lds + 37888);
        LAS bf16_t* stT = (LAS bf16_t*)(lds + 65024);
        LAS bf16_t* S = (LAS bf16_t*)(lds + 84992);
        LAS float* O = (LAS float*)(lds + 94208);
        if (tid < 384) {
            const int j = tid / 6, i0 = (tid % 6) * 8;
            const bf16_t* qp = c.proj + (row0 + j) * 3840 + h * 96;
            const bf16_t* kp = qp + 384;
            const u32x4 vq1 = *(const u32x4*)(qp + i0), vq2 = *(const u32x4*)(qp + 48 + i0), vk1 = *(const u32x4*)(kp + i0), vk2 = *(const u32x4*)(kp + 48 + i0);
            float q1[8], q2[8], k1[8], k2[8]; UNPACK8(vq1, q1); UNPACK8(vq2, q2); UNPACK8(vk1, k1); UNPACK8(vk2, k2);
            const float sc = 0.10206207261596575f;
            float qa[8], qb[8], ka[8], kb[8];
            const f32x4 c0 = *(const f32x4*)(c.rcs + (row0 + j) * 48 + i0), c1 = *(const f32x4*)(c.rcs + (row0 + j) * 48 + i0 + 4);
            const f32x4 s0 = *(const f32x4*)(c.rsn + (row0 + j) * 48 + i0), s1 = *(const f32x4*)(c.rsn + (row0 + j) * 48 + i0 + 4);
#pragma unroll
            for (int e = 0; e < 8; ++e) {
                const float co = (e < 4) ? c0[e & 3] : c1[e & 3], si = (e < 4) ? s0[e & 3] : s1[e & 3];
                qa[e] = (q1[e] * co - q2[e] * si) * sc; qb[e] = (q1[e] * si + q2[e] * co) * sc;
                ka[e] = k1[e] * co - k2[e] * si; kb[e] = k1[e] * si + k2[e] * co;
            }
            u32x4 o1, o2, o3, o4;
#pragma unroll
            for (int e = 0; e < 4; ++e) { o1[e] = pk2(qa[2 * e], qa[2 * e + 1]); o2[e] = pk2(qb[2 * e], qb[2 * e + 1]); o3[e] = pk2(ka[2 * e], ka[2 * e + 1]); o4[e] = pk2(kb[2 * e], kb[2 * e + 1]); }
            *(LAS u32x4*)(Qr + j * 104 + i0) = o1; *(LAS u32x4*)(Qr + j * 104 + 48 + i0) = o2;
            *(LAS u32x4*)(Kr + j * 104 + i0) = o3; *(LAS u32x4*)(Kr + j * 104 + 48 + i0) = o4;
        }
#pragma unroll
        for (int i = 0; i < 3; ++i) { const int v = tid + 512 * i; if (v < 1152) *(LAS u32x4*)(stT + (v / 12) * 104 + (v % 12) * 8) = stv[i]; }
        lds_barrier();
        for (int i = 0; i < 2; ++i) {
            const int idx = wid * 2 + i, ti = idx >> 2, tj = idx & 3;
            f32x4 s = (f32x4){0.f, 0.f, 0.f, 0.f};
            s = mma16(Qr + ti * 16 * 104, 104, Kr + tj * 16 * 104, 104, 96, s, lane);
#pragma unroll
            for (int j = 0; j < 4; ++j) {
                const int t = ti * 16 + q * 4 + j, jj = tj * 16 + r;
                const int dd = t > jj ? t - jj : jj - t;
                S[t * 72 + jj] = f2bf(s[j] * __expf(lg * (float)dd));
            }
        }
        lds_barrier();
        for (int i = 0; i < 3; ++i) {
            const int idx = wid * 3 + i, tt = idx / 6, et = idx % 6;
            f32x4 a1 = (f32x4){0.f, 0.f, 0.f, 0.f}, a2 = (f32x4){0.f, 0.f, 0.f, 0.f};
            a1 = mma16(S + tt * 16 * 72, 72, vT + et * 16 * 72, 72, 64, a1, lane);
            a2 = mma16(Qr + tt * 16 * 104, 104, stT + et * 16 * 104, 104, 96, a2, lane);
#pragma unroll
            for (int j = 0; j < 4; ++j) { const int t = tt * 16 + q * 4 + j; O[t * 100 + et * 16 + r] = a1[j] + __expf(lg * (float)(t + 1)) * a2[j]; }
        }
        lds_barrier();
        {
            const int t = tid >> 3, sub = tid & 7;
            float o[12], sm = 0.f;
#pragma unroll
            for (int j = 0; j < 12; ++j) { o[j] = O[t * 100 + sub * 12 + j]; sm += o[j]; }
            sm += __shfl_xor(sm, 1); sm += __shfl_xor(sm, 2); sm += __shfl_xor(sm, 4);
            const float mean = sm * (1.0f / 96.0f);
            float ss = 0.f;
#pragma unroll
            for (int j = 0; j < 12; ++j) { o[j] -= mean; ss += o[j] * o[j]; }
            ss += __shfl_xor(ss, 1); ss += __shfl_xor(ss, 2); ss += __shfl_xor(ss, 4);
            const float rstd = rsqrtf(ss * (1.0f / 96.0f) + 1e-6f);
            bf16_t* op = c.mix + (row0 + t) * 1024 + h * 96 + sub * 12;
            const float* gg = c.ret_gn_g + h * 96 + sub * 12;
#pragma unroll
            for (int j = 0; j < 6; ++j) {
                const unsigned gw = gwv[j];
                const float y0 = o[2 * j] * rstd * gg[2 * j] * silu(lo16(gw)), y1 = o[2 * j + 1] * rstd * gg[2 * j + 1] * silu(hi16(gw));
                *(unsigned*)(op + 2 * j) = pk2(y0, y1);
            }
        }
        lds_barrier();
    }
}

__device__ __forceinline__ void lru_m1(const MixCtx& c, int unit) {
    LAS unsigned char* lds = c.lds;
    const int tid = ltid(), wid = tid >> 6, lane = tid & 63;
    const int hh = unit & 1, bn = unit >> 1, n = bn & 127; const long row0 = (long)bn * 64; const int c0 = hh * 128;
    LAS float* xc = (LAS float*)lds; LAS float* Aa = (LAS float*)(lds + 32768); LAS bf16_t* xcb = (LAS bf16_t*)(lds + 65536);
    LAS bf16_t* lxs = (LAS bf16_t*)(lds + 83968);
    for (int v = tid; v < 67 * 16; v += 512) {
        const int rr = v >> 4, cc = (v & 15) * 8, tt = rr - 3;
        u32x4 val = (u32x4){0u, 0u, 0u, 0u};
        if (n * 64 + tt >= 0) val = *(const u32x4*)(c.proj + (row0 + tt) * 3840 + 3328 + c0 + cc);
        *(LAS u32x4*)(lxs + rr * 128 + cc) = val;
    }
    LAS bf16_t* wsm = (LAS bf16_t*)(lds + 101376);
#pragma unroll
    for (int i = 0; i < 4; ++i) {
        const int v = tid + 512 * i, mat = v >> 10, nbl = (v >> 9) & 1, d = (v >> 3) & 63, c8 = (v & 7) * 8;
        const u32x4 val = *(const u32x4*)((mat ? c.wxT : c.waT) + (hh * 2 + nbl) * 4096 + d * 64 + c8);
        *(LAS u32x4*)(wsm + ((mat * 2 + nbl) * 64 + d) * 72 + c8) = val;
    }
    const int cc = tid & 127, ch = c0 + cc;
    const float cw0 = c.conv_w[ch], cw1 = c.conv_w[256 + ch], cw2 = c.conv_w[512 + ch], cw3 = c.conv_w[768 + ch], cbv = c.conv_b[ch];
    lds_barrier();
#pragma unroll
    for (int i = 0; i < 16; ++i) {
        const int t = (tid >> 7) + 4 * i;
        const float acc = cbv + cw0 * bf2f(lxs[t * 128 + cc]) + cw1 * bf2f(lxs[(t + 1) * 128 + cc]) + cw2 * bf2f(lxs[(t + 2) * 128 + cc]) + cw3 * bf2f(lxs[(t + 3) * 128 + cc]);
        xc[t * 128 + cc] = acc; xcb[t * 136 + cc] = f2bf(acc);
    }
    lds_barrier();
    const int r = lane & 15, q = lane >> 4;
    for (int i = 0; i < 4; ++i) {
        const int idx = wid * 4 + i, nbl = idx >> 4, tt = (idx >> 2) & 3, dt = idx & 3;
        f32x4 ar = (f32x4){0.f, 0.f, 0.f, 0.f}, ai = (f32x4){0.f, 0.f, 0.f, 0.f};
#pragma unroll
        for (int k0 = 0; k0 < 64; k0 += 32) {
            const bf16x8 a = *(const LAS bf16x8*)(xcb + (tt * 16 + r) * 136 + nbl * 64 + k0 + q * 8);
            const bf16x8 b1 = *(const LAS bf16x8*)(wsm + ((0 + nbl) * 64 + dt * 16 + r) * 72 + k0 + q * 8);
            const bf16x8 b2 = *(const LAS bf16x8*)(wsm + ((2 + nbl) * 64 + dt * 16 + r) * 72 + k0 + q * 8);
            ar = __builtin_amdgcn_mfma_f32_16x16x32_bf16(a, b1, ar, 0, 0, 0);
            ai = __builtin_amdgcn_mfma_f32_16x16x32_bf16(a, b2, ai, 0, 0, 0);
        }
        const int c2 = nbl * 64 + dt * 16 + r, ch2 = c0 + c2;
        const float sp = log1pf(expf(-c.lam[ch2])), bav = c.ba[ch2], bxv = c.bx[ch2];
#pragma unroll
        for (int j = 0; j < 4; ++j) {
            const int t = tt * 16 + q * 4 + j;
            const float rr = 1.0f / (1.0f + __expf(-(ar[j] + bav))), ii = 1.0f / (1.0f + __expf(-(ai[j] + bxv)));
            const float la = -8.0f * sp * rr;
            const float a = __expf(la);
            const float u = sqrtf(fmaxf(1.0f - a * a, 0.f)) * ii * xc[t * 128 + c2];
            Aa[t * 128 + c2] = a; xc[t * 128 + c2] = u;
        }
    }
    lds_barrier();
    {
        LAS float* pt = (LAS float*)(lds + 138240);
        const int part = tid >> 7;
        float hs = 0.f, P = 1.f;
#pragma unroll
        for (int t = part * 16; t < part * 16 + 16; ++t) {
            const float a = Aa[t * 128 + cc], u = xc[t * 128 + cc];
            hs = a * hs + u; P *= a;
            xc[t * 128 + cc] = hs; Aa[t * 128 + cc] = P;
        }
        pt[part * 128 + cc] = P; pt[512 + part * 128 + cc] = hs;
        lds_barrier();
        float ch_ = 0.f, cP = 1.f;
#pragma unroll
        for (int pp = 0; pp < 3; ++pp) if (pp < part) { const float Pp = pt[pp * 128 + cc], hp = pt[512 + pp * 128 + cc]; ch_ = Pp * ch_ + hp; cP *= Pp; }
        if (part > 0) {
#pragma unroll
            for (int t = part * 16; t < part * 16 + 16; ++t) {
                const float Pl = Aa[t * 128 + cc];
                xc[t * 128 + cc] += Pl * ch_; Aa[t * 128 + cc] = Pl * cP;
            }
        }
        if (part == 3) { c.lruhe[(long)bn * 256 + ch] = xc[63 * 128 + cc]; c.lrupe[(long)bn * 256 + ch] = Aa[63 * 128 + cc]; }
    }
    lds_barrier();
#pragma unroll
    for (int i = 0; i < 2; ++i) {
        const int v = tid + 512 * i, t = v >> 4, c8 = (v & 15) * 8;
        const f32x4 h0 = *(const LAS f32x4*)(xc + t * 128 + c8), h1 = *(const LAS f32x4*)(xc + t * 128 + c8 + 4);
        const f32x4 p0 = *(const LAS f32x4*)(Aa + t * 128 + c8), p1 = *(const LAS f32x4*)(Aa + t * 128 + c8 + 4);
        u32x4 ph, pp; ph[0] = pk2(h0[0], h0[1]); ph[1] = pk2(h0[2], h0[3]); ph[2] = pk2(h1[0], h1[1]); ph[3] = pk2(h1[2], h1[3]);
        pp[0] = pk2(p0[0], p0[1]); pp[1] = pk2(p0[2], p0[3]); pp[2] = pk2(p1[0], p1[1]); pp[3] = pk2(p1[2], p1[3]);
        *(u32x4*)(c.lruh + (row0 + t) * 256 + c0 + c8) = ph; *(u32x4*)(c.lrup + (row0 + t) * 256 + c0 + c8) = pp;
    }
    lds_barrier();
}
__device__ __forceinline__ void lru_m3(const MixCtx& c, int bn) {
    const int tid = ltid(); const long row0 = (long)bn * 64;
#pragma unroll
    for (int i = 0; i < 4; ++i) {
        const int v = tid + 512 * i, t = v >> 5, cc = (v & 31) * 8;
        const u32x4 hv = *(const u32x4*)(c.lruh + (row0 + t) * 256 + cc);
        const u32x4 pv = *(const u32x4*)(c.lrup + (row0 + t) * 256 + cc);
        const u32x4 gv = *(const u32x4*)(c.proj + (row0 + t) * 3840 + 3584 + cc);
        const f32x4 ca = *(const f32x4*)(c.lruci + (long)bn * 256 + cc), cb = *(const f32x4*)(c.lruci + (long)bn * 256 + cc + 4);
        float hf[8], pf[8], gf[8]; UNPACK8(hv, hf); UNPACK8(pv, pf); UNPACK8(gv, gf);
        float o[8];
#pragma unroll
        for (int j = 0; j < 4; ++j) { o[j] = (hf[j] + pf[j] * ca[j]) * gelu_tanh(gf[j]); o[4 + j] = (hf[4 + j] + pf[4 + j] * cb[j]) * gelu_tanh(gf[4 + j]); }
        u32x4 pk; pk[0] = pk2(o[0], o[1]); pk[1] = pk2(o[2], o[3]); pk[2] = pk2(o[4], o[5]); pk[3] = pk2(o[6], o[7]);
        *(u32x4*)(c.mix + (row0 + t) * 1024 + 768 + cc) = pk;
    }
}

__device__ __forceinline__ void phase_scan(const MixCtx& c) {
    const long gt = (long)blockIdx.x * NTHREADS + ltid();
    if (gt < 49152) {
        const int bh = (int)(gt / 3072), g4 = (int)(gt % 3072), b = bh >> 2, h = bh & 3, d0 = (g4 * 4) & 127;
        float s0 = 0.f, s1 = 0.f, s2 = 0.f, s3 = 0.f;
        for (int n0 = 0; n0 < 128; n0 += 8) {
            u32x2 kv[8]; f32x4 la[8];
#pragma unroll
            for (int i = 0; i < 8; ++i) {
                const long unit = ((long)(b * 128 + n0 + i)) * 4 + h;
                kv[i] = *(const u32x2*)(c.sth + unit * 12288 + g4 * 4);
                la[i] = *(const f32x4*)(c.lasth + unit * 128 + d0);
            }
#pragma unroll
            for (int i = 0; i < 8; ++i) {
                const long unit = ((long)(b * 128 + n0 + i)) * 4 + h;
                u32x2 o; o[0] = pk2(s0, s1); o[1] = pk2(s2, s3); *(u32x2*)(c.sth + unit * 12288 + g4 * 4) = o;
                s0 = __expf(la[i][0]) * s0 + lo16(kv[i][0]); s1 = __expf(la[i][1]) * s1 + hi16(kv[i][0]);
                s2 = __expf(la[i][2]) * s2 + lo16(kv[i][1]); s3 = __expf(la[i][3]) * s3 + hi16(kv[i][1]);
            }
        }
    } else if (gt < 49152 + 36864) {
        const long g = gt - 49152; const int bh = (int)(g / 2304), g4 = (int)(g % 2304), b = bh >> 2, h = bh & 3;
        const float dec = expf(64.0f * log1pf(-exp2f(-5.0f - (float)h)));
        float s0 = 0.f, s1 = 0.f, s2 = 0.f, s3 = 0.f;
        for (int n0 = 0; n0 < 128; n0 += 8) {
            u32x2 kv[8];
#pragma unroll
            for (int i = 0; i < 8; ++i) { const long unit = ((long)(b * 128 + n0 + i)) * 4 + h; kv[i] = *(const u32x2*)(c.str + unit * 9216 + g4 * 4); }
#pragma unroll
            for (int i = 0; i < 8; ++i) {
                const long unit = ((long)(b * 128 + n0 + i)) * 4 + h;
                u32x2 o; o[0] = pk2(s0, s1); o[1] = pk2(s2, s3); *(u32x2*)(c.str + unit * 9216 + g4 * 4) = o;
                s0 = dec * s0 + lo16(kv[i][0]); s1 = dec * s1 + hi16(kv[i][0]); s2 = dec * s2 + lo16(kv[i][1]); s3 = dec * s3 + hi16(kv[i][1]);
            }
        }
    } else if (gt < 49152 + 36864 + 1024) {
        const int g = (int)(gt - 49152 - 36864), b = g >> 8, ch = g & 255;
        float carry = 0.f;
        for (int n0 = 0; n0 < 128; n0 += 8) {
            float pe[8], he[8];
#pragma unroll
            for (int i = 0; i < 8; ++i) { const long o = (long)(b * 128 + n0 + i) * 256 + ch; pe[i] = c.lrupe[o]; he[i] = c.lruhe[o]; }
#pragma unroll
            for (int i = 0; i < 8; ++i) { const long o = (long)(b * 128 + n0 + i) * 256 + ch; c.lruci[o] = carry; carry = pe[i] * carry + he[i]; }
        }
    }
}

#define XB_TMO      128
#define XB_XCNT(j)  (256  + 64 * (j))
#define XB_XSUB(j)  (1280 + 64 * (j))
#define XB_XGEN(j)  (2304 + 64 * (j))
#define XB_TOP      3328
#define XB_TOPGEN   3392
#define XCD_BAR_WORDS 3456
#define XB_SPIN_CAP (1u << 18)
__device__ __forceinline__ unsigned xb_ld(unsigned* p)              { return __hip_atomic_load(p, __ATOMIC_RELAXED, __HIP_MEMORY_SCOPE_AGENT); }
__device__ __forceinline__ unsigned xb_add(unsigned* p, unsigned v) { return __hip_atomic_fetch_add(p, v, __ATOMIC_RELAXED, __HIP_MEMORY_SCOPE_AGENT); }
__device__ __forceinline__ unsigned xb_xcc_id() { return (unsigned)__builtin_amdgcn_s_getreg((3 << 11) | 20) & 0xFu; }
#define XB_SPIN(cond, bar) do { unsigned _sp = 0; while (cond) { __builtin_amdgcn_s_sleep(1); \
    if ((++_sp & 255u) == 0u) { if (xb_ld(&(bar)[XB_TMO])) break; if (_sp > XB_SPIN_CAP) { atomicAdd(&(bar)[XB_TMO], 1u); break; } } } } while (0)
struct XcdBarrier { unsigned* bar; unsigned x; volatile LAS unsigned* st; };
__device__ __forceinline__ XcdBarrier xcd_barrier_post(unsigned* bar, volatile LAS unsigned* st) {
    XcdBarrier b; b.bar = bar; b.x = xb_xcc_id(); b.st = st;
    if (threadIdx.x == 0) (void)xb_add(&bar[XB_XCNT(b.x)], 1u);
    return b;
}
__device__ __forceinline__ void xcd_barrier_complete(unsigned* bar, unsigned x, unsigned& nloc, unsigned& nx) {
    const unsigned G = gridDim.x * gridDim.y * gridDim.z;
    unsigned sum, cnt, mine, sp = 0u;
    for (;;) {
        sum = 0u; cnt = 0u; mine = 0u;
#pragma unroll
        for (unsigned j = 0; j < 16; ++j) { const unsigned c = xb_ld(&bar[XB_XCNT(j)]); sum += c; cnt += (c > 0u) ? 1u : 0u; mine = (j == x) ? c : mine; }
        if (sum == G) break;
        __builtin_amdgcn_s_sleep(1);
        if ((++sp & 255u) == 0u) { if (xb_ld(&bar[XB_TMO])) break; if (sp > XB_SPIN_CAP) { atomicAdd(&bar[XB_TMO], 1u); break; } }
    }
    nloc = mine > 0u ? mine : 1u; nx = cnt > 0u ? cnt : 1u;
}
__device__ __forceinline__ void xcd_barrier(const XcdBarrier& b) {
    asm volatile("s_waitcnt vmcnt(0)" ::: "memory");
    __syncthreads();
    if (threadIdx.x == 0) {
        unsigned* bar = b.bar;
        __builtin_amdgcn_s_waitcnt(0);
        unsigned nloc = b.st[0], nx = b.st[1];
        if (nloc == 0u) { xcd_barrier_complete(bar, b.x, nloc, nx); b.st[0] = nloc; b.st[1] = nx; }
        const unsigned old = xb_add(&bar[XB_XSUB(b.x)], 1u);
        const unsigned gen = old / nloc;
        if (old + 1u == (gen + 1u) * nloc) {
            __builtin_amdgcn_fence(__ATOMIC_RELEASE, "agent");
            asm volatile("s_waitcnt vmcnt(0)" ::: "memory");
            const unsigned og = xb_add(&bar[XB_TOP], 1u);
            const unsigned tg = og / nx;
            if (og + 1u == (tg + 1u) * nx) xb_add(&bar[XB_TOPGEN], 1u);
            else XB_SPIN(xb_ld(&bar[XB_TOPGEN]) == tg, bar);
            __builtin_amdgcn_fence(__ATOMIC_ACQUIRE, "agent");
            xb_add(&bar[XB_XGEN(b.x)], 1u);
            asm volatile("s_waitcnt vmcnt(0)" ::: "memory");
        } else {
            XB_SPIN(xb_ld(&bar[XB_XGEN(b.x)]) == gen, bar);
            __builtin_amdgcn_fence(__ATOMIC_ACQUIRE, "agent");
            asm volatile("s_waitcnt vmcnt(0)" ::: "memory");
        }
    }
    __syncthreads();
}

__global__ void __launch_bounds__(NTHREADS) mega(Params p) {
    extern __shared__ __attribute__((aligned(16))) unsigned char shm[];
    LAS unsigned char* lds = (LAS unsigned char*)shm;
    cg::grid_group grid = cg::this_grid();
    const int G = gridDim.x, cb = blockIdx.x;
    volatile LAS unsigned* xst = (volatile LAS unsigned*)(lds + LDS_BYTES - 16);
    if (threadIdx.x < 2) xst[threadIdx.x] = 0u;
    __syncthreads();
    const XcdBarrier xb = xcd_barrier_post((unsigned*)(WSP + WS_BAR), xst);
#define ws WSP
#define BIG ((bf16_t*)(WSP + WS_BIG))
#define Hb ((bf16_t*)XOUT)
#define XB ((bf16_t*)(WSP + WS_H))
#define MEMN ((bf16_t*)(WSP + WS_MEMN))
#define KMEM ((bf16_t*)(WSP + WS_KMEM))
#define KV ((bf16_t*)(WSP + WS_KMEM))
#define MBT ((bf16_t*)(WSP + WS_MBT))
#define VWT ((bf16_t*)(WSP + WS_VWT))
#define VT ((bf16_t*)(WSP + WS_VT))
#define Qb (BIG + 32768l * 1024)
#define Pb (BIG + 2 * 32768l * 1024)
#define SSP(i) ((float*)(WSP + WS_SS) + (long)((i) & 1) * 32768 * 16)
#define X XOUT

    for (int ph = 0; ph < 38; ++ph) {
        const int l = ph / 19, k = ph % 19;

        GJob g{}; Epi E{}; bool is_gemm = true;
        g.lda = 1024; g.ldb = 1024; g.K = 1024; g.nM = 128; g.nN = 4; g.nZ = 1; E.scale = 1.0f; E.ldo = 1024;
        const float* ng = nullptr;
        switch (k) {
            case 1: g.A = XB; g.Bt = (const bf16_t*)(ws + WB_UP1); g.nN = 22; E.O = BIG; E.ss_in = SSP(l * 4 + 0); for (int rr = 0; rr < REP_GEMM; ++rr) { PH(2) gemm_phase<0>(lds, g, E, G, cb); } break;
            case 17: g.A = XB; g.Bt = (const bf16_t*)(ws + WB_UP2); g.nN = 22; E.O = BIG; E.ss_in = SSP(l * 4 + 3); for (int rr = 0; rr < REP_GEMM; ++rr) { PH(18) gemm_phase<0>(lds, g, E, G, cb); } break;
            case 2: case 3: continue;
            case 4: g.A = BIG; g.Bt = (const bf16_t*)(ws + WB_DN1); g.lda = 2816; g.ldb = 2816; g.K = 2816; E.resb = XB; E.scale = 0.5f; E.ss_out = SSP(l * 4 + 1); for (int rr = 0; rr < REP_GEMM; ++rr) { E.O = (rr == REP_GEMM - 1) ? XB : Hb; PH(4) gemm_phase<1>(lds, g, E, G, cb); } break;
            case 18: g.A = BIG; g.Bt = (const bf16_t*)(ws + WB_DN2); g.lda = 2816; g.ldb = 2816; g.K = 2816; E.resb = XB; E.scale = 0.5f; E.ss_out = SSP(l * 4 + 4); for (int rr = 0; rr < REP_GEMM; ++rr) { E.O = (rr == REP_GEMM - 1) ? XB : Hb; PH(19) gemm_phase<1>(lds, g, E, G, cb); } break;
            case 6: g.A = XB; g.Bt = (const bf16_t*)(ws + WB_IN); g.nN = 15; E.O = BIG; E.ldo = 3840; E.ss_in = SSP(l * 4 + 1); for (int rr = 0; rr < REP_GEMM; ++rr) { PH(5) gemm_phase<2>(lds, g, E, G, cb); }
                {
                GJob g2{}; Epi E2{}; g2.lda = 1024; g2.ldb = 1024; g2.K = 1024; g2.nZ = 1; E2.scale = 1.0f;
                g2.A = MEMN; g2.Bt = (const bf16_t*)(ws + WB_KV); g2.nM = 4; g2.nN = 8; E2.O = KV; E2.ldo = 2048; gemm_phase<2>(lds, g2, E2, G, (cb + 128) % G);
                } break;
            case 10:
                g.A = Hb; g.Bt = (const bf16_t*)(ws + WB_OUT); E.resb = XB; E.ss_out = SSP(l * 4 + 2); for (int rr = 0; rr < REP_GEMM; ++rr) { E.O = (rr == REP_GEMM - 1) ? XB : BIG; PH(13) gemm_phase<1>(lds, g, E, G, cb); } break;
            case 12: continue;
            case 13: g.A = XB; g.aZ1 = 8192l * 1024; g.Bt = MBT; g.bZ1 = 1024l * 1024; g.nM = 32; g.nN = 4; g.nZ = 4; g.rowZ = 8192;
                     E.O = Pb; E.rowZ = 8192; E.ss_in = SSP(l * 4 + 2); E.tab = (LAS float*)(lds + 131072); for (int rr = 0; rr < REP_GEMM; ++rr) { PH(15) gemm_phase<3>(lds, g, E, G, cb); } break;
            case 14: continue;
            case 15: g.A = Pb; g.aZ1 = 8192l * 1024; g.Bt = VWT; g.bZ1 = 1024l * 1024; g.nM = 32; g.nN = 4; g.nZ = 4; E.rowZ = 8192;
                     E.resb = XB; E.ss_out = SSP(l * 4 + 3); for (int rr = 0; rr < REP_GEMM; ++rr) { E.O = (rr == REP_GEMM - 1) ? XB : BIG; PH(17) gemm_phase<1>(lds, g, E, G, cb); } break;
            case 0: is_gemm = false; ng = PIN(3); break;
            case 5: case 11: case 16: continue;
            default: is_gemm = false; break;
        }
        if (is_gemm) {
        } else if (ng != nullptr) {
            for (int rr = 0; rr < REP_EW; ++rr) {
            if (k == 0) { PH(0) phase_convert(l, lds, 0, 3072); PH(0) phase_convert(l, lds, 3584, 4352); PH(0) phase_convert(l, lds, 6464, 6472);
                          PH(0) phase_convert_straight(PIN(22) + l * 1024l * 1024, PIN(20) + l * 1024, (bf16_t*)(ws + WB_Q)); }
            if (l == 0) { PH(1) phase_prep(PIN(0), XB, SSP(0), 32768); PH(1) phase_rope_table((const int*)PIN(2), XOUT + 16777216l, XOUT + 16777216l + 32768l * 48); }
            PH(1) phase_norm(PIN(1), PIN(21) + l * 1024, MEMN, 1024);
            }
        } else {
        MixCtx mc;
            mc.lds = lds; mc.proj = BIG; mc.mix = Hb; mc.sth = (bf16_t*)(ws + WS_STH); mc.str = (bf16_t*)(ws + WS_STR); mc.lasth = (float*)(ws + WS_LASTH);
            mc.lrup = (bf16_t*)(ws + WS_LRUP); mc.lruh = (bf16_t*)(ws + WS_LRUH); mc.lrupe = (float*)(ws + WS_LRUPE); mc.lruhe = (float*)(ws + WS_LRUHE); mc.lruci = (float*)(ws + WS_LRUCI);
            mc.waT = (const bf16_t*)(ws + WB_WA); mc.wxT = (const bf16_t*)(ws + WB_WX);
            mc.pos = (const int*)PIN(2); mc.hg_lb = PIN(10); mc.rcs = XOUT + 16777216l; mc.rsn = XOUT + 16777216l + 32768l * 48;
            mc.ret_gn_g = PIN(9) + l * 384; mc.hg_norm_g = PIN(11) + l * 384;
            mc.conv_w = PIN(12) + l * 1024; mc.conv_b = PIN(13) + l * 256; mc.ba = PIN(15) + l * 256; mc.bx = PIN(17) + l * 256; mc.lam = PIN(18) + l * 256;
            mc.l = l;
            if (k == 7) {
                for (int rr = 0; rr < REP_MIX; ++rr) for (int idx = cb; idx < 5120; idx += G) {
                    const int kk5 = idx % 5, u = idx / 5;
                    if (kk5 < 2) { RMT(0) ret_unit<false>(mc, 2 * u + kk5); }
                    else if (kk5 < 4) { RMT(1) hg_unit<false>(mc, 2 * u + (kk5 - 2)); }
                    else { RMT(2) lru_m1(mc, u); }
                }
                {
                GJob g2{}; Epi E2{}; g2.A = KV; g2.lda = 2048; g2.aZ1 = 256l * 2048; g2.aZ2 = 256; g2.Bt = (const bf16_t*)(ws + WB_Q); g2.ldb = 1024; g2.bZ2 = 256; g2.K = 256; g2.nM = 1; g2.nN = 4; g2.nZ = 16; g2.zshift = 2;
                E2.O = MBT; E2.ldo = 1024; E2.oZ1 = 1024l * 1024; E2.oZ2 = 256l * 1024; E2.zshift = 2; E2.scale = 0.0625f; gemm_phase<2>(lds, g2, E2, G, cb);
                GJob g3{}; Epi E3{}; g3.A = (const bf16_t*)(ws + WB_O); g3.lda = 1024; g3.aZ2 = 256; g3.Bt = KV + 1024; g3.ldb = 2048; g3.bZ1 = 256l * 2048; g3.bZ2 = 256; g3.K = 256; g3.nM = 4; g3.nN = 1; g3.nZ = 16; g3.zshift = 2;
                E3.O = VWT; E3.ldo = 1024; E3.oZ1 = 1024l * 1024; E3.oZ2 = 256; E3.zshift = 2; E3.scale = 1.0f; gemm_phase<2>(lds, g3, E3, G, (cb + 64) % G);
                                }
            } else if (k == 8) {
                PH(9) phase_scan(mc);
                PH(0) phase_convert(l, lds, 3072, 3328);
                PH(0) phase_convert(l, lds, 4352, 6464);
            } else {
                for (int rr = 0; rr < REP_MIX; ++rr) for (int idx = cb; idx < 4608; idx += G) {
                    const int kk9 = idx % 9, u = idx / 9;
                    if (kk9 < 4) { RMT(3) ret_unit<true>(mc, 4 * u + kk9); }
                    else if (kk9 < 8) { RMT(4) hg_unit<true>(mc, 4 * u + (kk9 - 4)); }
                    else { RMT(5) lru_m3(mc, u); }
                }
            }
        }
        if (ph == 0) grid.sync(); else xcd_barrier(xb);
    }
    PH(20) phase_final_norm(XB, X, PIN(29), 32768);
}

#undef ws
#undef BIG
#undef Hb
#undef XB
#undef MEMN
#undef KMEM
#undef KV
#undef MBT
#undef VWT
#undef VT
#undef Qb
#undef SSP
#undef Pb
#undef X
extern "C" void kernel_launch(void* const* d_in, const int* in_sizes, int n_in, void* d_out, int out_size, void* d_ws, size_t ws_size, hipStream_t stream) {
    static int grid = 0;
    if (grid == 0) {
        int dev = 0, cus = 0, per_cu = 0;
        (void)hipGetDevice(&dev);
        (void)hipDeviceGetAttribute(&cus, hipDeviceAttributeMultiprocessorCount, dev);
        if (hipFuncSetAttribute((const void*)mega, hipFuncAttributeMaxDynamicSharedMemorySize, LDS_BYTES) != hipSuccess) fprintf(stderr, "kernel_launch: hipFuncSetAttribute failed\n");
        if (hipOccupancyMaxActiveBlocksPerMultiprocessor(&per_cu, (const void*)mega, NTHREADS, LDS_BYTES) != hipSuccess || per_cu < 1) { fprintf(stderr, "kernel_launch: occupancy query says %d\n", per_cu); per_cu = 1; }
        (void)hipGetLastError();
        grid = cus * 1;
        if (ws_size < WS_END) fprintf(stderr, "kernel_launch: workspace too small: %zu < %zu\n", ws_size, (size_t)WS_END);
    }
    Params p{};
    for (int i = 0; i < 30; ++i) p.in[i] = (const float*)d_in[i];
    p.outp_ = (float*)d_out; p.wsp_ = (unsigned char*)d_ws;
    if (hipMemsetAsync((char*)d_ws + WS_BAR, 0, 16384, stream) != hipSuccess) fprintf(stderr, "kernel_launch: memset of barrier words failed\n");
    void* args[] = {&p};
    hipError_t e = hipLaunchCooperativeKernel((const void*)mega, dim3(grid), dim3(NTHREADS), args, LDS_BYTES, stream);
    if (e != hipSuccess) fprintf(stderr, "cooperative launch failed: %s (grid %d)\n", hipGetErrorString(e), grid);
}
```

```cpp
#include <hip/hip_runtime.h>
#include <hip/hip_cooperative_groups.h>
#include <cstdio>
namespace cg = cooperative_groups;

#define LAS __attribute__((address_space(3)))
typedef unsigned short bf16_t;
typedef short bf16x8 __attribute__((ext_vector_type(8)));
typedef float f32x4 __attribute__((ext_vector_type(4)));
typedef unsigned u32x4 __attribute__((ext_vector_type(4)));
typedef unsigned u32x2 __attribute__((ext_vector_type(2)));

constexpr int LDS_BYTES = 155648;
constexpr int NTHREADS = 512;
constexpr long T_TOK = 32768;
#ifndef PHMASK
#define PHMASK 0xffffffffu
#endif
#define PH(n) if ((PHMASK >> (n)) & 1u)
#ifndef REPK
#define REPK 0u
#endif
#define REP_GEMM (((REPK >> k) & 1u) ? 2 : 1)
#ifndef REP_MIX
#define REP_MIX 1
#endif
#ifndef REP_MT
#define REP_MT 0u
#endif
#define RMT(b) for (int r2 = 0; r2 < (((REP_MT >> (b)) & 1u) ? 2 : 1); ++r2)
#ifndef REP_EW
#define REP_EW 1
#endif

constexpr size_t WB_UP1 = 0;
constexpr size_t WB_DN1 = WB_UP1 + 5632ull * 1024 * 2;
constexpr size_t WB_IN = WB_DN1 + 1024ull * 2816 * 2;
constexpr size_t WB_OUT = WB_IN + 3840ull * 1024 * 2;
constexpr size_t WB_Q = WB_OUT + 1024ull * 1024 * 2;
constexpr size_t WB_KV = WB_Q + 1024ull * 1024 * 2;
constexpr size_t WB_O = WB_KV + 2048ull * 1024 * 2;
constexpr size_t WB_UP2 = WB_O + 1024ull * 1024 * 2;
constexpr size_t WB_DN2 = WB_UP2 + 5632ull * 1024 * 2;
constexpr size_t WB_WA = WB_DN2 + 1024ull * 2816 * 2;
constexpr size_t WB_WX = WB_WA + 16384ull * 2;
constexpr size_t WS_BIG = WB_WX + 16384ull * 2;
constexpr size_t WS_H = WS_BIG + 32768ull * 3840 * 2;
constexpr size_t WS_STH = WS_H + 32768ull * 1024 * 2;
constexpr size_t WS_STR = WS_STH + 2048ull * 96 * 128 * 2;
constexpr size_t WS_LASTH = WS_STR + 2048ull * 96 * 96 * 2;
constexpr size_t WS_LRUP = WS_LASTH + 2048ull * 128 * 4;
constexpr size_t WS_LRUH = WS_LRUP + 32768ull * 256 * 2;
constexpr size_t WS_LRUPE = WS_LRUH + 32768ull * 256 * 2;
constexpr size_t WS_LRUHE = WS_LRUPE + 512ull * 256 * 4;
constexpr size_t WS_LRUCI = WS_LRUHE + 512ull * 256 * 4;
constexpr size_t WS_MEMN = WS_LRUCI + 512ull * 256 * 4;
constexpr size_t WS_KMEM = WS_MEMN + 1024ull * 1024 * 2;
constexpr size_t WS_VT = WS_KMEM + 1024ull * 1024 * 2;
constexpr size_t WS_BAR = WS_VT + 1024ull * 1024 * 2;
constexpr size_t WS_SS = WS_BAR + 16384;
constexpr size_t WS_MBT = WS_SS + 2ull * 32768 * 16 * 4;
constexpr size_t WS_VWT = WS_MBT + 4ull * 1024 * 1024 * 2;
constexpr size_t WS_END = WS_VWT + 4ull * 1024 * 1024 * 2;

struct Params {
    const float* in[30];
    float* outp_;
    unsigned char* wsp_;
};

typedef const __attribute__((address_space(4))) Params* KArgP;
__device__ __forceinline__ KArgP kargs() { auto q = __builtin_amdgcn_kernarg_segment_ptr(); asm volatile("" : "+s"(q)); return (KArgP)q; }
#define PIN(i) (kargs()->in[i])
#define WSP (kargs()->wsp_)
#define XOUT (kargs()->outp_)
__device__ __forceinline__ int ltid() { int t = threadIdx.x; asm volatile("" : "+v"(t)); return t; }
__device__ __forceinline__ float bf2f(bf16_t b) { return __uint_as_float(((unsigned)b) << 16); }
typedef float f32x2_t __attribute__((ext_vector_type(2)));
typedef __bf16 bf16x2_t __attribute__((ext_vector_type(2)));
__device__ __forceinline__ unsigned pk2(float lo, float hi) { const f32x2_t f = {lo, hi}; const bf16x2_t b = __builtin_convertvector(f, bf16x2_t); return __builtin_bit_cast(unsigned, b); }
__device__ __forceinline__ bf16_t f2bf(float f) { return (bf16_t)(pk2(f, f) & 0xffffu); }
__device__ __forceinline__ float lo16(unsigned w) { return __uint_as_float(w << 16); }
__device__ __forceinline__ float hi16(unsigned w) { return __uint_as_float(w & 0xffff0000u); }
__device__ __forceinline__ float sigm(float x) { return __builtin_amdgcn_rcpf(1.0f + __expf(-x)); }
__device__ __forceinline__ float silu(float x) { return x * sigm(x); }
__device__ __forceinline__ float gelu_tanh(float x) { return x * sigm(1.5957691216f * (x + 0.044715f * x * x * x)); }
#define UNPACK8(v, f) do { _Pragma("unroll") for (int _i = 0; _i < 4; ++_i) { f[2 * _i] = lo16(v[_i]); f[2 * _i + 1] = hi16(v[_i]); } } while (0)

__device__ __forceinline__ f32x4 mma16(const LAS bf16_t* A, int lda, const LAS bf16_t* B, int ldb, int K, f32x4 acc, int lane) {
    const int r = lane & 15, q = lane >> 4;
    const LAS bf16_t* ap = A + r * lda + q * 8;
    const LAS bf16_t* bp = B + r * ldb + q * 8;
    for (int k0 = 0; k0 < K; k0 += 32) {
        const bf16x8 a = *(const LAS bf16x8*)(ap + k0);
        const bf16x8 b = *(const LAS bf16x8*)(bp + k0);
        acc = __builtin_amdgcn_mfma_f32_16x16x32_bf16(a, b, acc, 0, 0, 0);
    }
    return acc;
}

constexpr int BM = 256, BK = 64, HALF = 128, HTB = HALF * BK * 2;
__device__ __forceinline__ int lds_byte(int r, int c) { const int st = (r >> 4) * 2 + (c >> 5), rr = r & 15, cc = c & 31, ob = rr * 64 + cc * 2; return st * 1024 + (ob ^ (((ob >> 9) & 1) << 5)); }
__device__ __forceinline__ void stage_rc(int b, int& R, int& C) { const int st = b / 1024, sb = b % 1024, swz = sb ^ (((sb >> 9) & 1) << 5); R = (st >> 1) * 16 + swz / 64; C = (st & 1) * 32 + (swz % 64) / 2; }
__device__ __forceinline__ int perm32(int rho) { const int n = rho >> 4, i = rho & 15; return 8 * (i >> 2) + 4 * n + (i & 3); }

struct Unit { int pm, pn, z; };
struct GJob {
    const bf16_t* A; const bf16_t* Bt; int lda, ldb, K, nM, nN, nZ, zshift; long aZ1, aZ2, bZ1, bZ2;
    long rowZ;
};
__device__ __forceinline__ bool g_next(const GJob& g, int i, int G, int c, Unit& u) {
    const int per = g.nM * g.nN, tot = per * g.nZ;
    const long L = (long)i * G + c; if (L >= tot) return false;
    int wgid = (int)L; { const int q = tot / 8, r = tot % 8, xcd = wgid % 8, off = wgid / 8; wgid = (xcd < r ? xcd * (q + 1) : r * (q + 1) + (xcd - r) * q) + off; }
    u.z = wgid / per; const int w = wgid % per;
    const int nig = 8 * g.nN, gid = w / nig, fm = gid * 8, gsz = (g.nM - fm) < 8 ? (g.nM - fm) : 8;
    u.pm = fm + ((w % nig) % gsz); u.pn = (w % nig) / gsz; return true;
}
__device__ __forceinline__ const char* g_aptr(const GJob& g, const Unit& u) {
    const long z1 = u.z >> g.zshift, z2 = u.z & ((1 << g.zshift) - 1);
    return (const char*)(g.A + z1 * g.aZ1 + z2 * g.aZ2 + (long)u.pm * BM * g.lda);
}
__device__ __forceinline__ const char* g_bptr(const GJob& g, const Unit& u) {
    const long z1 = u.z >> g.zshift, z2 = u.z & ((1 << g.zshift) - 1);
    return (const char*)(g.Bt + z1 * g.bZ1 + z2 * g.bZ2 + (long)u.pn * BM * g.ldb);
}

typedef f32x4 AccT[2][2][4][2];

struct Epi {
    int mode; int ldo; int zshift; float scale; bf16_t* O; long oZ1, oZ2; const bf16_t* resb; LAS float* tab;
    long rowZ;
    const float* ss_in;
    float* ss_out;
};
__device__ __forceinline__ float row_rstd(const float* ss, long row) {
    const f32x4* sp = (const f32x4*)(ss + row * 16);
    const f32x4 a = (sp[0] + sp[1]) + (sp[2] + sp[3]);
    return rsqrtf(((a[0] + a[1]) + (a[2] + a[3])) * (1.0f / 1024.0f) + 1e-6f);
}
__device__ __forceinline__ void epi_swiglu(const Epi& E, AccT& acc, const Unit& u, int wr, int wc, int fr, int fq, const LAS float* rst) {
    const long row0 = (long)u.pm * BM + wr * 64 + fr; const int col0 = u.pn * 128 + wc * 32 + 8 * fq;
#pragma unroll
    for (int ai = 0; ai < 2; ++ai)
#pragma unroll
        for (int m = 0; m < 4; ++m) {
            const float rs = rst[ai * 128 + wr * 64 + m * 16 + fr];
            float o[8];
#pragma unroll
            for (int n = 0; n < 2; ++n)
#pragma unroll
                for (int j = 0; j < 4; ++j) o[n * 4 + j] = silu(acc[ai][0][m][n][j] * rs) * (acc[ai][1][m][n][j] * rs);
            u32x4 pk; pk[0] = pk2(o[0], o[1]); pk[1] = pk2(o[2], o[3]); pk[2] = pk2(o[4], o[5]); pk[3] = pk2(o[6], o[7]);
            *(u32x4*)(E.O + (row0 + ai * HALF + m * 16) * 2816 + col0) = pk;
        }
}
#define RESID_LOAD(ai, rv) _Pragma("unroll") for (int m = 0; m < 4; ++m) _Pragma("unroll") for (int bj = 0; bj < 2; ++bj) rv[m][bj] = *(const u32x4*)(E.resb + (row0 + (ai) * HALF + m * 16) * 1024 + col0 + bj * HALF)
#define RESID_COMP(ai, rv, pk) _Pragma("unroll") for (int m = 0; m < 4; ++m) { float sl = 0.f; _Pragma("unroll") for (int bj = 0; bj < 2; ++bj) { \
        float rf[8]; UNPACK8(rv[m][bj], rf); float v[8]; \
        _Pragma("unroll") for (int j = 0; j < 4; ++j) { v[j] = rf[j] + acc[ai][bj][m][0][j] * E.scale; v[4 + j] = rf[4 + j] + acc[ai][bj][m][1][j] * E.scale; } \
        _Pragma("unroll") for (int j = 0; j < 8; ++j) sl += v[j] * v[j]; \
        pk[m][bj][0] = pk2(v[0], v[1]); pk[m][bj][1] = pk2(v[2], v[3]); pk[m][bj][2] = pk2(v[4], v[5]); pk[m][bj][3] = pk2(v[6], v[7]); } ssl[ai][m] = sl; }
#define RESID_STORE(ai, pk) _Pragma("unroll") for (int m = 0; m < 4; ++m) _Pragma("unroll") for (int bj = 0; bj < 2; ++bj) *(u32x4*)(E.O + (row0 + (ai) * HALF + m * 16) * 1024 + col0 + bj * HALF) = pk[m][bj]
__device__ __forceinline__ void epi_resid(const Epi& E, AccT& acc, const Unit& u, int wr, int wc, int fr, int fq) {
    const long row0 = (long)u.z * E.rowZ + (long)u.pm * BM + wr * 64 + fr; const int col0 = u.pn * BM + wc * 32 + 8 * fq;
    float ssl[2][4];
    u32x4 rvA[4][2], pkA[4][2];
    RESID_LOAD(0, rvA);
    asm volatile("" ::: "memory");
    RESID_COMP(0, rvA, pkA);
    u32x4 rvB[4][2];
    RESID_LOAD(1, rvB);
    asm volatile("" ::: "memory");
    RESID_STORE(0, pkA);
    asm volatile("" ::: "memory");
    u32x4 pkB[4][2];
    RESID_COMP(1, rvB, pkB);
    RESID_STORE(1, pkB);
#pragma unroll
    for (int ai = 0; ai < 2; ++ai)
#pragma unroll
        for (int m = 0; m < 4; ++m) {
            float sl = ssl[ai][m];
            sl += __shfl_xor(sl, 16); sl += __shfl_xor(sl, 32);
            if (fq == 0) E.ss_out[(row0 + ai * HALF + m * 16) * 16 + u.pn * 4 + wc] = sl;
        }
}
#undef RESID_LOAD
#undef RESID_COMP
#undef RESID_STORE
__device__ __forceinline__ void epi_bf16(const Epi& E, AccT& acc, const Unit& u, int wr, int wc, int fr, int fq, const LAS float* rst) {
    const long z1 = u.z >> E.zshift, z2 = u.z & ((1 << E.zshift) - 1);
    bf16_t* base = E.O + z1 * E.oZ1 + z2 * E.oZ2;
    const long row0 = (long)u.pm * BM + wr * 64 + fr; const int col0 = u.pn * BM + wc * 32 + 8 * fq;
    const long ldo = E.ldo;
#pragma unroll
    for (int ai = 0; ai < 2; ++ai)
#pragma unroll
        for (int m = 0; m < 4; ++m) {
            float scale = E.scale;
            if (E.ss_in != nullptr) scale *= rst[ai * 128 + wr * 64 + m * 16 + fr];
#pragma unroll
            for (int bj = 0; bj < 2; ++bj) {
                const f32x4 a0 = acc[ai][bj][m][0] * scale, a1 = acc[ai][bj][m][1] * scale;
                u32x4 pk; pk[0] = pk2(a0[0], a0[1]); pk[1] = pk2(a0[2], a0[3]); pk[2] = pk2(a1[0], a1[1]); pk[3] = pk2(a1[2], a1[3]);
                *(u32x4*)(base + (row0 + ai * HALF + m * 16) * ldo + col0 + bj * HALF) = pk;
            }
        }
}
__device__ __forceinline__ void epi_softmax(const Epi& E, AccT& acc, const Unit& u, int wr, int wc, int fr, int fq, const LAS float* rst) {
    bf16_t* base = E.O + (long)u.z * E.rowZ * 1024 + u.pn * 256;
    const long row0 = (long)u.pm * BM + wr * 64 + fr; const int col0 = wc * 32 + 8 * fq;
    LAS float* tab = E.tab; LAS float* tab2 = tab + 1024;
#pragma unroll
    for (int ai = 0; ai < 2; ++ai)
#pragma unroll
        for (int m = 0; m < 4; ++m) {
            const float rs = rst[ai * 128 + wr * 64 + m * 16 + fr];
            float v = -3.0e38f;
#pragma unroll
            for (int bj = 0; bj < 2; ++bj)
#pragma unroll
                for (int n = 0; n < 2; ++n)
#pragma unroll
                    for (int j = 0; j < 4; ++j) { acc[ai][bj][m][n][j] *= rs; v = fmaxf(v, acc[ai][bj][m][n][j]); }
            v = fmaxf(v, __shfl_xor(v, 16)); v = fmaxf(v, __shfl_xor(v, 32));
            if (fq == 0) tab[(ai * 128 + wr * 64 + m * 16 + fr) * 4 + wc] = v;
        }
    asm volatile("s_waitcnt lgkmcnt(0)" ::: "memory"); __builtin_amdgcn_s_barrier(); asm volatile("" ::: "memory");
#pragma unroll
    for (int ai = 0; ai < 2; ++ai)
#pragma unroll
        for (int m = 0; m < 4; ++m) {
            const int rl = ai * 128 + wr * 64 + m * 16 + fr;
            const f32x4 t4 = *(const LAS f32x4*)(tab + rl * 4);
            const float M = fmaxf(fmaxf(t4[0], t4[1]), fmaxf(t4[2], t4[3]));
            float sm = 0.f;
#pragma unroll
            for (int bj = 0; bj < 2; ++bj)
#pragma unroll
                for (int n = 0; n < 2; ++n)
#pragma unroll
                    for (int j = 0; j < 4; ++j) { const float e = __expf(acc[ai][bj][m][n][j] - M); acc[ai][bj][m][n][j] = e; sm += e; }
            sm += __shfl_xor(sm, 16); sm += __shfl_xor(sm, 32);
            if (fq == 0) tab2[rl * 4 + wc] = sm;
        }
    asm volatile("s_waitcnt lgkmcnt(0)" ::: "memory"); __builtin_amdgcn_s_barrier(); asm volatile("" ::: "memory");
#pragma unroll
    for (int ai = 0; ai < 2; ++ai)
#pragma unroll
        for (int m = 0; m < 4; ++m) {
            const int rl = ai * 128 + wr * 64 + m * 16 + fr;
            const f32x4 t4 = *(const LAS f32x4*)(tab2 + rl * 4);
            const float inv = 1.0f / (t4[0] + t4[1] + t4[2] + t4[3]);
#pragma unroll
            for (int bj = 0; bj < 2; ++bj) {
                const f32x4 a0 = acc[ai][bj][m][0] * inv, a1 = acc[ai][bj][m][1] * inv;
                u32x4 pk; pk[0] = pk2(a0[0], a0[1]); pk[1] = pk2(a0[2], a0[3]); pk[2] = pk2(a1[0], a1[1]); pk[3] = pk2(a1[2], a1[3]);
                *(u32x4*)(base + (row0 + ai * HALF + m * 16) * 1024 + col0 + bj * HALF) = pk;
            }
        }
}

template <int MODE>
__device__ __forceinline__ void gemm_phase(LAS unsigned char* lds, const GJob& g, const Epi& E, int G, int c) {
    const int tid = ltid();
    const int wid = __builtin_amdgcn_readfirstlane(tid >> 6), lane = tid & 63, wr = wid >> 2, wc = wid & 3, fr = lane & 15, fq = lane >> 4;
    const int K = g.K, nt = K / BK;
    unsigned voffA[2], voffB[2];
#pragma unroll
    for (int i = 0; i < 2; ++i) { int R, C; stage_rc(tid * 16 + i * 8192, R, C); const int Rb = (R & ~31) + perm32(R & 31);
        voffA[i] = (unsigned)(R * g.lda + C) * 2u; voffB[i] = (unsigned)(Rb * g.ldb + C) * 2u; }
    const size_t kstep = (size_t)(BK * 2);
    const size_t hstepA = (size_t)HALF * g.lda * 2, hstepB = (size_t)HALF * g.ldb * 2;
    const unsigned ldsw = (unsigned)wid * 1024u;
    const int aoff = lds_byte(wr * 64 + fr, fq * 8), boff = lds_byte(wc * 32 + fr, fq * 8);
#define PG8_SA(b, h) (((b) * 2 + (h)) * HTB)
#define PG8_SB(b, h) ((4 + (b) * 2 + (h)) * HTB)
#define PG8_STAGE(bufoff, gbase, voff) do { _Pragma("unroll") for (int _i = 0; _i < 2; ++_i) \
        __builtin_amdgcn_global_load_lds((const unsigned*)((const char*)(gbase) + (voff)[_i]), (LAS unsigned*)(lds + (bufoff) + ldsw + _i * 8192), 16, 0, 0); } while (0)
#define PG8_LDA(dst, b, h) do { _Pragma("unroll") for (int m = 0; m < 4; ++m) _Pragma("unroll") for (int k = 0; k < 2; ++k) dst[m][k] = *(const LAS bf16x8*)(lds + PG8_SA(b, h) + aoff + m * 2048 + k * 1024); } while (0)
#define PG8_LDB(dst, b, h) do { _Pragma("unroll") for (int n = 0; n < 2; ++n) _Pragma("unroll") for (int k = 0; k < 2; ++k) dst[n][k] = *(const LAS bf16x8*)(lds + PG8_SB(b, h) + boff + n * 2048 + k * 1024); } while (0)
#define PG8_MMA(ai, bj, At, Bt) do { __builtin_amdgcn_s_setprio(1); _Pragma("unroll") for (int m = 0; m < 4; ++m) _Pragma("unroll") for (int n = 0; n < 2; ++n) _Pragma("unroll") for (int k = 0; k < 2; ++k) \
        acc[ai][bj][m][n] = __builtin_amdgcn_mfma_f32_16x16x32_bf16(Bt[n][k], At[m][k], acc[ai][bj][m][n], 0, 0, 0); __builtin_amdgcn_s_setprio(0); } while (0)
#define PG8_WAIT_V(n) asm volatile("s_waitcnt vmcnt(" #n ")" ::: "memory")
#define PG8_WAIT_L(n) asm volatile("s_waitcnt lgkmcnt(" #n ")" ::: "memory")
#define PG8_BAR __builtin_amdgcn_s_barrier()
#define PG8_SCHED __builtin_amdgcn_sched_barrier(0)
    Unit cur, nxt; int ui = 0;
    LAS float* rstab = (LAS float*)(lds + 139264);
    if ((MODE == 0 || MODE == 2 || MODE == 3) && E.ss_in != nullptr) {
        for (int u0 = 0; u0 < 16; u0 += 2) {
            Unit uu; const int uidx = u0 + (tid >> 8);
            if (g_next(g, uidx, G, c, uu)) rstab[uidx * 256 + (tid & 255)] = row_rstd(E.ss_in, (long)(uu.z >> g.zshift) * g.rowZ + (long)uu.pm * BM + (tid & 255));
        }
        __syncthreads();
    }
    if (!g_next(g, 0, G, c, cur)) return;
    AccT acc;
#pragma unroll
    for (int a = 0; a < 2; ++a)
#pragma unroll
        for (int b = 0; b < 2; ++b)
#pragma unroll
            for (int m = 0; m < 4; ++m)
#pragma unroll
                for (int n = 0; n < 2; ++n) acc[a][b][m][n] = (f32x4){0.f, 0.f, 0.f, 0.f};
    bf16x8 At[4][2], B0[2][2], B1[2][2];
    const char* cA = g_aptr(g, cur); const char* cB = g_bptr(g, cur);
    PG8_STAGE(PG8_SB(0, 0), cB, voffB); PG8_STAGE(PG8_SA(0, 0), cA, voffA); PG8_STAGE(PG8_SB(0, 1), cB + hstepB, voffB); PG8_STAGE(PG8_SA(0, 1), cA + hstepA, voffA);
    if (wr == 1) PG8_BAR;
    PG8_WAIT_V(4); PG8_BAR;
    PG8_STAGE(PG8_SB(1, 0), cB + kstep, voffB); PG8_STAGE(PG8_SA(1, 0), cA + kstep, voffA); PG8_STAGE(PG8_SB(1, 1), cB + hstepB + kstep, voffB);
    PG8_WAIT_V(6); PG8_BAR;
    for (;;) {
        const bool has_next = g_next(g, ui + 1, G, c, nxt);
        const char* nA = has_next ? g_aptr(g, nxt) : cA; const char* nB = has_next ? g_bptr(g, nxt) : cB;
        for (int t = 0; t < nt; t += 2) {
            const bool last = (t == nt - 2);
            const char* a1 = cA + (size_t)(t + 1) * kstep;
            const char* a2 = last ? nA : cA + (size_t)(t + 2) * kstep; const char* b2 = last ? nB : cB + (size_t)(t + 2) * kstep;
            const char* a3 = a2 + kstep; const char* b3 = b2 + kstep;
            PG8_LDB(B0, 0, 0); PG8_SCHED; PG8_LDA(At, 0, 0); PG8_STAGE(PG8_SA(1, 1), a1 + hstepA, voffA);
            PG8_WAIT_L(8); PG8_BAR; PG8_WAIT_L(0); PG8_MMA(0, 0, At, B0); PG8_BAR; PG8_SCHED;
            PG8_LDB(B1, 0, 1); PG8_STAGE(PG8_SB(0, 0), b2, voffB);
            PG8_BAR; PG8_WAIT_L(0); PG8_MMA(0, 1, At, B1); PG8_BAR;
            PG8_LDA(At, 0, 1); PG8_STAGE(PG8_SA(0, 0), a2, voffA);
            PG8_BAR; PG8_WAIT_L(0); PG8_MMA(1, 0, At, B0); PG8_BAR; PG8_SCHED;
            PG8_STAGE(PG8_SB(0, 1), b2 + hstepB, voffB);
            PG8_WAIT_V(6); PG8_BAR; PG8_MMA(1, 1, At, B1); PG8_BAR;
            PG8_LDB(B0, 1, 0); PG8_SCHED; PG8_LDA(At, 1, 0); PG8_STAGE(PG8_SA(0, 1), a2 + hstepA, voffA);
            PG8_WAIT_L(8); PG8_BAR; PG8_WAIT_L(0); PG8_MMA(0, 0, At, B0); PG8_BAR; PG8_SCHED;
            PG8_LDB(B1, 1, 1); PG8_STAGE(PG8_SB(1, 0), b3, voffB);
            PG8_BAR; PG8_WAIT_L(0); PG8_MMA(0, 1, At, B1); PG8_BAR;
            PG8_LDA(At, 1, 1); PG8_STAGE(PG8_SA(1, 0), a3, voffA);
            PG8_BAR; PG8_WAIT_L(0); PG8_MMA(1, 0, At, B0); PG8_BAR; PG8_SCHED;
            PG8_STAGE(PG8_SB(1, 1), b3 + hstepB, voffB);
            PG8_WAIT_V(6); PG8_BAR; PG8_MMA(1, 1, At, B1); PG8_BAR;
        }
        if (MODE == 0) epi_swiglu(E, acc, cur, wr, wc, fr, fq, rstab + ui * 256); else if (MODE == 1) epi_resid(E, acc, cur, wr, wc, fr, fq);
        else if (MODE == 2) epi_bf16(E, acc, cur, wr, wc, fr, fq, rstab + ui * 256); else epi_softmax(E, acc, cur, wr, wc, fr, fq, rstab + ui * 256);
        if (!has_next) break;
#pragma unroll
        for (int a = 0; a < 2; ++a)
#pragma unroll
            for (int b = 0; b < 2; ++b)
#pragma unroll
                for (int m = 0; m < 4; ++m)
#pragma unroll
                    for (int n = 0; n < 2; ++n) acc[a][b][m][n] = (f32x4){0.f, 0.f, 0.f, 0.f};
        cur = nxt; cA = nA; cB = nB; ++ui;
    }
    PG8_WAIT_V(0);
    if (wr == 0) PG8_BAR;
    PG8_BAR;
#undef PG8_SA
#undef PG8_SB
#undef PG8_STAGE
#undef PG8_LDA
#undef PG8_LDB
#undef PG8_MMA
#undef PG8_WAIT_V
#undef PG8_WAIT_L
#undef PG8_BAR
#undef PG8_SCHED
}

__device__ __forceinline__ void phase_convert(int l, LAS unsigned char* lds, int t_lo, int t_hi) {
    LAS float* tl = (LAS float*)lds;
    const int tid = ltid();
    const long FW = 1024l * 2816;
    for (int tile = t_lo + blockIdx.x; tile < t_hi; tile += gridDim.x) {
        const float* src = nullptr; bf16_t* dst = nullptr; const float* gk = nullptr;
        int K = 64, N = 64, Gd = 64, rs = 0, roff = 0, local = 0;
        unsigned char* ws = WSP;
#define JOB(T0, NT, SRC, KK, NN, DST, GG, RS, RO, GK) if (tile >= (T0) && tile < (T0) + (NT)) { src = (SRC); K = (KK); N = (NN); dst = (bf16_t*)(DST); Gd = (GG); rs = (RS); roff = (RO); gk = (GK); local = tile - (T0); }
        JOB(0, 704, PIN(4) + l * FW, 1024, 2816, ws + WB_UP1, 128, 256, 0, PIN(3) + l * 1024)
        else JOB(704, 704, PIN(5) + l * FW, 1024, 2816, ws + WB_UP1, 128, 256, 128, PIN(3) + l * 1024)
        else JOB(1408, 704, PIN(6) + l * FW, 2816, 1024, ws + WB_DN1, 1024, 0, 0, nullptr)
        else JOB(2112, 960, PIN(8) + l * 1024l * 3840, 1024, 3840, ws + WB_IN, 3840, 0, 0, PIN(7) + l * 1024)
        else JOB(3072, 256, PIN(19) + l * 1024l * 1024, 1024, 1024, ws + WB_OUT, 1024, 0, 0, nullptr)
        else if (tile >= 3328 && tile < 3584) { continue; }
        else JOB(3584, 512, PIN(23) + l * 1024l * 2048, 1024, 2048, ws + WB_KV, 2048, 0, 0, nullptr)
        else JOB(4096, 256, PIN(24) + l * 1024l * 1024, 1024, 1024, ws + WB_O, 1024, 0, 0, nullptr)
        else JOB(4352, 704, PIN(26) + l * FW, 1024, 2816, ws + WB_UP2, 128, 256, 0, PIN(25) + l * 1024)
        else JOB(5056, 704, PIN(27) + l * FW, 1024, 2816, ws + WB_UP2, 128, 256, 128, PIN(25) + l * 1024)
        else JOB(5760, 704, PIN(28) + l * FW, 2816, 1024, ws + WB_DN2, 1024, 0, 0, nullptr)
        else if (tile < 6468) { const int nb = tile - 6464; src = PIN(14) + l * 16384 + nb * 4096; dst = (bf16_t*)(ws + WB_WA + nb * 8192); }
        else { const int nb = tile - 6468; src = PIN(16) + l * 16384 + nb * 4096; dst = (bf16_t*)(ws + WB_WX + nb * 8192); }
#undef JOB
        const int ntn = N / 64, k0 = (local / ntn) * 64, n0 = (local % ntn) * 64;
#pragma unroll
        for (int i = 0; i < 2; ++i) {
            const int idx = tid + i * 512, row = idx >> 4, c4 = idx & 15;
            f32x4 v = *(const f32x4*)(src + (long)(k0 + row) * N + n0 + c4 * 4);
            if (gk != nullptr) v = v * gk[k0 + row];
            tl[(c4 * 4 + 0) * 65 + row] = v[0]; tl[(c4 * 4 + 1) * 65 + row] = v[1]; tl[(c4 * 4 + 2) * 65 + row] = v[2]; tl[(c4 * 4 + 3) * 65 + row] = v[3];
        }
        __syncthreads();
        {
            const int n = tid >> 3, kk = (tid & 7) * 8, nn = n0 + n;
            const int drow = (nn / Gd) * rs + roff + (nn % Gd);
            u32x4 pk;
#pragma unroll
            for (int q = 0; q < 4; ++q) pk[q] = pk2(tl[n * 65 + kk + 2 * q], tl[n * 65 + kk + 2 * q + 1]);
            *(u32x4*)(dst + (long)drow * K + k0 + kk) = pk;
        }
        __syncthreads();
    }
}

__device__ __forceinline__ void phase_convert_straight(const float* src, const float* gk, bf16_t* dst) {
    const long gt = (long)blockIdx.x * NTHREADS + ltid();
    for (long v = gt; v < 131072; v += (long)gridDim.x * NTHREADS) {
        const int k = (int)(v >> 7);
        const f32x4 a = *(const f32x4*)(src + v * 8), b = *(const f32x4*)(src + v * 8 + 4);
        const float gg = gk[k];
        u32x4 pk; pk[0] = pk2(a[0] * gg, a[1] * gg); pk[1] = pk2(a[2] * gg, a[3] * gg); pk[2] = pk2(b[0] * gg, b[1] * gg); pk[3] = pk2(b[2] * gg, b[3] * gg);
        *(u32x4*)(dst + v * 8) = pk;
    }
}

__device__ __forceinline__ void phase_rope_table(const int* pos, float* cs, float* sn) {
    const long gt = (long)blockIdx.x * NTHREADS + ltid();
    for (long p = gt; p < 32768l * 48; p += (long)gridDim.x * NTHREADS) {
        const int t = (int)(p / 48), i = (int)(p % 48);
        const float inv_freq = __expf(-9.210340371976184f * (float)i * (1.0f / 48.0f));
        const float ang = (float)pos[t] * inv_freq;
        const float k = rintf(ang * 0.15915494309189535f);
        float r = fmaf(-k, 6.28125f, ang); r = fmaf(-k, 1.9353071795864769e-3f, r);
        cs[p] = __cosf(r); sn[p] = __sinf(r);
    }
}

__device__ __forceinline__ void phase_norm(const float* src, const float* g, bf16_t* dst, int nrows) {
    const int tid_ = ltid(); const int lane = tid_ & 63, gw = blockIdx.x * 8 + (tid_ >> 6), nw = gridDim.x * 8;
    for (int row = gw; row < nrows; row += nw) {
        const f32x4* pr = (const f32x4*)(src + (long)row * 1024);
        f32x4 v[4]; float ss = 0.f;
#pragma unroll
        for (int i = 0; i < 4; ++i) { v[i] = pr[lane + 64 * i]; ss += v[i][0] * v[i][0] + v[i][1] * v[i][1] + v[i][2] * v[i][2] + v[i][3] * v[i][3]; }
#pragma unroll
        for (int m = 32; m >= 1; m >>= 1) ss += __shfl_xor(ss, m);
        const float rstd = rsqrtf(ss * (1.0f / 1024.0f) + 1e-6f);
#pragma unroll
        for (int i = 0; i < 4; ++i) {
            const f32x4 gg = ((const f32x4*)g)[lane + 64 * i];
            u32x2 pk; pk[0] = pk2(v[i][0] * rstd * gg[0], v[i][1] * rstd * gg[1]); pk[1] = pk2(v[i][2] * rstd * gg[2], v[i][3] * rstd * gg[3]);
            *(u32x2*)(dst + (long)row * 1024 + (lane + 64 * i) * 4) = pk;
        }
    }
}
__device__ __forceinline__ void phase_prep(const float* src, bf16_t* dst, float* ss_out, int nrows) {
    const int tid_ = ltid(); const int lane = tid_ & 63, gw = blockIdx.x * 8 + (tid_ >> 6), nw = gridDim.x * 8;
    for (int row = gw; row < nrows; row += nw) {
        const f32x4* pr = (const f32x4*)(src + (long)row * 1024);
        f32x4 v[4]; float ss = 0.f;
#pragma unroll
        for (int i = 0; i < 4; ++i) { v[i] = pr[lane + 64 * i]; ss += v[i][0] * v[i][0] + v[i][1] * v[i][1] + v[i][2] * v[i][2] + v[i][3] * v[i][3]; }
#pragma unroll
        for (int m = 32; m >= 1; m >>= 1) ss += __shfl_xor(ss, m);
        if (lane < 16) ss_out[(long)row * 16 + lane] = (lane == 0) ? ss : 0.f;
#pragma unroll
        for (int i = 0; i < 4; ++i) { u32x2 pk; pk[0] = pk2(v[i][0], v[i][1]); pk[1] = pk2(v[i][2], v[i][3]); *(u32x2*)(dst + (long)row * 1024 + (lane + 64 * i) * 4) = pk; }
    }
}
__device__ __forceinline__ void phase_final_norm(const bf16_t* xb, float* out, const float* g, int nrows) {
    const int tid_ = ltid(); const int lane = tid_ & 63, gw = blockIdx.x * 8 + (tid_ >> 6), nw = gridDim.x * 8;
    for (int row = gw; row < nrows; row += nw) {
        float v[16]; float ss = 0.f;
#pragma unroll
        for (int i = 0; i < 2; ++i) {
            const u32x4 rv = *(const u32x4*)(xb + (long)row * 1024 + (lane + 64 * i) * 8);
#pragma unroll
            for (int q = 0; q < 4; ++q) { v[i * 8 + 2 * q] = lo16(rv[q]); v[i * 8 + 2 * q + 1] = hi16(rv[q]); }
        }
#pragma unroll
        for (int j = 0; j < 16; ++j) ss += v[j] * v[j];
#pragma unroll
        for (int m = 32; m >= 1; m >>= 1) ss += __shfl_xor(ss, m);
        const float rstd = rsqrtf(ss * (1.0f / 1024.0f) + 1e-6f);
#pragma unroll
        for (int i = 0; i < 2; ++i) {
            const f32x4 g0 = *(const f32x4*)(g + (lane + 64 * i) * 8), g1 = *(const f32x4*)(g + (lane + 64 * i) * 8 + 4);
            f32x4 o0, o1;
#pragma unroll
            for (int j = 0; j < 4; ++j) { o0[j] = v[i * 8 + j] * rstd * g0[j]; o1[j] = v[i * 8 + 4 + j] * rstd * g1[j]; }
            *(f32x4*)(out + (long)row * 1024 + (lane + 64 * i) * 8) = o0; *(f32x4*)(out + (long)row * 1024 + (lane + 64 * i) * 8 + 4) = o1;
        }
    }
}

__device__ __forceinline__ void lds_barrier() { asm volatile("s_waitcnt lgkmcnt(0)" ::: "memory"); __builtin_amdgcn_s_barrier(); asm volatile("" ::: "memory"); }
struct MixCtx {
    LAS unsigned char* lds;
    const bf16_t* proj;
    bf16_t* mix;
    bf16_t* sth; bf16_t* str; float* lasth;
    bf16_t* lrup; bf16_t* lruh; float* lrupe; float* lruhe; float* lruci;
    const bf16_t* waT; const bf16_t* wxT;
    const int* pos; const float* rcs; const float* rsn;
    const float* lb1;
    const float* ret_gn_g; const float* hg_lb; const float* hg_norm_g;
    const float* conv_w; const float* conv_b; const float* ba; const float* bx; const float* lam;
    int l;
};

template <bool M3>
__device__ __forceinline__ void hg_unit(const MixCtx& c, int unit) {
    LAS unsigned char* lds = c.lds;
    const int tid = ltid(), wid = tid >> 6, lane = tid & 63;
    const int h = unit & 3; const long row0 = (long)(unit >> 2) * 64;
    LAS float* cum = (LAS float*)lds;
    LAS float* Kb = (LAS float*)(lds + 65536);
    LAS bf16_t* inpT = (LAS bf16_t*)(lds + (M3 ? 102400 : 51200));
    float kk[2][8], qq[2][8];
    float lbv[8];
    if (c.l == 0) {
#pragma unroll
        for (int j = 0; j < 8; ++j) lbv[j] = 0.f;
    } else {
        const f32x4 la = *(const f32x4*)(c.lb1 + h * 128 + (tid & 15) * 8), lb = *(const f32x4*)(c.lb1 + h * 128 + (tid & 15) * 8 + 4);
#pragma unroll
        for (int j = 0; j < 4; ++j) { lbv[j] = la[j]; lbv[4 + j] = lb[j]; }
    }
    u32x4 stv[3]; unsigned gwv[6];
    if (M3) {
#pragma unroll
        for (int i = 0; i < 3; ++i) { const int v = tid + 512 * i; stv[i] = *(const u32x4*)(c.sth + (long)unit * 12288 + (v >> 4) * 128 + (v & 15) * 8); }
        const bf16_t* gp = c.proj + (row0 + (tid >> 3)) * 3840 + 2944 + h * 96 + (tid & 7) * 12;
#pragma unroll
        for (int j = 0; j < 6; ++j) gwv[j] = *(const unsigned*)(gp + 2 * j);
    }
#pragma unroll
    for (int i = 0; i < 2; ++i) {
        const int e8 = tid + 512 * i, t = e8 >> 4, d0 = (e8 & 15) * 8;
        const bf16_t* pr = c.proj + (row0 + t) * 3840;
        const u32x4 vf = *(const u32x4*)(pr + 2048 + h * 128 + d0);
        float xf[8]; UNPACK8(vf, xf);
#pragma unroll
        for (int j = 0; j < 8; ++j) {
            const float s = 1.0f / (1.0f + __expf(-xf[j]));
            const float f = lbv[j] + (1.0f - lbv[j]) * s;
            if (M3) kk[i][j] = 1.0f - f; else Kb[t * 128 + d0 + j] = 1.0f - f;
            cum[t * 128 + d0 + j] = __logf(f);
        }
        if (M3) {
            const u32x4 vq = *(const u32x4*)(pr + 1536 + h * 128 + d0);
            float xq[8]; UNPACK8(vq, xq);
#pragma unroll
            for (int j = 0; j < 8; ++j) qq[i][j] = silu(xq[j]);
        }
    }
    for (int v = tid; v < 768; v += 512) {
        const int t = v & 63, e0 = (v >> 6) * 8;
        const u32x4 vi = *(const u32x4*)(c.proj + (row0 + t) * 3840 + 2560 + h * 96 + e0);
#pragma unroll
        for (int j = 0; j < 4; ++j) { inpT[(e0 + 2 * j) * 72 + t] = (bf16_t)(vi[j] & 0xffffu); inpT[(e0 + 2 * j + 1) * 72 + t] = (bf16_t)(vi[j] >> 16); }
    }
    lds_barrier();
    {
        LAS float* ptot = (LAS float*)(lds + 152064);
        const int d = tid & 127, part = tid >> 7;
        float v[16]; float run = 0.f;
#pragma unroll
        for (int t = 0; t < 16; ++t) { v[t] = cum[(part * 16 + t) * 128 + d]; run += v[t]; }
        ptot[part * 128 + d] = run;
        lds_barrier();
        float base = 0.f;
#pragma unroll
        for (int pp = 0; pp < 3; ++pp) base += (pp < part) ? ptot[pp * 128 + d] : 0.f;
        if (M3) {
#pragma unroll
            for (int t = 0; t < 16; ++t) { base += v[t]; cum[(part * 16 + t) * 128 + d] = base; }
            if (part == 1) ((LAS float*)(lds + 154112))[d] = __expf(base);
        } else {
            const float last = (ptot[d] + ptot[128 + d]) + (ptot[256 + d] + ptot[384 + d]);
            LAS bf16_t* KlT = (LAS bf16_t*)(lds + 32768);
            float e[16];
#pragma unroll
            for (int t = 0; t < 16; ++t) { base += v[t]; e[t] = Kb[(part * 16 + t) * 128 + d] * __expf(last - base); }
            u32x4 p0, p1;
#pragma unroll
            for (int q2 = 0; q2 < 4; ++q2) { p0[q2] = pk2(e[2 * q2], e[2 * q2 + 1]); p1[q2] = pk2(e[8 + 2 * q2], e[8 + 2 * q2 + 1]); }
            *(LAS u32x4*)(KlT + d * 72 + part * 16) = p0; *(LAS u32x4*)(KlT + d * 72 + part * 16 + 8) = p1;
            if (part == 3) c.lasth[(long)unit * 128 + d] = last;
        }
    }
    lds_barrier();
    if (!M3) {
        LAS bf16_t* KlT = (LAS bf16_t*)(lds + 32768);
        LAS bf16_t* kvs = (LAS bf16_t*)(lds + 99328);
        const int r = lane & 15, q = lane >> 4;
        for (int i = 0; i < 6; ++i) {
            const int idx = wid + 8 * i, et = idx >> 3, dt = idx & 7;
            f32x4 acc = (f32x4){0.f, 0.f, 0.f, 0.f};
            acc = mma16(inpT + et * 16 * 72, 72, KlT + dt * 16 * 72, 72, 64, acc, lane);
#pragma unroll
            for (int j = 0; j < 4; ++j) kvs[(et * 16 + q * 4 + j) * 136 + dt * 16 + r] = f2bf(acc[j]);
        }
        lds_barrier();
#pragma unroll
        for (int i = 0; i < 3; ++i) {
            const int v = tid + 512 * i, e = v >> 4, d0 = (v & 15) * 8;
            *(u32x4*)(c.sth + (long)unit * 12288 + e * 128 + d0) = *(const LAS u32x4*)(kvs + e * 136 + d0);
        }
        lds_barrier();
    } else {
        LAS bf16_t* Qp = (LAS bf16_t*)(lds + 32768); LAS bf16_t* Qm = (LAS bf16_t*)(lds + 50176);
        LAS bf16_t* Kp = (LAS bf16_t*)(lds + 67584); LAS bf16_t* Km = (LAS bf16_t*)(lds + 84992);
        LAS bf16_t* stT = (LAS bf16_t*)(lds + 116224); LAS bf16_t* S = (LAS bf16_t*)(lds + 142336);
        LAS float* O = (LAS float*)lds;
        LAS float* ecr = (LAS float*)(lds + 154112);
#pragma unroll
        for (int i = 0; i < 2; ++i) {
            const int e8 = tid + 512 * i, t = e8 >> 4, d0 = (e8 & 15) * 8;
            float qp[8], qm[8], kp[8], km[8];
#pragma unroll
            for (int j = 0; j < 8; ++j) {
                const float cref = cum[31 * 128 + d0 + j], cc = cum[t * 128 + d0 + j];
                const float ep = __expf(cc - cref), em = __expf(cref - cc);
                qp[j] = qq[i][j] * ep; qm[j] = qq[i][j] * em; kp[j] = kk[i][j] * ep; km[j] = kk[i][j] * em;
            }
            u32x4 a, b, cc4, d;
#pragma unroll
            for (int j = 0; j < 4; ++j) { a[j] = pk2(qp[2 * j], qp[2 * j + 1]); b[j] = pk2(qm[2 * j], qm[2 * j + 1]); cc4[j] = pk2(kp[2 * j], kp[2 * j + 1]); d[j] = pk2(km[2 * j], km[2 * j + 1]); }
            *(LAS u32x4*)(Qp + t * 136 + d0) = a; *(LAS u32x4*)(Qm + t * 136 + d0) = b; *(LAS u32x4*)(Kp + t * 136 + d0) = cc4; *(LAS u32x4*)(Km + t * 136 + d0) = d;
        }
#pragma unroll
        for (int i = 0; i < 3; ++i) {
            const int v = tid + 512 * i, e = v >> 4, d0 = (v & 15) * 8;
            const u32x4 s = stv[i];
            float sf[8]; UNPACK8(s, sf);
            u32x4 o;
#pragma unroll
            for (int j = 0; j < 4; ++j) o[j] = pk2(sf[2 * j] * ecr[d0 + 2 * j], sf[2 * j + 1] * ecr[d0 + 2 * j + 1]);
            *(LAS u32x4*)(stT + e * 136 + d0) = o;
        }
        lds_barrier();
        const int r = lane & 15, q = lane >> 4;
        for (int i = 0; i < 2; ++i) {
            const int idx = wid * 2 + i, ti = idx >> 2, tj = idx & 3;
            f32x4 s1 = (f32x4){0.f, 0.f, 0.f, 0.f}, s2 = (f32x4){0.f, 0.f, 0.f, 0.f};
            if (ti >= tj) s1 = mma16(Qp + ti * 16 * 136, 136, Km + tj * 16 * 136, 136, 128, s1, lane);
            if (ti <= tj) s2 = mma16(Qm + ti * 16 * 136, 136, Kp + tj * 16 * 136, 136, 128, s2, lane);
#pragma unroll
            for (int j = 0; j < 4; ++j) {
                const int t = ti * 16 + q * 4 + j, jj = tj * 16 + r;
                S[t * 72 + jj] = f2bf(t >= jj ? s1[j] : s2[j]);
            }
        }
        lds_barrier();
        for (int i = 0; i < 3; ++i) {
            const int idx = wid * 3 + i, tt = idx / 6, et = idx % 6;
            f32x4 acc = (f32x4){0.f, 0.f, 0.f, 0.f};
            acc = mma16(S + tt * 16 * 72, 72, inpT + et * 16 * 72, 72, 64, acc, lane);
            acc = mma16(Qp + tt * 16 * 136, 136, stT + et * 16 * 136, 136, 128, acc, lane);
#pragma unroll
            for (int j = 0; j < 4; ++j) O[(tt * 16 + q * 4 + j) * 100 + et * 16 + r] = acc[j];
        }
        lds_barrier();
        {
            const int t = tid >> 3, sub = tid & 7;
            float o[12], ss = 0.f;
#pragma unroll
            for (int j = 0; j < 12; ++j) { o[j] = O[t * 100 + sub * 12 + j]; ss += o[j] * o[j]; }
            ss += __shfl_xor(ss, 1); ss += __shfl_xor(ss, 2); ss += __shfl_xor(ss, 4);
            const float rstd = rsqrtf(ss * (1.0f / 96.0f) + 1e-6f);
            bf16_t* op = c.mix + (row0 + t) * 1024 + 384 + h * 96 + sub * 12;
            const float* gg = c.hg_norm_g + h * 96 + sub * 12;
#pragma unroll
            for (int j = 0; j < 6; ++j) {
                const unsigned gw = gwv[j];
                const float y0 = o[2 * j] * rstd * gg[2 * j] * silu(lo16(gw)), y1 = o[2 * j + 1] * rstd * gg[2 * j + 1] * silu(hi16(gw));
                *(unsigned*)(op + 2 * j) = pk2(y0, y1);
            }
        }
        lds_barrier();
    }
}

__device__ __forceinline__ void rope_tables(const MixCtx& c, long row0, LAS float* cs, LAS float* sn) {
    for (int p = ltid(); p < 3072; p += 512) {
        const int t = p / 48, i = p % 48;
        const float inv_freq = __expf(-9.210340371976184f * (float)i * (1.0f / 48.0f));
        const float ang = (float)c.pos[row0 + t] * inv_freq;
        const float k = rintf(ang * 0.15915494309189535f);
        float r = fmaf(-k, 6.28125f, ang); r = fmaf(-k, 1.9353071795864769e-3f, r);
        cs[p] = __cosf(r); sn[p] = __sinf(r);
    }
}
template <bool M3>
__device__ __forceinline__ void ret_unit(const MixCtx& c, int unit) {
    LAS unsigned char* lds = c.lds;
    const int tid = ltid(), wid = tid >> 6, lane = tid & 63;
    const int h = unit & 3; const long row0 = (long)(unit >> 2) * 64;
    const float lg = log1pf(-exp2f(-5.0f - (float)h));
    LAS float* cs = (LAS float*)lds; LAS float* sn = (LAS float*)(lds + 12288);
    u32x4 stv[3]; unsigned gwv[6];
    if (M3) {
#pragma unroll
        for (int i = 0; i < 3; ++i) { const int v = tid + 512 * i; if (v < 1152) stv[i] = *(const u32x4*)(c.str + (long)unit * 9216 + (v / 12) * 96 + (v % 12) * 8); }
        const bf16_t* gp = c.proj + (row0 + (tid >> 3)) * 3840 + 1152 + h * 96 + (tid & 7) * 12;
#pragma unroll
        for (int j = 0; j < 6; ++j) gwv[j] = *(const unsigned*)(gp + 2 * j);
    }
    LAS bf16_t* vT = (LAS bf16_t*)(lds + 51200);
    for (int v = tid; v < 768; v += 512) {
        const int t = v & 63, e0 = (v >> 6) * 8;
        const u32x4 vi = *(const u32x4*)(c.proj + (row0 + t) * 3840 + 768 + h * 96 + e0);
#pragma unroll
        for (int j = 0; j < 4; ++j) { vT[(e0 + 2 * j) * 72 + t] = (bf16_t)(vi[j] & 0xffffu); vT[(e0 + 2 * j + 1) * 72 + t] = (bf16_t)(vi[j] >> 16); }
    }
    const int r = lane & 15, q = lane >> 4;
    if (!M3) {
        LAS bf16_t* KdT = (LAS bf16_t*)(lds + 24576);
        if (tid < 384) {
            const int j = tid & 63, i0 = (tid >> 6) * 8;
            const bf16_t* kp = c.proj + (row0 + j) * 3840 + 384 + h * 96;
            const u32x4 v1 = *(const u32x4*)(kp + i0), v2 = *(const u32x4*)(kp + 48 + i0);
            float k1[8], k2[8]; UNPACK8(v1, k1); UNPACK8(v2, k2);
            const float dec = __expf(lg * (float)(63 - j));
            const f32x4 c0 = *(const f32x4*)(c.rcs + (row0 + j) * 48 + i0), c1 = *(const f32x4*)(c.rcs + (row0 + j) * 48 + i0 + 4);
            const f32x4 s0 = *(const f32x4*)(c.rsn + (row0 + j) * 48 + i0), s1 = *(const f32x4*)(c.rsn + (row0 + j) * 48 + i0 + 4);
#pragma unroll
            for (int e = 0; e < 8; ++e) {
                const float co = (e < 4) ? c0[e & 3] : c1[e & 3], si = (e < 4) ? s0[e & 3] : s1[e & 3];
                KdT[(i0 + e) * 72 + j] = f2bf((k1[e] * co - k2[e] * si) * dec);
                KdT[(48 + i0 + e) * 72 + j] = f2bf((k1[e] * si + k2[e] * co) * dec);
            }
        }
        lds_barrier();
        LAS bf16_t* kvs = (LAS bf16_t*)(lds + 65536);
        for (int i = 0; i < 5; ++i) {
            const int idx = wid + 8 * i;
            if (idx < 36) {
                const int et = idx / 6, dt = idx % 6;
                f32x4 acc = (f32x4){0.f, 0.f, 0.f, 0.f};
                acc = mma16(vT + et * 16 * 72, 72, KdT + dt * 16 * 72, 72, 64, acc, lane);
#pragma unroll
                for (int j = 0; j < 4; ++j) kvs[(et * 16 + q * 4 + j) * 104 + dt * 16 + r] = f2bf(acc[j]);
            }
        }
        lds_barrier();
#pragma unroll
        for (int i = 0; i < 3; ++i) { const int v = tid + 512 * i; if (v < 1152) *(u32x4*)(c.str + (long)unit * 9216 + (v / 12) * 96 + (v % 12) * 8) = *(const LAS u32x4*)(kvs + (v / 12) * 104 + (v % 12) * 8); }
        lds_barrier();
    } else {
        LAS bf16_t* Qr = (LAS bf16_t*)(lds + 24576); LAS bf16_t* Kr = (LAS bf16_t*)(lds + 37888);
        LAS bf16_t* stT = (LAS bf16_t*)(lds + 65024);
        LAS bf16_t* S = (LAS bf16_t*)(lds + 84992);
        LAS float* O = (LAS float*)(lds + 94208);
        if (tid < 384) {
            const int j = tid / 6, i0 = (tid % 6) * 8;
            const bf16_t* qp = c.proj + (row0 + j) * 3840 + h * 96;
            const bf16_t* kp = qp + 384;
            const u32x4 vq1 = *(const u32x4*)(qp + i0), vq2 = *(const u32x4*)(qp + 48 + i0), vk1 = *(const u32x4*)(kp + i0), vk2 = *(const u32x4*)(kp + 48 + i0);
            float q1[8], q2[8], k1[8], k2[8]; UNPACK8(vq1, q1); UNPACK8(vq2, q2); UNPACK8(vk1, k1); UNPACK8(vk2, k2);
            const float sc = 0.10206207261596575f;
            float qa[8], qb[8], ka[8], kb[8];
            const f32x4 c0 = *(const f32x4*)(c.rcs + (row0 + j) * 48 + i0), c1 = *(const f32x4*)(c.rcs + (row0 + j) * 48 + i0 + 4);
            const f32x4 s0 = *(const f32x4*)(c.rsn + (row0 + j) * 48 + i0), s1 = *(const f32x4*)(c.rsn + (row0 + j) * 48 + i0 + 4);
#pragma unroll
            for (int e = 0; e < 8; ++e) {
                const float co = (e < 4) ? c0[e & 3] : c1[e & 3], si = (e < 4) ? s0[e & 3] : s1[e & 3];
                qa[e] = (q1[e] * co - q2[e] * si) * sc; qb[e] = (q1[e] * si + q2[e] * co) * sc;
                ka[e] = k1[e] * co - k2[e] * si; kb[e] = k1[e] * si + k2[e] * co;
            }
            u32x4 o1, o2, o3, o4;
#pragma unroll
            for (int e = 0; e < 4; ++e) { o1[e] = pk2(qa[2 * e], qa[2 * e + 1]); o2[e] = pk2(qb[2 * e], qb[2 * e + 1]); o3[e] = pk2(ka[2 * e], ka[2 * e + 1]); o4[e] = pk2(kb[2 * e], kb[2 * e + 1]); }
            *(LAS u32x4*)(Qr + j * 104 + i0) = o1; *(LAS u32x4*)(Qr + j * 104 + 48 + i0) = o2;
            *(LAS u32x4*)(Kr + j * 104 + i0) = o3; *(LAS u32x4*)(Kr + j * 104 + 48 + i0) = o4;
        }
#pragma unroll
        for (int i = 0; i < 3; ++i) { const int v = tid + 512 * i; if (v < 1152) *(LAS u32x4*)(stT + (v / 12) * 104 + (v % 12) * 8) = stv[i]; }
        lds_barrier();
        for (int i = 0; i < 2; ++i) {
            const int idx = wid * 2 + i, ti = idx >> 2, tj = idx & 3;
            f32x4 s = (f32x4){0.f, 0.f, 0.f, 0.f};
            s = mma16(Qr + ti * 16 * 104, 104, Kr + tj * 16 * 104, 104, 96, s, lane);
#pragma unroll
            for (int j = 0; j < 4; ++j) {
                const int t = ti * 16 + q * 4 + j, jj = tj * 16 + r;
                const int dd = t > jj ? t - jj : jj - t;
                S[t * 72 + jj] = f2bf(s[j] * __expf(lg * (float)dd));
            }
        }
        lds_barrier();
        for (int i = 0; i < 3; ++i) {
            const int idx = wid * 3 + i, tt = idx / 6, et = idx % 6;
            f32x4 a1 = (f32x4){0.f, 0.f, 0.f, 0.f}, a2 = (f32x4){0.f, 0.f, 0.f, 0.f};
            a1 = mma16(S + tt * 16 * 72, 72, vT + et * 16 * 72, 72, 64, a1, lane);
            a2 = mma16(Qr + tt * 16 * 104, 104, stT + et * 16 * 104, 104, 96, a2, lane);
#pragma unroll
            for (int j = 0; j < 4; ++j) { const int t = tt * 16 + q * 4 + j; O[t * 100 + et * 16 + r] = a1[j] + __expf(lg * (float)(t + 1)) * a2[j]; }
        }
        lds_barrier();
        {
            const int t = tid >> 3, sub = tid & 7;
            float o[12], sm = 0.f;
#pragma unroll
            for (int j = 0; j < 12; ++j) { o[j] = O[t * 100 + sub * 12 + j]; sm += o[j]; }
            sm += __shfl_xor(sm, 1); sm += __shfl_xor(sm, 2); sm += __shfl_xor(sm, 4);
            const float mean = sm * (1.0f / 96.0f);
            float ss = 0.f;
#pragma unroll
            for (int j = 0; j < 12; ++j) { o[j] -= mean; ss += o[j] * o[j]; }
            ss += __shfl_xor(ss, 1); ss += __shfl_xor(ss, 2); ss += __shfl_xor(ss, 4);
            const float rstd = rsqrtf(ss * (1.0f / 96.0f) + 1e-6f);
            bf16_t* op = c.mix + (row0 + t) * 1024 + h * 96 + sub * 12;
            const float* gg = c.ret_gn_g + h * 96 + sub * 12;
#pragma unroll
            for (int j = 0; j < 6; ++j) {
                const unsigned gw = gwv[j];
                const float y0 = o[2 * j] * rstd * gg[2 * j] * silu(lo16(gw)), y1 = o[2 * j + 1] * rstd * gg[2 * j + 1] * silu(hi16(gw));
                *(unsigned*)(op + 2 * j) = pk2(y0, y1);
            }
        }
        lds_barrier();
    }
}

__device__ __forceinline__ void lru_m1(const MixCtx& c, int unit) {
    LAS unsigned char* lds = c.lds;
    const int tid = ltid(), wid = tid >> 6, lane = tid & 63;
    const int hh = unit & 1, bn = unit >> 1, n = bn & 127; const long row0 = (long)bn * 64; const int c0 = hh * 128;
    LAS float* xc = (LAS float*)lds; LAS float* Aa = (LAS float*)(lds + 32768); LAS bf16_t* xcb = (LAS bf16_t*)(lds + 65536);
    LAS bf16_t* lxs = (LAS bf16_t*)(lds + 83968);
    for (int v = tid; v < 67 * 16; v += 512) {
        const int rr = v >> 4, cc = (v & 15) * 8, tt = rr - 3;
        u32x4 val = (u32x4){0u, 0u, 0u, 0u};
        if (n * 64 + tt >= 0) val = *(const u32x4*)(c.proj + (row0 + tt) * 3840 + 3328 + c0 + cc);
        *(LAS u32x4*)(lxs + rr * 128 + cc) = val;
    }
    LAS bf16_t* wsm = (LAS bf16_t*)(lds + 101376);
#pragma unroll
    for (int i = 0; i < 4; ++i) {
        const int v = tid + 512 * i, mat = v >> 10, nbl = (v >> 9) & 1, d = (v >> 3) & 63, c8 = (v & 7) * 8;
        const u32x4 val = *(const u32x4*)((mat ? c.wxT : c.waT) + (hh * 2 + nbl) * 4096 + d * 64 + c8);
        *(LAS u32x4*)(wsm + ((mat * 2 + nbl) * 64 + d) * 72 + c8) = val;
    }
    const int cc = tid & 127, ch = c0 + cc;
    const float cw0 = c.conv_w[ch], cw1 = c.conv_w[256 + ch], cw2 = c.conv_w[512 + ch], cw3 = c.conv_w[768 + ch], cbv = c.conv_b[ch];
    lds_barrier();
#pragma unroll
    for (int i = 0; i < 16; ++i) {
        const int t = (tid >> 7) + 4 * i;
        const float acc = cbv + cw0 * bf2f(lxs[t * 128 + cc]) + cw1 * bf2f(lxs[(t + 1) * 128 + cc]) + cw2 * bf2f(lxs[(t + 2) * 128 + cc]) + cw3 * bf2f(lxs[(t + 3) * 128 + cc]);
        xc[t * 128 + cc] = acc; xcb[t * 136 + cc] = f2bf(acc);
    }
    lds_barrier();
    const int r = lane & 15, q = lane >> 4;
    for (int i = 0; i < 4; ++i) {
        const int idx = wid * 4 + i, nbl = idx >> 4, tt = (idx >> 2) & 3, dt = idx & 3;
        f32x4 ar = (f32x4){0.f, 0.f, 0.f, 0.f}, ai = (f32x4){0.f, 0.f, 0.f, 0.f};
#pragma unroll
        for (int k0 = 0; k0 < 64; k0 += 32) {
            const bf16x8 a = *(const LAS bf16x8*)(xcb + (tt * 16 + r) * 136 + nbl * 64 + k0 + q * 8);
            const bf16x8 b1 = *(const LAS bf16x8*)(wsm + ((0 + nbl) * 64 + dt * 16 + r) * 72 + k0 + q * 8);
            const bf16x8 b2 = *(const LAS bf16x8*)(wsm + ((2 + nbl) * 64 + dt * 16 + r) * 72 + k0 + q * 8);
            ar = __builtin_amdgcn_mfma_f32_16x16x32_bf16(a, b1, ar, 0, 0, 0);
            ai = __builtin_amdgcn_mfma_f32_16x16x32_bf16(a, b2, ai, 0, 0, 0);
        }
        const int c2 = nbl * 64 + dt * 16 + r, ch2 = c0 + c2;
        const float sp = log1pf(expf(-c.lam[ch2])), bav = c.ba[ch2], bxv = c.bx[ch2];
#pragma unroll
        for (int j = 0; j < 4; ++j) {
            const int t = tt * 16 + q * 4 + j;
            const float rr = 1.0f / (1.0f + __expf(-(ar[j] + bav))), ii = 1.0f / (1.0f + __expf(-(ai[j] + bxv)));
            const float la = -8.0f * sp * rr;
            const float a = __expf(la);
            const float u = sqrtf(fmaxf(1.0f - a * a, 0.f)) * ii * xc[t * 128 + c2];
            Aa[t * 128 + c2] = a; xc[t * 128 + c2] = u;
        }
    }
    lds_barrier();
    {
        LAS float* pt = (LAS float*)(lds + 138240);
        const int part = tid >> 7;
        float hs = 0.f, P = 1.f;
#pragma unroll
        for (int t = part * 16; t < part * 16 + 16; ++t) {
            const float a = Aa[t * 128 + cc], u = xc[t * 128 + cc];
            hs = a * hs + u; P *= a;
            xc[t * 128 + cc] = hs; Aa[t * 128 + cc] = P;
        }
        pt[part * 128 + cc] = P; pt[512 + part * 128 + cc] = hs;
        lds_barrier();
        float ch_ = 0.f, cP = 1.f;
#pragma unroll
        for (int pp = 0; pp < 3; ++pp) if (pp < part) { const float Pp = pt[pp * 128 + cc], hp = pt[512 + pp * 128 + cc]; ch_ = Pp * ch_ + hp; cP *= Pp; }
        if (part > 0) {
#pragma unroll
            for (int t = part * 16; t < part * 16 + 16; ++t) {
                const float Pl = Aa[t * 128 + cc];
                xc[t * 128 + cc] += Pl * ch_; Aa[t * 128 + cc] = Pl * cP;
            }
        }
        if (part == 3) { c.lruhe[(long)bn * 256 + ch] = xc[63 * 128 + cc]; c.lrupe[(long)bn * 256 + ch] = Aa[63 * 128 + cc]; }
    }
    lds_barrier();
#pragma unroll
    for (int i = 0; i < 2; ++i) {
        const int v = tid + 512 * i, t = v >> 4, c8 = (v & 15) * 8;
        const f32x4 h0 = *(const LAS f32x4*)(xc + t * 128 + c8), h1 = *(const LAS f32x4*)(xc + t * 128 + c8 + 4);
        const f32x4 p0 = *(const LAS f32x4*)(Aa + t * 128 + c8), p1 = *(const LAS f32x4*)(Aa + t * 128 + c8 + 4);
        u32x4 ph, pp; ph[0] = pk2(h0[0], h0[1]); ph[1] = pk2(h0[2], h0[3]); ph[2] = pk2(h1[0], h1[1]); ph[3] = pk2(h1[2], h1[3]);
        pp[0] = pk2(p0[0], p0[1]); pp[1] = pk2(p0[2], p0[3]); pp[2] = pk2(p1[0], p1[1]); pp[3] = pk2(p1[2], p1[3]);
        *(u32x4*)(c.lruh + (row0 + t) * 256 + c0 + c8) = ph; *(u32x4*)(c.lrup + (row0 + t) * 256 + c0 + c8) = pp;
    }
    lds_barrier();
}
__device__ __forceinline__ void lru_m3(const MixCtx& c, int bn) {
    const int tid = ltid(); const long row0 = (long)bn * 64;
#pragma unroll
    for (int i = 0; i < 4; ++i) {
        const int v = tid + 512 * i, t = v >> 5, cc = (v & 31) * 8;
        const u32x4 hv = *(const u32x4*)(c.lruh + (row0 + t) * 256 + cc);
        const u32x4 pv = *(const u32x4*)(c.lrup + (row0 + t) * 256 + cc);
        const u32x4 gv = *(const u32x4*)(c.proj + (row0 + t) * 3840 + 3584 + cc);
        const f32x4 ca = *(const f32x4*)(c.lruci + (long)bn * 256 + cc), cb = *(const f32x4*)(c.lruci + (long)bn * 256 + cc + 4);
        float hf[8], pf[8], gf[8]; UNPACK8(hv, hf); UNPACK8(pv, pf); UNPACK8(gv, gf);
        float o[8];
#pragma unroll
        for (int j = 0; j < 4; ++j) { o[j] = (hf[j] + pf[j] * ca[j]) * gelu_tanh(gf[j]); o[4 + j] = (hf[4 + j] + pf[4 + j] * cb[j]) * gelu_tanh(gf[4 + j]); }
        u32x4 pk; pk[0] = pk2(o[0], o[1]); pk[1] = pk2(o[2], o[3]); pk[2] = pk2(o[4], o[5]); pk[3] = pk2(o[6], o[7]);
        *(u32x4*)(c.mix + (row0 + t) * 1024 + 768 + cc) = pk;
    }
}

__device__ __forceinline__ void phase_scan(const MixCtx& c) {
    const long gt = (long)blockIdx.x * NTHREADS + ltid();
    if (gt < 49152) {
        const int bh = (int)(gt / 3072), g4 = (int)(gt % 3072), b = bh >> 2, h = bh & 3, d0 = (g4 * 4) & 127;
        float s0 = 0.f, s1 = 0.f, s2 = 0.f, s3 = 0.f;
        for (int n0 = 0; n0 < 128; n0 += 8) {
            u32x2 kv[8]; f32x4 la[8];
#pragma unroll
            for (int i = 0; i < 8; ++i) {
                const long unit = ((long)(b * 128 + n0 + i)) * 4 + h;
                kv[i] = *(const u32x2*)(c.sth + unit * 12288 + g4 * 4);
                la[i] = *(const f32x4*)(c.lasth + unit * 128 + d0);
            }
#pragma unroll
            for (int i = 0; i < 8; ++i) {
                const long unit = ((long)(b * 128 + n0 + i)) * 4 + h;
                u32x2 o; o[0] = pk2(s0, s1); o[1] = pk2(s2, s3); *(u32x2*)(c.sth + unit * 12288 + g4 * 4) = o;
                s0 = __expf(la[i][0]) * s0 + lo16(kv[i][0]); s1 = __expf(la[i][1]) * s1 + hi16(kv[i][0]);
                s2 = __expf(la[i][2]) * s2 + lo16(kv[i][1]); s3 = __expf(la[i][3]) * s3 + hi16(kv[i][1]);
            }
        }
    } else if (gt < 49152 + 36864) {
        const long g = gt - 49152; const int bh = (int)(g / 2304), g4 = (int)(g % 2304), b = bh >> 2, h = bh & 3;
        const float dec = expf(64.0f * log1pf(-exp2f(-5.0f - (float)h)));
        float s0 = 0.f, s1 = 0.f, s2 = 0.f, s3 = 0.f;
        for (int n0 = 0; n0 < 128; n0 += 8) {
            u32x2 kv[8];
#pragma unroll
            for (int i = 0; i < 8; ++i) { const long unit = ((long)(b * 128 + n0 + i)) * 4 + h; kv[i] = *(const u32x2*)(c.str + unit * 9216 + g4 * 4); }
#pragma unroll
            for (int i = 0; i < 8; ++i) {
                const long unit = ((long)(b * 128 + n0 + i)) * 4 + h;
                u32x2 o; o[0] = pk2(s0, s1); o[1] = pk2(s2, s3); *(u32x2*)(c.str + unit * 9216 + g4 * 4) = o;
                s0 = dec * s0 + lo16(kv[i][0]); s1 = dec * s1 + hi16(kv[i][0]); s2 = dec * s2 + lo16(kv[i][1]); s3 = dec * s3 + hi16(kv[i][1]);
            }
        }
    } else if (gt < 49152 + 36864 + 1024) {
        const int g = (int)(gt - 49152 - 36864), b = g >> 8, ch = g & 255;
        float carry = 0.f;
        for (int n0 = 0; n0 < 128; n0 += 8) {
            float pe[8], he[8];
#pragma unroll
            for (int i = 0; i < 8; ++i) { const long o = (long)(b * 128 + n0 + i) * 256 + ch; pe[i] = c.lrupe[o]; he[i] = c.lruhe[o]; }
#pragma unroll
            for (int i = 0; i < 8; ++i) { const long o = (long)(b * 128 + n0 + i) * 256 + ch; c.lruci[o] = carry; carry = pe[i] * carry + he[i]; }
        }
    }
}

#define XB_TMO      128
#define XB_XCNT(j)  (256  + 64 * (j))
#define XB_XSUB(j)  (1280 + 64 * (j))
#define XB_XGEN(j)  (2304 + 64 * (j))
#define XB_TOP      3328
#define XB_TOPGEN   3392
#define XCD_BAR_WORDS 3456
#define XB_SPIN_CAP (1u << 18)
__device__ __forceinline__ unsigned xb_ld(unsigned* p)              { return __hip_atomic_load(p, __ATOMIC_RELAXED, __HIP_MEMORY_SCOPE_AGENT); }
__device__ __forceinline__ unsigned xb_add(unsigned* p, unsigned v) { return __hip_atomic_fetch_add(p, v, __ATOMIC_RELAXED, __HIP_MEMORY_SCOPE_AGENT); }
__device__ __forceinline__ unsigned xb_xcc_id() { return (unsigned)__builtin_amdgcn_s_getreg((3 << 11) | 20) & 0xFu; }
#define XB_SPIN(cond, bar) do { unsigned _sp = 0; while (cond) { __builtin_amdgcn_s_sleep(1); \
    if ((++_sp & 255u) == 0u) { if (xb_ld(&(bar)[XB_TMO])) break; if (_sp > XB_SPIN_CAP) { atomicAdd(&(bar)[XB_TMO], 1u); break; } } } } while (0)
struct XcdBarrier { unsigned* bar; unsigned x; volatile LAS unsigned* st; };
__device__ __forceinline__ XcdBarrier xcd_barrier_post(unsigned* bar, volatile LAS unsigned* st) {
    XcdBarrier b; b.bar = bar; b.x = xb_xcc_id(); b.st = st;
    if (threadIdx.x == 0) (void)xb_add(&bar[XB_XCNT(b.x)], 1u);
    return b;
}
__device__ __forceinline__ void xcd_barrier_complete(unsigned* bar, unsigned x, unsigned& nloc, unsigned& nx) {
    const unsigned G = gridDim.x * gridDim.y * gridDim.z;
    unsigned sum, cnt, mine, sp = 0u;
    for (;;) {
        sum = 0u; cnt = 0u; mine = 0u;
#pragma unroll
        for (unsigned j = 0; j < 16; ++j) { const unsigned c = xb_ld(&bar[XB_XCNT(j)]); sum += c; cnt += (c > 0u) ? 1u : 0u; mine = (j == x) ? c : mine; }
        if (sum == G) break;
        __builtin_amdgcn_s_sleep(1);
        if ((++sp & 255u) == 0u) { if (xb_ld(&bar[XB_TMO])) break; if (sp > XB_SPIN_CAP) { atomicAdd(&bar[XB_TMO], 1u); break; } }
    }
    nloc = mine > 0u ? mine : 1u; nx = cnt > 0u ? cnt : 1u;
}
__device__ __forceinline__ void xcd_barrier(const XcdBarrier& b) {
    asm volatile("s_waitcnt vmcnt(0)" ::: "memory");
    __syncthreads();
    if (threadIdx.x == 0) {
        unsigned* bar = b.bar;
        __builtin_amdgcn_s_waitcnt(0);
        unsigned nloc = b.st[0], nx = b.st[1];
        if (nloc == 0u) { xcd_barrier_complete(bar, b.x, nloc, nx); b.st[0] = nloc; b.st[1] = nx; }
        const unsigned old = xb_add(&bar[XB_XSUB(b.x)], 1u);
        const unsigned gen = old / nloc;
        if (old + 1u == (gen + 1u) * nloc) {
            __builtin_amdgcn_fence(__ATOMIC_RELEASE, "agent");
            asm volatile("s_waitcnt vmcnt(0)" ::: "memory");
            const unsigned og = xb_add(&bar[XB_TOP], 1u);
            const unsigned tg = og / nx;
            if (og + 1u == (tg + 1u) * nx) xb_add(&bar[XB_TOPGEN], 1u);
            else XB_SPIN(xb_ld(&bar[XB_TOPGEN]) == tg, bar);
            __builtin_amdgcn_fence(__ATOMIC_ACQUIRE, "agent");
            xb_add(&bar[XB_XGEN(b.x)], 1u);
            asm volatile("s_waitcnt vmcnt(0)" ::: "memory");
        } else {
            XB_SPIN(xb_ld(&bar[XB_XGEN(b.x)]) == gen, bar);
            __builtin_amdgcn_fence(__ATOMIC_ACQUIRE, "agent");
            asm volatile("s_waitcnt vmcnt(0)" ::: "memory");
        }
    }
    __syncthreads();
}

__global__ void __launch_bounds__(NTHREADS) mega(Params p) {
    extern __shared__ __attribute__((aligned(16))) unsigned char shm[];
    LAS unsigned char* lds = (LAS unsigned char*)shm;
    cg::grid_group grid = cg::this_grid();
    const int G = gridDim.x, cb = blockIdx.x;
    volatile LAS unsigned* xst = (volatile LAS unsigned*)(lds + LDS_BYTES - 16);
    if (threadIdx.x < 2) xst[threadIdx.x] = 0u;
    __syncthreads();
    const XcdBarrier xb = xcd_barrier_post((unsigned*)(WSP + WS_BAR), xst);
#define ws WSP
#define BIG ((bf16_t*)(WSP + WS_BIG))
#define Hb ((bf16_t*)XOUT)
#define XB ((bf16_t*)(WSP + WS_H))
#define MEMN ((bf16_t*)(WSP + WS_MEMN))
#define KMEM ((bf16_t*)(WSP + WS_KMEM))
#define KV ((bf16_t*)(WSP + WS_KMEM))
#define MBT ((bf16_t*)(WSP + WS_MBT))
#define VWT ((bf16_t*)(WSP + WS_VWT))
#define VT ((bf16_t*)(WSP + WS_VT))
#define Qb (BIG + 32768l * 1024)
#define Pb (BIG + 2 * 32768l * 1024)
#define SSP(i) ((float*)(WSP + WS_SS) + (long)((i) & 1) * 32768 * 16)
#define X XOUT

    for (int ph = 0; ph < 38; ++ph) {
        const int l = ph / 19, k = ph % 19;

        GJob g{}; Epi E{}; bool is_gemm = true;
        g.lda = 1024; g.ldb = 1024; g.K = 1024; g.nM = 128; g.nN = 4; g.nZ = 1; E.scale = 1.0f; E.ldo = 1024;
        const float* ng = nullptr;
        switch (k) {
            case 1: g.A = XB; g.Bt = (const bf16_t*)(ws + WB_UP1); g.nN = 22; E.O = BIG; E.ss_in = SSP(l * 4 + 0); for (int rr = 0; rr < REP_GEMM; ++rr) { PH(2) gemm_phase<0>(lds, g, E, G, cb); } break;
            case 17: g.A = XB; g.Bt = (const bf16_t*)(ws + WB_UP2); g.nN = 22; E.O = BIG; E.ss_in = SSP(l * 4 + 3); for (int rr = 0; rr < REP_GEMM; ++rr) { PH(18) gemm_phase<0>(lds, g, E, G, cb); } break;
            case 2: case 3: continue;
            case 4: g.A = BIG; g.Bt = (const bf16_t*)(ws + WB_DN1); g.lda = 2816; g.ldb = 2816; g.K = 2816; E.resb = XB; E.scale = 0.5f; E.ss_out = SSP(l * 4 + 1); for (int rr = 0; rr < REP_GEMM; ++rr) { E.O = (rr == REP_GEMM - 1) ? XB : Hb; PH(4) gemm_phase<1>(lds, g, E, G, cb); } break;
            case 18: g.A = BIG; g.Bt = (const bf16_t*)(ws + WB_DN2); g.lda = 2816; g.ldb = 2816; g.K = 2816; E.resb = XB; E.scale = 0.5f; E.ss_out = SSP(l * 4 + 4); for (int rr = 0; rr < REP_GEMM; ++rr) { E.O = (rr == REP_GEMM - 1) ? XB : Hb; PH(19) gemm_phase<1>(lds, g, E, G, cb); } break;
            case 6: g.A = XB; g.Bt = (const bf16_t*)(ws + WB_IN); g.nN = 15; E.O = BIG; E.ldo = 3840; E.ss_in = SSP(l * 4 + 1); for (int rr = 0; rr < REP_GEMM; ++rr) { PH(5) gemm_phase<2>(lds, g, E, G, cb); }
                {
                GJob g2{}; Epi E2{}; g2.lda = 1024; g2.ldb = 1024; g2.K = 1024; g2.nZ = 1; E2.scale = 1.0f;
                g2.A = MEMN; g2.Bt = (const bf16_t*)(ws + WB_KV); g2.nM = 4; g2.nN = 8; E2.O = KV; E2.ldo = 2048; gemm_phase<2>(lds, g2, E2, G, (cb + 128) % G);
                } break;
            case 10:
                g.A = Hb; g.Bt = (const bf16_t*)(ws + WB_OUT); E.resb = XB; E.ss_out = SSP(l * 4 + 2); for (int rr = 0; rr < REP_GEMM; ++rr) { E.O = (rr == REP_GEMM - 1) ? XB : BIG; PH(13) gemm_phase<1>(lds, g, E, G, cb); } break;
            case 12: continue;
            case 13: g.A = XB; g.aZ1 = 8192l * 1024; g.Bt = MBT; g.bZ1 = 1024l * 1024; g.nM = 32; g.nN = 4; g.nZ = 4; g.rowZ = 8192;
                     E.O = Pb; E.rowZ = 8192; E.ss_in = SSP(l * 4 + 2); E.tab = (LAS float*)(lds + 131072); for (int rr = 0; rr < REP_GEMM; ++rr) { PH(15) gemm_phase<3>(lds, g, E, G, cb); } break;
            case 14: continue;
            case 15: g.A = Pb; g.aZ1 = 8192l * 1024; g.Bt = VWT; g.bZ1 = 1024l * 1024; g.nM = 32; g.nN = 4; g.nZ = 4; E.rowZ = 8192;
                     E.resb = XB; E.ss_out = SSP(l * 4 + 3); for (int rr = 0; rr < REP_GEMM; ++rr) { E.O = (rr == REP_GEMM - 1) ? XB : BIG; PH(17) gemm_phase<1>(lds, g, E, G, cb); } break;
            case 0: is_gemm = false; ng = PIN(3); break;
            case 5: case 11: case 16: continue;
            default: is_gemm = false; break;
        }
        if (is_gemm) {
        } else if (ng != nullptr) {
            for (int rr = 0; rr < REP_EW; ++rr) {
            if (k == 0) { PH(0) phase_convert(l, lds, 0, 3072); PH(0) phase_convert(l, lds, 3584, 4352); PH(0) phase_convert(l, lds, 6464, 6472);
                          PH(0) phase_convert_straight(PIN(22) + l * 1024l * 1024, PIN(20) + l * 1024, (bf16_t*)(ws + WB_Q)); }
            if (l == 0) { PH(1) phase_prep(PIN(0), XB, SSP(0), 32768); PH(1) phase_rope_table((const int*)PIN(2), XOUT + 16777216l, XOUT + 16777216l + 32768l * 48);
                          if (cb == 0) { const int j = ltid(); const float* hp = PIN(10); (XOUT + 16777216l + 2 * 32768l * 48)[j] = sigm(hp[512 + j] - hp[j]); } }
            PH(1) phase_norm(PIN(1), PIN(21) + l * 1024, MEMN, 1024);
            }
        } else {
        MixCtx mc;
            mc.lds = lds; mc.proj = BIG; mc.mix = Hb; mc.sth = (bf16_t*)(ws + WS_STH); mc.str = (bf16_t*)(ws + WS_STR); mc.lasth = (float*)(ws + WS_LASTH);
            mc.lrup = (bf16_t*)(ws + WS_LRUP); mc.lruh = (bf16_t*)(ws + WS_LRUH); mc.lrupe = (float*)(ws + WS_LRUPE); mc.lruhe = (float*)(ws + WS_LRUHE); mc.lruci = (float*)(ws + WS_LRUCI);
            mc.waT = (const bf16_t*)(ws + WB_WA); mc.wxT = (const bf16_t*)(ws + WB_WX);
            mc.pos = (const int*)PIN(2); mc.hg_lb = PIN(10); mc.rcs = XOUT + 16777216l; mc.rsn = XOUT + 16777216l + 32768l * 48; mc.lb1 = XOUT + 16777216l + 2 * 32768l * 48;
            mc.ret_gn_g = PIN(9) + l * 384; mc.hg_norm_g = PIN(11) + l * 384;
            mc.conv_w = PIN(12) + l * 1024; mc.conv_b = PIN(13) + l * 256; mc.ba = PIN(15) + l * 256; mc.bx = PIN(17) + l * 256; mc.lam = PIN(18) + l * 256;
            mc.l = l;
            if (k == 7) {
                for (int rr = 0; rr < REP_MIX; ++rr) for (int idx = cb; idx < 5120; idx += G) {
                    const int kk5 = idx % 5, u = idx / 5;
                    if (kk5 < 2) { RMT(0) ret_unit<false>(mc, 2 * u + kk5); }
                    else if (kk5 < 4) { RMT(1) hg_unit<false>(mc, 2 * u + (kk5 - 2)); }
                    else { RMT(2) lru_m1(mc, u); }
                }
                {
                GJob g2{}; Epi E2{}; g2.A = KV; g2.lda = 2048; g2.aZ1 = 256l * 2048; g2.aZ2 = 256; g2.Bt = (const bf16_t*)(ws + WB_Q); g2.ldb = 1024; g2.bZ2 = 256; g2.K = 256; g2.nM = 1; g2.nN = 4; g2.nZ = 16; g2.zshift = 2;
                E2.O = MBT; E2.ldo = 1024; E2.oZ1 = 1024l * 1024; E2.oZ2 = 256l * 1024; E2.zshift = 2; E2.scale = 0.0625f; gemm_phase<2>(lds, g2, E2, G, cb);
                GJob g3{}; Epi E3{}; g3.A = (const bf16_t*)(ws + WB_O); g3.lda = 1024; g3.aZ2 = 256; g3.Bt = KV + 1024; g3.ldb = 2048; g3.bZ1 = 256l * 2048; g3.bZ2 = 256; g3.K = 256; g3.nM = 4; g3.nN = 1; g3.nZ = 16; g3.zshift = 2;
                E3.O = VWT; E3.ldo = 1024; E3.oZ1 = 1024l * 1024; E3.oZ2 = 256; E3.zshift = 2; E3.scale = 1.0f; gemm_phase<2>(lds, g3, E3, G, (cb + 64) % G);
                                }
            } else if (k == 8) {
                PH(9) phase_scan(mc);
                PH(0) phase_convert(l, lds, 3072, 3328);
                PH(0) phase_convert(l, lds, 4352, 6464);
            } else {
                for (int rr = 0; rr < REP_MIX; ++rr) for (int idx = cb; idx < 4608; idx += G) {
                    const int kk9 = idx % 9, u = idx / 9;
                    if (kk9 < 4) { RMT(3) ret_unit<true>(mc, 4 * u + kk9); }
                    else if (kk9 < 8) { RMT(4) hg_unit<true>(mc, 4 * u + (kk9 - 4)); }
                    else { RMT(5) lru_m3(mc, u); }
                }
            }
        }
        if (ph == 0) grid.sync(); else xcd_barrier(xb);
    }
    PH(20) phase_final_norm(XB, X, PIN(29), 32768);
}

#undef ws
#undef BIG
#undef Hb
#undef XB
#undef MEMN
#undef KMEM
#undef KV
#undef MBT
#undef VWT
#undef VT
#undef Qb
#undef SSP
#undef Pb
#undef X
extern "C" void kernel_launch(void* const* d_in, const int* in_sizes, int n_in, void* d_out, int out_size, void* d_ws, size_t ws_size, hipStream_t stream) {
    static int grid = 0;
    if (grid == 0) {
        int dev = 0, cus = 0, per_cu = 0;
        (void)hipGetDevice(&dev);
        (void)hipDeviceGetAttribute(&cus, hipDeviceAttributeMultiprocessorCount, dev);
        if (hipFuncSetAttribute((const void*)mega, hipFuncAttributeMaxDynamicSharedMemorySize, LDS_BYTES) != hipSuccess) fprintf(stderr, "kernel_launch: hipFuncSetAttribute failed\n");
        if (hipOccupancyMaxActiveBlocksPerMultiprocessor(&per_cu, (const void*)mega, NTHREADS, LDS_BYTES) != hipSuccess || per_cu < 1) { fprintf(stderr, "kernel_launch: occupancy query says %d\n", per_cu); per_cu = 1; }
        (void)hipGetLastError();
        grid = cus * 1;
        if (ws_size < WS_END) fprintf(stderr, "kernel_launch: workspace too small: %zu < %zu\n", ws_size, (size_t)WS_END);
    }
    Params p{};
    for (int i = 0; i < 30; ++i) p.in[i] = (const float*)d_in[i];
    p.outp_ = (float*)d_out; p.wsp_ = (unsigned char*)d_ws;
    if (hipMemsetAsync((char*)d_ws + WS_BAR, 0, 16384, stream) != hipSuccess) fprintf(stderr, "kernel_launch: memset of barrier words failed\n");
    void* args[] = {&p};
    hipError_t e = hipLaunchCooperativeKernel((const void*)mega, dim3(grid), dim3(NTHREADS), args, LDS_BYTES, stream);
    if (e != hipSuccess) fprintf(stderr, "cooperative launch failed: %s (grid %d)\n", hipGetErrorString(e), grid);
}
```

```cpp
#include <hip/hip_runtime.h>
#include <hip/hip_cooperative_groups.h>
#include <cstdio>
namespace cg = cooperative_groups;

#define LAS __attribute__((address_space(3)))
typedef unsigned short bf16_t;
typedef short bf16x8 __attribute__((ext_vector_type(8)));
typedef float f32x4 __attribute__((ext_vector_type(4)));
typedef unsigned u32x4 __attribute__((ext_vector_type(4)));
typedef unsigned u32x2 __attribute__((ext_vector_type(2)));

constexpr int LDS_BYTES = 155648;
constexpr int NTHREADS = 512;
constexpr long T_TOK = 32768;
#ifndef PHMASK
#define PHMASK 0xffffffffu
#endif
#define PH(n) if ((PHMASK >> (n)) & 1u)
#ifndef REPK
#define REPK 0u
#endif
#define REP_GEMM (((REPK >> k) & 1u) ? 2 : 1)
#ifndef REP_MIX
#define REP_MIX 1
#endif
#ifndef REP_MT
#define REP_MT 0u
#endif
#define RMT(b) for (int r2 = 0; r2 < (((REP_MT >> (b)) & 1u) ? 2 : 1); ++r2)
#ifndef REP_EW
#define REP_EW 1
#endif

constexpr size_t WB_UP1 = 0;
constexpr size_t WB_DN1 = WB_UP1 + 5632ull * 1024 * 2;
constexpr size_t WB_IN = WB_DN1 + 1024ull * 2816 * 2;
constexpr size_t WB_OUT = WB_IN + 3840ull * 1024 * 2;
constexpr size_t WB_Q = WB_OUT + 1024ull * 1024 * 2;
constexpr size_t WB_KV = WB_Q + 1024ull * 1024 * 2;
constexpr size_t WB_O = WB_KV + 2048ull * 1024 * 2;
constexpr size_t WB_UP2 = WB_O + 1024ull * 1024 * 2;
constexpr size_t WB_DN2 = WB_UP2 + 5632ull * 1024 * 2;
constexpr size_t WB_WA = WB_DN2 + 1024ull * 2816 * 2;
constexpr size_t WB_WX = WB_WA + 16384ull * 2;
constexpr size_t WS_BIG = WB_WX + 16384ull * 2;
constexpr size_t WS_H = WS_BIG + 32768ull * 3840 * 2;
constexpr size_t WS_STH = WS_H + 32768ull * 1024 * 2;
constexpr size_t WS_STR = WS_STH + 2048ull * 96 * 128 * 2;
constexpr size_t WS_LASTH = WS_STR + 2048ull * 96 * 96 * 2;
constexpr size_t WS_LRUP = WS_LASTH + 2048ull * 128 * 4;
constexpr size_t WS_LRUH = WS_LRUP + 32768ull * 256 * 2;
constexpr size_t WS_LRUPE = WS_LRUH + 32768ull * 256 * 2;
constexpr size_t WS_LRUHE = WS_LRUPE + 512ull * 256 * 4;
constexpr size_t WS_LRUCI = WS_LRUHE + 512ull * 256 * 4;
constexpr size_t WS_MEMN = WS_LRUCI + 512ull * 256 * 4;
constexpr size_t WS_KMEM = WS_MEMN + 1024ull * 1024 * 2;
constexpr size_t WS_VT = WS_KMEM + 1024ull * 1024 * 2;
constexpr size_t WS_BAR = WS_VT + 1024ull * 1024 * 2;
constexpr size_t WS_SS = WS_BAR + 16384;
constexpr size_t WS_MBT = WS_SS + 2ull * 32768 * 16 * 4;
constexpr size_t WS_VWT = WS_MBT + 4ull * 1024 * 1024 * 2;
constexpr size_t WS_END = WS_VWT + 4ull * 1024 * 1024 * 2;

struct Params {
    const float* in[30];
    float* outp_;
    unsigned char* wsp_;
};

typedef const __attribute__((address_space(4))) Params* KArgP;
__device__ __forceinline__ KArgP kargs() { auto q = __builtin_amdgcn_kernarg_segment_ptr(); asm volatile("" : "+s"(q)); return (KArgP)q; }
#define PIN(i) (kargs()->in[i])
#define WSP (kargs()->wsp_)
#define XOUT (kargs()->outp_)
__device__ __forceinline__ int ltid() { int t = threadIdx.x; asm volatile("" : "+v"(t)); return t; }
__device__ __forceinline__ float bf2f(bf16_t b) { return __uint_as_float(((unsigned)b) << 16); }
typedef float f32x2_t __attribute__((ext_vector_type(2)));
typedef __bf16 bf16x2_t __attribute__((ext_vector_type(2)));
__device__ __forceinline__ unsigned pk2(float lo, float hi) { const f32x2_t f = {lo, hi}; const bf16x2_t b = __builtin_convertvector(f, bf16x2_t); return __builtin_bit_cast(unsigned, b); }
__device__ __forceinline__ bf16_t f2bf(float f) { return (bf16_t)(pk2(f, f) & 0xffffu); }
__device__ __forceinline__ float lo16(unsigned w) { return __uint_as_float(w << 16); }
__device__ __forceinline__ float hi16(unsigned w) { return __uint_as_float(w & 0xffff0000u); }
__device__ __forceinline__ float sigm(float x) { return __builtin_amdgcn_rcpf(1.0f + __expf(-x)); }
__device__ __forceinline__ float silu(float x) { return x * sigm(x); }
__device__ __forceinline__ float gelu_tanh(float x) { return x * sigm(1.5957691216f * (x + 0.044715f * x * x * x)); }
#define UNPACK8(v, f) do { _Pragma("unroll") for (int _i = 0; _i < 4; ++_i) { f[2 * _i] = lo16(v[_i]); f[2 * _i + 1] = hi16(v[_i]); } } while (0)

__device__ __forceinline__ f32x4 mma16(const LAS bf16_t* A, int lda, const LAS bf16_t* B, int ldb, int K, f32x4 acc, int lane) {
    const int r = lane & 15, q = lane >> 4;
    const LAS bf16_t* ap = A + r * lda + q * 8;
    const LAS bf16_t* bp = B + r * ldb + q * 8;
    for (int k0 = 0; k0 < K; k0 += 32) {
        const bf16x8 a = *(const LAS bf16x8*)(ap + k0);
        const bf16x8 b = *(const LAS bf16x8*)(bp + k0);
        acc = __builtin_amdgcn_mfma_f32_16x16x32_bf16(a, b, acc, 0, 0, 0);
    }
    return acc;
}

constexpr int BM = 256, BK = 64, HALF = 128, HTB = HALF * BK * 2;
__device__ __forceinline__ int lds_byte(int r, int c) { const int st = (r >> 4) * 2 + (c >> 5), rr = r & 15, cc = c & 31, ob = rr * 64 + cc * 2; return st * 1024 + (ob ^ (((ob >> 9) & 1) << 5)); }
__device__ __forceinline__ void stage_rc(int b, int& R, int& C) { const int st = b / 1024, sb = b % 1024, swz = sb ^ (((sb >> 9) & 1) << 5); R = (st >> 1) * 16 + swz / 64; C = (st & 1) * 32 + (swz % 64) / 2; }
__device__ __forceinline__ int perm32(int rho) { const int n = rho >> 4, i = rho & 15; return 8 * (i >> 2) + 4 * n + (i & 3); }

struct Unit { int pm, pn, z; };
struct GJob {
    const bf16_t* A; const bf16_t* Bt; int lda, ldb, K, nM, nN, nZ, zshift; long aZ1, aZ2, bZ1, bZ2;
    long rowZ;
};
__device__ __forceinline__ bool g_next(const GJob& g, int i, int G, int c, Unit& u) {
    const int per = g.nM * g.nN, tot = per * g.nZ;
    const long L = (long)i * G + c; if (L >= tot) return false;
    int wgid = (int)L; { const int q = tot / 8, r = tot % 8, xcd = wgid % 8, off = wgid / 8; wgid = (xcd < r ? xcd * (q + 1) : r * (q + 1) + (xcd - r) * q) + off; }
    u.z = wgid / per; const int w = wgid % per;
    const int nig = 8 * g.nN, gid = w / nig, fm = gid * 8, gsz = (g.nM - fm) < 8 ? (g.nM - fm) : 8;
    u.pm = fm + ((w % nig) % gsz); u.pn = (w % nig) / gsz; return true;
}
__device__ __forceinline__ const char* g_aptr(const GJob& g, const Unit& u) {
    const long z1 = u.z >> g.zshift, z2 = u.z & ((1 << g.zshift) - 1);
    return (const char*)(g.A + z1 * g.aZ1 + z2 * g.aZ2 + (long)u.pm * BM * g.lda);
}
__device__ __forceinline__ const char* g_bptr(const GJob& g, const Unit& u) {
    const long z1 = u.z >> g.zshift, z2 = u.z & ((1 << g.zshift) - 1);
    return (const char*)(g.Bt + z1 * g.bZ1 + z2 * g.bZ2 + (long)u.pn * BM * g.ldb);
}

typedef f32x4 AccT[2][2][4][2];

struct Epi {
    int mode; int ldo; int zshift; float scale; bf16_t* O; long oZ1, oZ2; const bf16_t* resb; LAS float* tab;
    long rowZ;
    const float* ss_in;
    float* ss_out;
};
__device__ __forceinline__ float row_rstd(const float* ss, long row) {
    const f32x4* sp = (const f32x4*)(ss + row * 16);
    const f32x4 a = (sp[0] + sp[1]) + (sp[2] + sp[3]);
    return rsqrtf(((a[0] + a[1]) + (a[2] + a[3])) * (1.0f / 1024.0f) + 1e-6f);
}
__device__ __forceinline__ void epi_swiglu(const Epi& E, AccT& acc, const Unit& u, int wr, int wc, int fr, int fq, const LAS float* rst) {
    const long row0 = (long)u.pm * BM + wr * 64 + fr; const int col0 = u.pn * 128 + wc * 32 + 8 * fq;
#pragma unroll
    for (int ai = 0; ai < 2; ++ai)
#pragma unroll
        for (int m = 0; m < 4; ++m) {
            const float rs = rst[ai * 128 + wr * 64 + m * 16 + fr];
            float o[8];
#pragma unroll
            for (int n = 0; n < 2; ++n)
#pragma unroll
                for (int j = 0; j < 4; ++j) o[n * 4 + j] = silu(acc[ai][0][m][n][j] * rs) * (acc[ai][1][m][n][j] * rs);
            u32x4 pk; pk[0] = pk2(o[0], o[1]); pk[1] = pk2(o[2], o[3]); pk[2] = pk2(o[4], o[5]); pk[3] = pk2(o[6], o[7]);
            *(u32x4*)(E.O + (row0 + ai * HALF + m * 16) * 2816 + col0) = pk;
        }
}
#define RESID_LOAD(ai, rv) _Pragma("unroll") for (int m = 0; m < 4; ++m) _Pragma("unroll") for (int bj = 0; bj < 2; ++bj) rv[m][bj] = *(const u32x4*)(E.resb + (row0 + (ai) * HALF + m * 16) * 1024 + col0 + bj * HALF)
#define RESID_COMP(ai, rv, pk) _Pragma("unroll") for (int m = 0; m < 4; ++m) { float sl = 0.f; _Pragma("unroll") for (int bj = 0; bj < 2; ++bj) { \
        float rf[8]; UNPACK8(rv[m][bj], rf); float v[8]; \
        _Pragma("unroll") for (int j = 0; j < 4; ++j) { v[j] = rf[j] + acc[ai][bj][m][0][j] * E.scale; v[4 + j] = rf[4 + j] + acc[ai][bj][m][1][j] * E.scale; } \
        _Pragma("unroll") for (int j = 0; j < 8; ++j) sl += v[j] * v[j]; \
        pk[m][bj][0] = pk2(v[0], v[1]); pk[m][bj][1] = pk2(v[2], v[3]); pk[m][bj][2] = pk2(v[4], v[5]); pk[m][bj][3] = pk2(v[6], v[7]); } ssl[ai][m] = sl; }
#define RESID_STORE(ai, pk) _Pragma("unroll") for (int m = 0; m < 4; ++m) _Pragma("unroll") for (int bj = 0; bj < 2; ++bj) *(u32x4*)(E.O + (row0 + (ai) * HALF + m * 16) * 1024 + col0 + bj * HALF) = pk[m][bj]
__device__ __forceinline__ void epi_resid(const Epi& E, AccT& acc, const Unit& u, int wr, int wc, int fr, int fq) {
    const long row0 = (long)u.z * E.rowZ + (long)u.pm * BM + wr * 64 + fr; const int col0 = u.pn * BM + wc * 32 + 8 * fq;
    float ssl[2][4];
    u32x4 rvA[4][2], pkA[4][2];
    RESID_LOAD(0, rvA);
    asm volatile("" ::: "memory");
    RESID_COMP(0, rvA, pkA);
    u32x4 rvB[4][2];
    RESID_LOAD(1, rvB);
    asm volatile("" ::: "memory");
    RESID_STORE(0, pkA);
    asm volatile("" ::: "memory");
    u32x4 pkB[4][2];
    RESID_COMP(1, rvB, pkB);
    RESID_STORE(1, pkB);
#pragma unroll
    for (int ai = 0; ai < 2; ++ai)
#pragma unroll
        for (int m = 0; m < 4; ++m) {
            float sl = ssl[ai][m];
            sl += __shfl_xor(sl, 16); sl += __shfl_xor(sl, 32);
            if (fq == 0) E.ss_out[(row0 + ai * HALF + m * 16) * 16 + u.pn * 4 + wc] = sl;
        }
}
#undef RESID_LOAD
#undef RESID_COMP
#undef RESID_STORE
__device__ __forceinline__ void epi_bf16(const Epi& E, AccT& acc, const Unit& u, int wr, int wc, int fr, int fq, const LAS float* rst) {
    const long z1 = u.z >> E.zshift, z2 = u.z & ((1 << E.zshift) - 1);
    bf16_t* base = E.O + z1 * E.oZ1 + z2 * E.oZ2;
    const long row0 = (long)u.pm * BM + wr * 64 + fr; const int col0 = u.pn * BM + wc * 32 + 8 * fq;
    const long ldo = E.ldo;
#pragma unroll
    for (int ai = 0; ai < 2; ++ai)
#pragma unroll
        for (int m = 0; m < 4; ++m) {
            float scale = E.scale;
            if (E.ss_in != nullptr) scale *= rst[ai * 128 + wr * 64 + m * 16 + fr];
#pragma unroll
            for (int bj = 0; bj < 2; ++bj) {
                const f32x4 a0 = acc[ai][bj][m][0] * scale, a1 = acc[ai][bj][m][1] * scale;
                u32x4 pk; pk[0] = pk2(a0[0], a0[1]); pk[1] = pk2(a0[2], a0[3]); pk[2] = pk2(a1[0], a1[1]); pk[3] = pk2(a1[2], a1[3]);
                *(u32x4*)(base + (row0 + ai * HALF + m * 16) * ldo + col0 + bj * HALF) = pk;
            }
        }
}
__device__ __forceinline__ void epi_softmax(const Epi& E, AccT& acc, const Unit& u, int wr, int wc, int fr, int fq, const LAS float* rst) {
    bf16_t* base = E.O + (long)u.z * E.rowZ * 1024 + u.pn * 256;
    const long row0 = (long)u.pm * BM + wr * 64 + fr; const int col0 = wc * 32 + 8 * fq;
    LAS float* tab = E.tab; LAS float* tab2 = tab + 1024;
#pragma unroll
    for (int ai = 0; ai < 2; ++ai)
#pragma unroll
        for (int m = 0; m < 4; ++m) {
            const float rs = rst[ai * 128 + wr * 64 + m * 16 + fr];
            float v = -3.0e38f;
#pragma unroll
            for (int bj = 0; bj < 2; ++bj)
#pragma unroll
                for (int n = 0; n < 2; ++n)
#pragma unroll
                    for (int j = 0; j < 4; ++j) { acc[ai][bj][m][n][j] *= rs; v = fmaxf(v, acc[ai][bj][m][n][j]); }
            v = fmaxf(v, __shfl_xor(v, 16)); v = fmaxf(v, __shfl_xor(v, 32));
            if (fq == 0) tab[(ai * 128 + wr * 64 + m * 16 + fr) * 4 + wc] = v;
        }
    asm volatile("s_waitcnt lgkmcnt(0)" ::: "memory"); __builtin_amdgcn_s_barrier(); asm volatile("" ::: "memory");
#pragma unroll
    for (int ai = 0; ai < 2; ++ai)
#pragma unroll
        for (int m = 0; m < 4; ++m) {
            const int rl = ai * 128 + wr * 64 + m * 16 + fr;
            const f32x4 t4 = *(const LAS f32x4*)(tab + rl * 4);
            const float M = fmaxf(fmaxf(t4[0], t4[1]), fmaxf(t4[2], t4[3]));
            float sm = 0.f;
#pragma unroll
            for (int bj = 0; bj < 2; ++bj)
#pragma unroll
                for (int n = 0; n < 2; ++n)
#pragma unroll
                    for (int j = 0; j < 4; ++j) { const float e = __expf(acc[ai][bj][m][n][j] - M); acc[ai][bj][m][n][j] = e; sm += e; }
            sm += __shfl_xor(sm, 16); sm += __shfl_xor(sm, 32);
            if (fq == 0) tab2[rl * 4 + wc] = sm;
        }
    asm volatile("s_waitcnt lgkmcnt(0)" ::: "memory"); __builtin_amdgcn_s_barrier(); asm volatile("" ::: "memory");
#pragma unroll
    for (int ai = 0; ai < 2; ++ai)
#pragma unroll
        for (int m = 0; m < 4; ++m) {
            const int rl = ai * 128 + wr * 64 + m * 16 + fr;
            const f32x4 t4 = *(const LAS f32x4*)(tab2 + rl * 4);
            const float inv = 1.0f / (t4[0] + t4[1] + t4[2] + t4[3]);
#pragma unroll
            for (int bj = 0; bj < 2; ++bj) {
                const f32x4 a0 = acc[ai][bj][m][0] * inv, a1 = acc[ai][bj][m][1] * inv;
                u32x4 pk; pk[0] = pk2(a0[0], a0[1]); pk[1] = pk2(a0[2], a0[3]); pk[2] = pk2(a1[0], a1[1]); pk[3] = pk2(a1[2], a1[3]);
                *(u32x4*)(base + (row0 + ai * HALF + m * 16) * 1024 + col0 + bj * HALF) = pk;
            }
        }
}

template <int MODE>
__device__ __forceinline__ void gemm_phase(LAS unsigned char* lds, const GJob& g, const Epi& E, int G, int c) {
    const int tid = ltid();
    const int wid = __builtin_amdgcn_readfirstlane(tid >> 6), lane = tid & 63, wr = wid >> 2, wc = wid & 3, fr = lane & 15, fq = lane >> 4;
    const int K = g.K, nt = K / BK;
    unsigned voffA[2], voffB[2];
#pragma unroll
    for (int i = 0; i < 2; ++i) { int R, C; stage_rc(tid * 16 + i * 8192, R, C); const int Rb = (R & ~31) + perm32(R & 31);
        voffA[i] = (unsigned)(R * g.lda + C) * 2u; voffB[i] = (unsigned)(Rb * g.ldb + C) * 2u; }
    const size_t kstep = (size_t)(BK * 2);
    const size_t hstepA = (size_t)HALF * g.lda * 2, hstepB = (size_t)HALF * g.ldb * 2;
    const unsigned ldsw = (unsigned)wid * 1024u;
    const int aoff = lds_byte(wr * 64 + fr, fq * 8), boff = lds_byte(wc * 32 + fr, fq * 8);
#define PG8_SA(b, h) (((b) * 2 + (h)) * HTB)
#define PG8_SB(b, h) ((4 + (b) * 2 + (h)) * HTB)
#define PG8_STAGE(bufoff, gbase, voff) do { _Pragma("unroll") for (int _i = 0; _i < 2; ++_i) \
        __builtin_amdgcn_global_load_lds((const unsigned*)((const char*)(gbase) + (voff)[_i]), (LAS unsigned*)(lds + (bufoff) + ldsw + _i * 8192), 16, 0, 0); } while (0)
#define PG8_LDA(dst, b, h) do { _Pragma("unroll") for (int m = 0; m < 4; ++m) _Pragma("unroll") for (int k = 0; k < 2; ++k) dst[m][k] = *(const LAS bf16x8*)(lds + PG8_SA(b, h) + aoff + m * 2048 + k * 1024); } while (0)
#define PG8_LDB(dst, b, h) do { _Pragma("unroll") for (int n = 0; n < 2; ++n) _Pragma("unroll") for (int k = 0; k < 2; ++k) dst[n][k] = *(const LAS bf16x8*)(lds + PG8_SB(b, h) + boff + n * 2048 + k * 1024); } while (0)
#define PG8_MMA(ai, bj, At, Bt) do { __builtin_amdgcn_s_setprio(1); _Pragma("unroll") for (int m = 0; m < 4; ++m) _Pragma("unroll") for (int n = 0; n < 2; ++n) _Pragma("unroll") for (int k = 0; k < 2; ++k) \
        acc[ai][bj][m][n] = __builtin_amdgcn_mfma_f32_16x16x32_bf16(Bt[n][k], At[m][k], acc[ai][bj][m][n], 0, 0, 0); __builtin_amdgcn_s_setprio(0); } while (0)
#define PG8_WAIT_V(n) asm volatile("s_waitcnt vmcnt(" #n ")" ::: "memory")
#define PG8_WAIT_L(n) asm volatile("s_waitcnt lgkmcnt(" #n ")" ::: "memory")
#define PG8_BAR __builtin_amdgcn_s_barrier()
#define PG8_SCHED __builtin_amdgcn_sched_barrier(0)
    Unit cur, nxt; int ui = 0;
    LAS float* rstab = (LAS float*)(lds + 139264);
    if ((MODE == 0 || MODE == 2 || MODE == 3) && E.ss_in != nullptr) {
        for (int u0 = 0; u0 < 16; u0 += 2) {
            Unit uu; const int uidx = u0 + (tid >> 8);
            if (g_next(g, uidx, G, c, uu)) rstab[uidx * 256 + (tid & 255)] = row_rstd(E.ss_in, (long)(uu.z >> g.zshift) * g.rowZ + (long)uu.pm * BM + (tid & 255));
        }
        __syncthreads();
    }
    if (!g_next(g, 0, G, c, cur)) return;
    AccT acc;
#pragma unroll
    for (int a = 0; a < 2; ++a)
#pragma unroll
        for (int b = 0; b < 2; ++b)
#pragma unroll
            for (int m = 0; m < 4; ++m)
#pragma unroll
                for (int n = 0; n < 2; ++n) acc[a][b][m][n] = (f32x4){0.f, 0.f, 0.f, 0.f};
    bf16x8 At[4][2], B0[2][2], B1[2][2];
    const char* cA = g_aptr(g, cur); const char* cB = g_bptr(g, cur);
    PG8_STAGE(PG8_SB(0, 0), cB, voffB); PG8_STAGE(PG8_SA(0, 0), cA, voffA); PG8_STAGE(PG8_SB(0, 1), cB + hstepB, voffB); PG8_STAGE(PG8_SA(0, 1), cA + hstepA, voffA);
    if (wr == 1) PG8_BAR;
    PG8_WAIT_V(4); PG8_BAR;
    PG8_STAGE(PG8_SB(1, 0), cB + kstep, voffB); PG8_STAGE(PG8_SA(1, 0), cA + kstep, voffA); PG8_STAGE(PG8_SB(1, 1), cB + hstepB + kstep, voffB);
    PG8_WAIT_V(6); PG8_BAR;
    for (;;) {
        const bool has_next = g_next(g, ui + 1, G, c, nxt);
        const char* nA = has_next ? g_aptr(g, nxt) : cA; const char* nB = has_next ? g_bptr(g, nxt) : cB;
        for (int t = 0; t < nt; t += 2) {
            const bool last = (t == nt - 2);
            const char* a1 = cA + (size_t)(t + 1) * kstep;
            const char* a2 = last ? nA : cA + (size_t)(t + 2) * kstep; const char* b2 = last ? nB : cB + (size_t)(t + 2) * kstep;
            const char* a3 = a2 + kstep; const char* b3 = b2 + kstep;
            PG8_LDB(B0, 0, 0); PG8_SCHED; PG8_LDA(At, 0, 0); PG8_STAGE(PG8_SA(1, 1), a1 + hstepA, voffA);
            PG8_WAIT_L(8); PG8_BAR; PG8_WAIT_L(0); PG8_MMA(0, 0, At, B0); PG8_BAR; PG8_SCHED;
            PG8_LDB(B1, 0, 1); PG8_STAGE(PG8_SB(0, 0), b2, voffB);
            PG8_BAR; PG8_WAIT_L(0); PG8_MMA(0, 1, At, B1); PG8_BAR;
            PG8_LDA(At, 0, 1); PG8_STAGE(PG8_SA(0, 0), a2, voffA);
            PG8_BAR; PG8_WAIT_L(0); PG8_MMA(1, 0, At, B0); PG8_BAR; PG8_SCHED;
            PG8_STAGE(PG8_SB(0, 1), b2 + hstepB, voffB);
            PG8_WAIT_V(6); PG8_BAR; PG8_MMA(1, 1, At, B1); PG8_BAR;
            PG8_LDB(B0, 1, 0); PG8_SCHED; PG8_LDA(At, 1, 0); PG8_STAGE(PG8_SA(0, 1), a2 + hstepA, voffA);
            PG8_WAIT_L(8); PG8_BAR; PG8_WAIT_L(0); PG8_MMA(0, 0, At, B0); PG8_BAR; PG8_SCHED;
            PG8_LDB(B1, 1, 1); PG8_STAGE(PG8_SB(1, 0), b3, voffB);
            PG8_BAR; PG8_WAIT_L(0); PG8_MMA(0, 1, At, B1); PG8_BAR;
            PG8_LDA(At, 1, 1); PG8_STAGE(PG8_SA(1, 0), a3, voffA);
            PG8_BAR; PG8_WAIT_L(0); PG8_MMA(1, 0, At, B0); PG8_BAR; PG8_SCHED;
            PG8_STAGE(PG8_SB(1, 1), b3 + hstepB, voffB);
            PG8_WAIT_V(6); PG8_BAR; PG8_MMA(1, 1, At, B1); PG8_BAR;
        }
        if (MODE == 0) epi_swiglu(E, acc, cur, wr, wc, fr, fq, rstab + ui * 256); else if (MODE == 1) epi_resid(E, acc, cur, wr, wc, fr, fq);
        else if (MODE == 2) epi_bf16(E, acc, cur, wr, wc, fr, fq, rstab + ui * 256); else epi_softmax(E, acc, cur, wr, wc, fr, fq, rstab + ui * 256);
        if (!has_next) break;
#pragma unroll
        for (int a = 0; a < 2; ++a)
#pragma unroll
            for (int b = 0; b < 2; ++b)
#pragma unroll
                for (int m = 0; m < 4; ++m)
#pragma unroll
                    for (int n = 0; n < 2; ++n) acc[a][b][m][n] = (f32x4){0.f, 0.f, 0.f, 0.f};
        cur = nxt; cA = nA; cB = nB; ++ui;
    }
    PG8_WAIT_V(0);
    if (wr == 0) PG8_BAR;
    PG8_BAR;
#undef PG8_SA
#undef PG8_SB
#undef PG8_STAGE
#undef PG8_LDA
#undef PG8_LDB
#undef PG8_MMA
#undef PG8_WAIT_V
#undef PG8_WAIT_L
#undef PG8_BAR
#undef PG8_SCHED
}

__device__ __forceinline__ void phase_convert(int l, LAS unsigned char* lds, int t_lo, int t_hi) {
    LAS float* tl = (LAS float*)lds;
    const int tid = ltid();
    const long FW = 1024l * 2816;
    for (int tile = t_lo + blockIdx.x; tile < t_hi; tile += gridDim.x) {
        const float* src = nullptr; bf16_t* dst = nullptr; const float* gk = nullptr;
        int K = 64, N = 256, Gd = 256, rs = 0, roff = 0, local = 0;
        unsigned char* ws = WSP;
#define JOB(T0, NT, SRC, KK, NN, DST, GG, RS, RO, GK) if (tile >= (T0) && tile < (T0) + (NT)) { src = (SRC); K = (KK); N = (NN); dst = (bf16_t*)(DST); Gd = (GG); rs = (RS); roff = (RO); gk = (GK); local = tile - (T0); }
        JOB(0, 176, PIN(4) + l * FW, 1024, 2816, ws + WB_UP1, 128, 256, 0, PIN(3) + l * 1024)
        else JOB(176, 176, PIN(5) + l * FW, 1024, 2816, ws + WB_UP1, 128, 256, 128, PIN(3) + l * 1024)
        else JOB(352, 176, PIN(6) + l * FW, 2816, 1024, ws + WB_DN1, 1024, 0, 0, nullptr)
        else JOB(528, 240, PIN(8) + l * 1024l * 3840, 1024, 3840, ws + WB_IN, 3840, 0, 0, PIN(7) + l * 1024)
        else JOB(768, 64, PIN(19) + l * 1024l * 1024, 1024, 1024, ws + WB_OUT, 1024, 0, 0, nullptr)
        else JOB(832, 128, PIN(23) + l * 1024l * 2048, 1024, 2048, ws + WB_KV, 2048, 0, 0, nullptr)
        else JOB(960, 64, PIN(24) + l * 1024l * 1024, 1024, 1024, ws + WB_O, 1024, 0, 0, nullptr)
        else JOB(1024, 176, PIN(26) + l * FW, 1024, 2816, ws + WB_UP2, 128, 256, 0, PIN(25) + l * 1024)
        else JOB(1200, 176, PIN(27) + l * FW, 1024, 2816, ws + WB_UP2, 128, 256, 128, PIN(25) + l * 1024)
        else JOB(1376, 176, PIN(28) + l * FW, 2816, 1024, ws + WB_DN2, 1024, 0, 0, nullptr)
#undef JOB
        const int ntn = N / 256, k0 = (local / ntn) * 64, n0 = (local % ntn) * 256;
        f32x4 v[4][2];
#pragma unroll
        for (int sub = 0; sub < 4; ++sub)
#pragma unroll
            for (int i = 0; i < 2; ++i) {
                const int idx = tid + i * 512, row = idx >> 4, c4 = idx & 15;
                v[sub][i] = *(const f32x4*)(src + (long)(k0 + row) * N + n0 + sub * 64 + c4 * 4);
            }
#pragma unroll
        for (int sub = 0; sub < 4; ++sub)
#pragma unroll
            for (int i = 0; i < 2; ++i) {
                const int idx = tid + i * 512, row = idx >> 4, c4 = idx & 15;
                f32x4 x = v[sub][i];
                if (gk != nullptr) x = x * gk[k0 + row];
                LAS float* t2 = tl + sub * 4160;
                t2[(c4 * 4 + 0) * 65 + row] = x[0]; t2[(c4 * 4 + 1) * 65 + row] = x[1]; t2[(c4 * 4 + 2) * 65 + row] = x[2]; t2[(c4 * 4 + 3) * 65 + row] = x[3];
            }
        __syncthreads();
#pragma unroll
        for (int sub = 0; sub < 4; ++sub) {
            const int n = tid >> 3, kk = (tid & 7) * 8, nn = n0 + sub * 64 + n;
            const int drow = (nn / Gd) * rs + roff + (nn % Gd);
            const LAS float* t2 = tl + sub * 4160;
            u32x4 pk;
#pragma unroll
            for (int q = 0; q < 4; ++q) pk[q] = pk2(t2[n * 65 + kk + 2 * q], t2[n * 65 + kk + 2 * q + 1]);
            *(u32x4*)(dst + (long)drow * K + k0 + kk) = pk;
        }
        __syncthreads();
    }
}
__device__ __forceinline__ void phase_convert_lru(int l, LAS unsigned char* lds) {
    LAS float* tl = (LAS float*)lds;
    const int tid = ltid();
    for (int tile = blockIdx.x; tile < 8; tile += gridDim.x) {
        const int nb = tile & 3;
        const float* src = ((tile < 4) ? PIN(14) : PIN(16)) + l * 16384 + nb * 4096;
        bf16_t* dst = (bf16_t*)(WSP + ((tile < 4) ? WB_WA : WB_WX) + nb * 8192);
#pragma unroll
        for (int i = 0; i < 2; ++i) {
            const int idx = tid + i * 512, row = idx >> 4, c4 = idx & 15;
            const f32x4 x = *(const f32x4*)(src + (long)row * 64 + c4 * 4);
            tl[(c4 * 4 + 0) * 65 + row] = x[0]; tl[(c4 * 4 + 1) * 65 + row] = x[1]; tl[(c4 * 4 + 2) * 65 + row] = x[2]; tl[(c4 * 4 + 3) * 65 + row] = x[3];
        }
        __syncthreads();
        {
            const int n = tid >> 3, kk = (tid & 7) * 8;
            u32x4 pk;
#pragma unroll
            for (int q = 0; q < 4; ++q) pk[q] = pk2(tl[n * 65 + kk + 2 * q], tl[n * 65 + kk + 2 * q + 1]);
            *(u32x4*)(dst + (long)n * 64 + kk) = pk;
        }
        __syncthreads();
    }
}

__device__ __forceinline__ void phase_convert_straight(const float* src, const float* gk, bf16_t* dst) {
    const long gt = (long)blockIdx.x * NTHREADS + ltid();
    for (long v = gt; v < 131072; v += (long)gridDim.x * NTHREADS) {
        const int k = (int)(v >> 7);
        const f32x4 a = *(const f32x4*)(src + v * 8), b = *(const f32x4*)(src + v * 8 + 4);
        const float gg = gk[k];
        u32x4 pk; pk[0] = pk2(a[0] * gg, a[1] * gg); pk[1] = pk2(a[2] * gg, a[3] * gg); pk[2] = pk2(b[0] * gg, b[1] * gg); pk[3] = pk2(b[2] * gg, b[3] * gg);
        *(u32x4*)(dst + v * 8) = pk;
    }
}

__device__ __forceinline__ void phase_rope_table(const int* pos, float* cs, float* sn) {
    const long gt = (long)blockIdx.x * NTHREADS + ltid();
    for (long p = gt; p < 32768l * 48; p += (long)gridDim.x * NTHREADS) {
        const int t = (int)(p / 48), i = (int)(p % 48);
        const float inv_freq = __expf(-9.210340371976184f * (float)i * (1.0f / 48.0f));
        const float ang = (float)pos[t] * inv_freq;
        const float k = rintf(ang * 0.15915494309189535f);
        float r = fmaf(-k, 6.28125f, ang); r = fmaf(-k, 1.9353071795864769e-3f, r);
        cs[p] = __cosf(r); sn[p] = __sinf(r);
    }
}

__device__ __forceinline__ void phase_norm(const float* src, const float* g, bf16_t* dst, int nrows) {
    const int tid_ = ltid(); const int lane = tid_ & 63, gw = blockIdx.x * 8 + (tid_ >> 6), nw = gridDim.x * 8;
    for (int row = gw; row < nrows; row += nw) {
        const f32x4* pr = (const f32x4*)(src + (long)row * 1024);
        f32x4 v[4]; float ss = 0.f;
#pragma unroll
        for (int i = 0; i < 4; ++i) { v[i] = pr[lane + 64 * i]; ss += v[i][0] * v[i][0] + v[i][1] * v[i][1] + v[i][2] * v[i][2] + v[i][3] * v[i][3]; }
#pragma unroll
        for (int m = 32; m >= 1; m >>= 1) ss += __shfl_xor(ss, m);
        const float rstd = rsqrtf(ss * (1.0f / 1024.0f) + 1e-6f);
#pragma unroll
        for (int i = 0; i < 4; ++i) {
            const f32x4 gg = ((const f32x4*)g)[lane + 64 * i];
            u32x2 pk; pk[0] = pk2(v[i][0] * rstd * gg[0], v[i][1] * rstd * gg[1]); pk[1] = pk2(v[i][2] * rstd * gg[2], v[i][3] * rstd * gg[3]);
            *(u32x2*)(dst + (long)row * 1024 + (lane + 64 * i) * 4) = pk;
        }
    }
}
__device__ __forceinline__ void phase_prep(const float* src, bf16_t* dst, float* ss_out, int nrows) {
    const int tid_ = ltid(); const int lane = tid_ & 63, gw = blockIdx.x * 8 + (tid_ >> 6), nw = gridDim.x * 8;
    for (int row = gw; row < nrows; row += nw) {
        const f32x4* pr = (const f32x4*)(src + (long)row * 1024);
        f32x4 v[4]; float ss = 0.f;
#pragma unroll
        for (int i = 0; i < 4; ++i) { v[i] = pr[lane + 64 * i]; ss += v[i][0] * v[i][0] + v[i][1] * v[i][1] + v[i][2] * v[i][2] + v[i][3] * v[i][3]; }
#pragma unroll
        for (int m = 32; m >= 1; m >>= 1) ss += __shfl_xor(ss, m);
        if (lane < 16) ss_out[(long)row * 16 + lane] = (lane == 0) ? ss : 0.f;
#pragma unroll
        for (int i = 0; i < 4; ++i) { u32x2 pk; pk[0] = pk2(v[i][0], v[i][1]); pk[1] = pk2(v[i][2], v[i][3]); *(u32x2*)(dst + (long)row * 1024 + (lane + 64 * i) * 4) = pk; }
    }
}
__device__ __forceinline__ void phase_final_norm(const bf16_t* xb, float* out, const float* g, int nrows) {
    const int tid_ = ltid(); const int lane = tid_ & 63, gw = blockIdx.x * 8 + (tid_ >> 6), nw = gridDim.x * 8;
    for (int row = gw; row < nrows; row += nw) {
        float v[16]; float ss = 0.f;
#pragma unroll
        for (int i = 0; i < 2; ++i) {
            const u32x4 rv = *(const u32x4*)(xb + (long)row * 1024 + (lane + 64 * i) * 8);
#pragma unroll
            for (int q = 0; q < 4; ++q) { v[i * 8 + 2 * q] = lo16(rv[q]); v[i * 8 + 2 * q + 1] = hi16(rv[q]); }
        }
#pragma unroll
        for (int j = 0; j < 16; ++j) ss += v[j] * v[j];
#pragma unroll
        for (int m = 32; m >= 1; m >>= 1) ss += __shfl_xor(ss, m);
        const float rstd = rsqrtf(ss * (1.0f / 1024.0f) + 1e-6f);
#pragma unroll
        for (int i = 0; i < 2; ++i) {
            const f32x4 g0 = *(const f32x4*)(g + (lane + 64 * i) * 8), g1 = *(const f32x4*)(g + (lane + 64 * i) * 8 + 4);
            f32x4 o0, o1;
#pragma unroll
            for (int j = 0; j < 4; ++j) { o0[j] = v[i * 8 + j] * rstd * g0[j]; o1[j] = v[i * 8 + 4 + j] * rstd * g1[j]; }
            *(f32x4*)(out + (long)row * 1024 + (lane + 64 * i) * 8) = o0; *(f32x4*)(out + (long)row * 1024 + (lane + 64 * i) * 8 + 4) = o1;
        }
    }
}

__device__ __forceinline__ void lds_barrier() { asm volatile("s_waitcnt lgkmcnt(0)" ::: "memory"); __builtin_amdgcn_s_barrier(); asm volatile("" ::: "memory"); }
struct MixCtx {
    LAS unsigned char* lds;
    const bf16_t* proj;
    bf16_t* mix;
    bf16_t* sth; bf16_t* str; float* lasth;
    bf16_t* lrup; bf16_t* lruh; float* lrupe; float* lruhe; float* lruci;
    const bf16_t* waT; const bf16_t* wxT;
    const int* pos; const float* rcs; const float* rsn;
    const float* lb1;
    const float* ret_gn_g; const float* hg_lb; const float* hg_norm_g;
    const float* conv_w; const float* conv_b; const float* ba; const float* bx; const float* lam;
    int l;
};

template <bool M3>
__device__ __forceinline__ void hg_unit(const MixCtx& c, int unit) {
    LAS unsigned char* lds = c.lds;
    const int tid = ltid(), wid = tid >> 6, lane = tid & 63;
    const int h = unit & 3; const long row0 = (long)(unit >> 2) * 64;
    LAS float* cum = (LAS float*)lds;
    LAS float* Kb = (LAS float*)(lds + 65536);
    LAS bf16_t* inpT = (LAS bf16_t*)(lds + (M3 ? 102400 : 51200));
    float kk[2][8], qq[2][8];
    float lbv[8];
    if (c.l == 0) {
#pragma unroll
        for (int j = 0; j < 8; ++j) lbv[j] = 0.f;
    } else {
        const f32x4 la = *(const f32x4*)(c.lb1 + h * 128 + (tid & 15) * 8), lb = *(const f32x4*)(c.lb1 + h * 128 + (tid & 15) * 8 + 4);
#pragma unroll
        for (int j = 0; j < 4; ++j) { lbv[j] = la[j]; lbv[4 + j] = lb[j]; }
    }
    u32x4 stv[3]; unsigned gwv[6];
    if (M3) {
#pragma unroll
        for (int i = 0; i < 3; ++i) { const int v = tid + 512 * i; stv[i] = *(const u32x4*)(c.sth + (long)unit * 12288 + (v >> 4) * 128 + (v & 15) * 8); }
        const bf16_t* gp = c.proj + (row0 + (tid >> 3)) * 3840 + 2944 + h * 96 + (tid & 7) * 12;
#pragma unroll
        for (int j = 0; j < 6; ++j) gwv[j] = *(const unsigned*)(gp + 2 * j);
    }
#pragma unroll
    for (int i = 0; i < 2; ++i) {
        const int e8 = tid + 512 * i, t = e8 >> 4, d0 = (e8 & 15) * 8;
        const bf16_t* pr = c.proj + (row0 + t) * 3840;
        const u32x4 vf = *(const u32x4*)(pr + 2048 + h * 128 + d0);
        float xf[8]; UNPACK8(vf, xf);
#pragma unroll
        for (int j = 0; j < 8; ++j) {
            const float s = 1.0f / (1.0f + __expf(-xf[j]));
            const float f = lbv[j] + (1.0f - lbv[j]) * s;
            if (M3) kk[i][j] = 1.0f - f; else Kb[t * 128 + d0 + j] = 1.0f - f;
            cum[t * 128 + d0 + j] = __logf(f);
        }
        if (M3) {
            const u32x4 vq = *(const u32x4*)(pr + 1536 + h * 128 + d0);
            float xq[8]; UNPACK8(vq, xq);
#pragma unroll
            for (int j = 0; j < 8; ++j) qq[i][j] = silu(xq[j]);
        }
    }
    for (int v = tid; v < 768; v += 512) {
        const int t = v & 63, e0 = (v >> 6) * 8;
        const u32x4 vi = *(const u32x4*)(c.proj + (row0 + t) * 3840 + 2560 + h * 96 + e0);
#pragma unroll
        for (int j = 0; j < 4; ++j) { inpT[(e0 + 2 * j) * 72 + t] = (bf16_t)(vi[j] & 0xffffu); inpT[(e0 + 2 * j + 1) * 72 + t] = (bf16_t)(vi[j] >> 16); }
    }
    lds_barrier();
    {
        LAS float* ptot = (LAS float*)(lds + 152064);
        const int d = tid & 127, part = tid >> 7;
        float v[16]; float run = 0.f;
#pragma unroll
        for (int t = 0; t < 16; ++t) { v[t] = cum[(part * 16 + t) * 128 + d]; run += v[t]; }
        ptot[part * 128 + d] = run;
        lds_barrier();
        float base = 0.f;
#pragma unroll
        for (int pp = 0; pp < 3; ++pp) base += (pp < part) ? ptot[pp * 128 + d] : 0.f;
        if (M3) {
#pragma unroll
            for (int t = 0; t < 16; ++t) { base += v[t]; cum[(part * 16 + t) * 128 + d] = base; }
            if (part == 1) ((LAS float*)(lds + 154112))[d] = __expf(base);
        } else {
            const float last = (ptot[d] + ptot[128 + d]) + (ptot[256 + d] + ptot[384 + d]);
            LAS bf16_t* KlT = (LAS bf16_t*)(lds + 32768);
            float e[16];
#pragma unroll
            for (int t = 0; t < 16; ++t) { base += v[t]; e[t] = Kb[(part * 16 + t) * 128 + d] * __expf(last - base); }
            u32x4 p0, p1;
#pragma unroll
            for (int q2 = 0; q2 < 4; ++q2) { p0[q2] = pk2(e[2 * q2], e[2 * q2 + 1]); p1[q2] = pk2(e[8 + 2 * q2], e[8 + 2 * q2 + 1]); }
            *(LAS u32x4*)(KlT + d * 72 + part * 16) = p0; *(LAS u32x4*)(KlT + d * 72 + part * 16 + 8) = p1;
            if (part == 3) c.lasth[(long)unit * 128 + d] = last;
        }
    }
    lds_barrier();
    if (!M3) {
        LAS bf16_t* KlT = (LAS bf16_t*)(lds + 32768);
        LAS bf16_t* kvs = (LAS bf16_t*)(lds + 99328);
        const int r = lane & 15, q = lane >> 4;
        for (int i = 0; i < 6; ++i) {
            const int idx = wid + 8 * i, et = idx >> 3, dt = idx & 7;
            f32x4 acc = (f32x4){0.f, 0.f, 0.f, 0.f};
            acc = mma16(inpT + et * 16 * 72, 72, KlT + dt * 16 * 72, 72, 64, acc, lane);
#pragma unroll
            for (int j = 0; j < 4; ++j) kvs[(et * 16 + q * 4 + j) * 136 + dt * 16 + r] = f2bf(acc[j]);
        }
        lds_barrier();
#pragma unroll
        for (int i = 0; i < 3; ++i) {
            const int v = tid + 512 * i, e = v >> 4, d0 = (v & 15) * 8;
            *(u32x4*)(c.sth + (long)unit * 12288 + e * 128 + d0) = *(const LAS u32x4*)(kvs + e * 136 + d0);
        }
        lds_barrier();
    } else {
        LAS bf16_t* Qp = (LAS bf16_t*)(lds + 32768); LAS bf16_t* Qm = (LAS bf16_t*)(lds + 50176);
        LAS bf16_t* Kp = (LAS bf16_t*)(lds + 67584); LAS bf16_t* Km = (LAS bf16_t*)(lds + 84992);
        LAS bf16_t* stT = (LAS bf16_t*)(lds + 116224); LAS bf16_t* S = (LAS bf16_t*)(lds + 142336);
        LAS float* O = (LAS float*)lds;
        LAS float* ecr = (LAS float*)(lds + 154112);
#pragma unroll
        for (int i = 0; i < 2; ++i) {
            const int e8 = tid + 512 * i, t = e8 >> 4, d0 = (e8 & 15) * 8;
            float qp[8], qm[8], kp[8], km[8];
#pragma unroll
            for (int j = 0; j < 8; ++j) {
                const float cref = cum[31 * 128 + d0 + j], cc = cum[t * 128 + d0 + j];
                const float ep = __expf(cc - cref), em = __expf(cref - cc);
                qp[j] = qq[i][j] * ep; qm[j] = qq[i][j] * em; kp[j] = kk[i][j] * ep; km[j] = kk[i][j] * em;
            }
            u32x4 a, b, cc4, d;
#pragma unroll
            for (int j = 0; j < 4; ++j) { a[j] = pk2(qp[2 * j], qp[2 * j + 1]); b[j] = pk2(qm[2 * j], qm[2 * j + 1]); cc4[j] = pk2(kp[2 * j], kp[2 * j + 1]); d[j] = pk2(km[2 * j], km[2 * j + 1]); }
            *(LAS u32x4*)(Qp + t * 136 + d0) = a; *(LAS u32x4*)(Qm + t * 136 + d0) = b; *(LAS u32x4*)(Kp + t * 136 + d0) = cc4; *(LAS u32x4*)(Km + t * 136 + d0) = d;
        }
#pragma unroll
        for (int i = 0; i < 3; ++i) {
            const int v = tid + 512 * i, e = v >> 4, d0 = (v & 15) * 8;
            const u32x4 s = stv[i];
            float sf[8]; UNPACK8(s, sf);
            u32x4 o;
#pragma unroll
            for (int j = 0; j < 4; ++j) o[j] = pk2(sf[2 * j] * ecr[d0 + 2 * j], sf[2 * j + 1] * ecr[d0 + 2 * j + 1]);
            *(LAS u32x4*)(stT + e * 136 + d0) = o;
        }
        lds_barrier();
        const int r = lane & 15, q = lane >> 4;
        for (int i = 0; i < 2; ++i) {
            const int idx = wid * 2 + i, ti = idx >> 2, tj = idx & 3;
            f32x4 s1 = (f32x4){0.f, 0.f, 0.f, 0.f}, s2 = (f32x4){0.f, 0.f, 0.f, 0.f};
            if (ti >= tj) s1 = mma16(Qp + ti * 16 * 136, 136, Km + tj * 16 * 136, 136, 128, s1, lane);
            if (ti <= tj) s2 = mma16(Qm + ti * 16 * 136, 136, Kp + tj * 16 * 136, 136, 128, s2, lane);
#pragma unroll
            for (int j = 0; j < 4; ++j) {
                const int t = ti * 16 + q * 4 + j, jj = tj * 16 + r;
                S[t * 72 + jj] = f2bf(t >= jj ? s1[j] : s2[j]);
            }
        }
        lds_barrier();
        for (int i = 0; i < 3; ++i) {
            const int idx = wid * 3 + i, tt = idx / 6, et = idx % 6;
            f32x4 acc = (f32x4){0.f, 0.f, 0.f, 0.f};
            acc = mma16(S + tt * 16 * 72, 72, inpT + et * 16 * 72, 72, 64, acc, lane);
            acc = mma16(Qp + tt * 16 * 136, 136, stT + et * 16 * 136, 136, 128, acc, lane);
#pragma unroll
            for (int j = 0; j < 4; ++j) O[(tt * 16 + q * 4 + j) * 100 + et * 16 + r] = acc[j];
        }
        lds_barrier();
        {
            const int t = tid >> 3, sub = tid & 7;
            float o[12], ss = 0.f;
#pragma unroll
            for (int j = 0; j < 12; ++j) { o[j] = O[t * 100 + sub * 12 + j]; ss += o[j] * o[j]; }
            ss += __shfl_xor(ss, 1); ss += __shfl_xor(ss, 2); ss += __shfl_xor(ss, 4);
            const float rstd = rsqrtf(ss * (1.0f / 96.0f) + 1e-6f);
            bf16_t* op = c.mix + (row0 + t) * 1024 + 384 + h * 96 + sub * 12;
            const float* gg = c.hg_norm_g + h * 96 + sub * 12;
#pragma unroll
            for (int j = 0; j < 6; ++j) {
                const unsigned gw = gwv[j];
                const float y0 = o[2 * j] * rstd * gg[2 * j] * silu(lo16(gw)), y1 = o[2 * j + 1] * rstd * gg[2 * j + 1] * silu(hi16(gw));
                *(unsigned*)(op + 2 * j) = pk2(y0, y1);
            }
        }
        lds_barrier();
    }
}

__device__ __forceinline__ void rope_tables(const MixCtx& c, long row0, LAS float* cs, LAS float* sn) {
    for (int p = ltid(); p < 3072; p += 512) {
        const int t = p / 48, i = p % 48;
        const float inv_freq = __expf(-9.210340371976184f * (float)i * (1.0f / 48.0f));
        const float ang = (float)c.pos[row0 + t] * inv_freq;
        const float k = rintf(ang * 0.15915494309189535f);
        float r = fmaf(-k, 6.28125f, ang); r = fmaf(-k, 1.9353071795864769e-3f, r);
        cs[p] = __cosf(r); sn[p] = __sinf(r);
    }
}
template <bool M3>
__device__ __forceinline__ void ret_unit(const MixCtx& c, int unit) {
    LAS unsigned char* lds = c.lds;
    const int tid = ltid(), wid = tid >> 6, lane = tid & 63;
    const int h = unit & 3; const long row0 = (long)(unit >> 2) * 64;
    const float lg = log1pf(-exp2f(-5.0f - (float)h));
    LAS float* cs = (LAS float*)lds; LAS float* sn = (LAS float*)(lds + 12288);
    u32x4 stv[3]; unsigned gwv[6];
    if (M3) {
#pragma unroll
        for (int i = 0; i < 3; ++i) { const int v = tid + 512 * i; if (v < 1152) stv[i] = *(const u32x4*)(c.str + (long)unit * 9216 + (v / 12) * 96 + (v % 12) * 8); }
        const bf16_t* gp = c.proj + (row0 + (tid >> 3)) * 3840 + 1152 + h * 96 + (tid & 7) * 12;
#pragma unroll
        for (int j = 0; j < 6; ++j) gwv[j] = *(const unsigned*)(gp + 2 * j);
    }
    LAS bf16_t* vT = (LAS bf16_t*)(lds + 51200);
    for (int v = tid; v < 768; v += 512) {
        const int t = v & 63, e0 = (v >> 6) * 8;
        const u32x4 vi = *(const u32x4*)(c.proj + (row0 + t) * 3840 + 768 + h * 96 + e0);
#pragma unroll
        for (int j = 0; j < 4; ++j) { vT[(e0 + 2 * j) * 72 + t] = (bf16_t)(vi[j] & 0xffffu); vT[(e0 + 2 * j + 1) * 72 + t] = (bf16_t)(vi[j] >> 16); }
    }
    const int r = lane & 15, q = lane >> 4;
    if (!M3) {
        LAS bf16_t* KdT = (LAS bf16_t*)(lds + 24576);
        if (tid < 384) {
            const int j = tid & 63, i0 = (tid >> 6) * 8;
            const bf16_t* kp = c.proj + (row0 + j) * 3840 + 384 + h * 96;
            const u32x4 v1 = *(const u32x4*)(kp + i0), v2 = *(const u32x4*)(kp + 48 + i0);
            float k1[8], k2[8]; UNPACK8(v1, k1); UNPACK8(v2, k2);
            const float dec = __expf(lg * (float)(63 - j));
            const f32x4 c0 = *(const f32x4*)(c.rcs + (row0 + j) * 48 + i0), c1 = *(const f32x4*)(c.rcs + (row0 + j) * 48 + i0 + 4);
            const f32x4 s0 = *(const f32x4*)(c.rsn + (row0 + j) * 48 + i0), s1 = *(const f32x4*)(c.rsn + (row0 + j) * 48 + i0 + 4);
#pragma unroll
            for (int e = 0; e < 8; ++e) {
                const float co = (e < 4) ? c0[e & 3] : c1[e & 3], si = (e < 4) ? s0[e & 3] : s1[e & 3];
                KdT[(i0 + e) * 72 + j] = f2bf((k1[e] * co - k2[e] * si) * dec);
                KdT[(48 + i0 + e) * 72 + j] = f2bf((k1[e] * si + k2[e] * co) * dec);
            }
        }
        lds_barrier();
        LAS bf16_t* kvs = (LAS bf16_t*)(lds + 65536);
        for (int i = 0; i < 5; ++i) {
            const int idx = wid + 8 * i;
            if (idx < 36) {
                const int et = idx / 6, dt = idx % 6;
                f32x4 acc = (f32x4){0.f, 0.f, 0.f, 0.f};
                acc = mma16(vT + et * 16 * 72, 72, KdT + dt * 16 * 72, 72, 64, acc, lane);
#pragma unroll
                for (int j = 0; j < 4; ++j) kvs[(et * 16 + q * 4 + j) * 104 + dt * 16 + r] = f2bf(acc[j]);
            }
        }
        lds_barrier();
#pragma unroll
        for (int i = 0; i < 3; ++i) { const int v = tid + 512 * i; if (v < 1152) *(u32x4*)(c.str + (long)unit * 9216 + (v / 12) * 96 + (v % 12) * 8) = *(const LAS u32x4*)(kvs + (v / 12) * 104 + (v % 12) * 8); }
        lds_barrier();
    } else {
        LAS bf16_t* Qr = (LAS bf16_t*)(lds + 24576); LAS bf16_t* Kr = (LAS bf16_t*)(lds + 37888);
        LAS bf16_t* stT = (LAS bf16_t*)(lds + 65024);
        LAS bf16_t* S = (LAS bf16_t*)(lds + 84992);
        LAS float* O = (LAS float*)(lds + 94208);
        if (tid < 384) {
            const int j = tid / 6, i0 = (tid % 6) * 8;
            const bf16_t* qp = c.proj + (row0 + j) * 3840 + h * 96;
            const bf16_t* kp = qp + 384;
            const u32x4 vq1 = *(const u32x4*)(qp + i0), vq2 = *(const u32x4*)(qp + 48 + i0), vk1 = *(const u32x4*)(kp + i0), vk2 = *(const u32x4*)(kp + 48 + i0);
            float q1[8], q2[8], k1[8], k2[8]; UNPACK8(vq1, q1); UNPACK8(vq2, q2); UNPACK8(vk1, k1); UNPACK8(vk2, k2);
            const float sc = 0.10206207261596575f;
            float qa[8], qb[8], ka[8], kb[8];
            const f32x4 c0 = *(const f32x4*)(c.rcs + (row0 + j) * 48 + i0), c1 = *(const f32x4*)(c.rcs + (row0 + j) * 48 + i0 + 4);
            const f32x4 s0 = *(const f32x4*)(c.rsn + (row0 + j) * 48 + i0), s1 = *(const f32x4*)(c.rsn + (row0 + j) * 48 + i0 + 4);
#pragma unroll
            for (int e = 0; e < 8; ++e) {
                const float co = (e < 4) ? c0[e & 3] : c1[e & 3], si = (e < 4) ? s0[e & 3] : s1[e & 3];
                qa[e] = (q1[e] * co - q2[e] * si) * sc; qb[e] = (q1[e] * si + q2[e] * co) * sc;
                ka[e] = k1[e] * co - k2[e] * si; kb[e] = k1[e] * si + k2[e] * co;
            }
            u32x4 o1, o2, o3, o4;
#pragma unroll
            for (int e = 0; e < 4; ++e) { o1[e] = pk2(qa[2 * e], qa[2 * e + 1]); o2[e] = pk2(qb[2 * e], qb[2 * e + 1]); o3[e] = pk2(ka[2 * e], ka[2 * e + 1]); o4[e] = pk2(kb[2 * e], kb[2 * e + 1]); }
            *(LAS u32x4*)(Qr + j * 104 + i0) = o1; *(LAS u32x4*)(Qr + j * 104 + 48 + i0) = o2;
            *(LAS u32x4*)(Kr + j * 104 + i0) = o3; *(LAS u32x4*)(Kr + j * 104 + 48 + i0) = o4;
        }
#pragma unroll
        for (int i = 0; i < 3; ++i) { const int v = tid + 512 * i; if (v < 1152) *(LAS u32x4*)(stT + (v / 12) * 104 + (v % 12) * 8) = stv[i]; }
        lds_barrier();
        for (int i = 0; i < 2; ++i) {
            const int idx = wid * 2 + i, ti = idx >> 2, tj = idx & 3;
            f32x4 s = (f32x4){0.f, 0.f, 0.f, 0.f};
            s = mma16(Qr + ti * 16 * 104, 104, Kr + tj * 16 * 104, 104, 96, s, lane);
#pragma unroll
            for (int j = 0; j < 4; ++j) {
                const int t = ti * 16 + q * 4 + j, jj = tj * 16 + r;
                const int dd = t > jj ? t - jj : jj - t;
                S[t * 72 + jj] = f2bf(s[j] * __expf(lg * (float)dd));
            }
        }
        lds_barrier();
        for (int i = 0; i < 3; ++i) {
            const int idx = wid * 3 + i, tt = idx / 6, et = idx % 6;
            f32x4 a1 = (f32x4){0.f, 0.f, 0.f, 0.f}, a2 = (f32x4){0.f, 0.f, 0.f, 0.f};
            a1 = mma16(S + tt * 16 * 72, 72, vT + et * 16 * 72, 72, 64, a1, lane);
            a2 = mma16(Qr + tt * 16 * 104, 104, stT + et * 16 * 104, 104, 96, a2, lane);
#pragma unroll
            for (int j = 0; j < 4; ++j) { const int t = tt * 16 + q * 4 + j; O[t * 100 + et * 16 + r] = a1[j] + __expf(lg * (float)(t + 1)) * a2[j]; }
        }
        lds_barrier();
        {
            const int t = tid >> 3, sub = tid & 7;
            float o[12], sm = 0.f;
#pragma unroll
            for (int j = 0; j < 12; ++j) { o[j] = O[t * 100 + sub * 12 + j]; sm += o[j]; }
            sm += __shfl_xor(sm, 1); sm += __shfl_xor(sm, 2); sm += __shfl_xor(sm, 4);
            const float mean = sm * (1.0f / 96.0f);
            float ss = 0.f;
#pragma unroll
            for (int j = 0; j < 12; ++j) { o[j] -= mean; ss += o[j] * o[j]; }
            ss += __shfl_xor(ss, 1); ss += __shfl_xor(ss, 2); ss += __shfl_xor(ss, 4);
            const float rstd = rsqrtf(ss * (1.0f / 96.0f) + 1e-6f);
            bf16_t* op = c.mix + (row0 + t) * 1024 + h * 96 + sub * 12;
            const float* gg = c.ret_gn_g + h * 96 + sub * 12;
#pragma unroll
            for (int j = 0; j < 6; ++j) {
                const unsigned gw = gwv[j];
                const float y0 = o[2 * j] * rstd * gg[2 * j] * silu(lo16(gw)), y1 = o[2 * j + 1] * rstd * gg[2 * j + 1] * silu(hi16(gw));
                *(unsigned*)(op + 2 * j) = pk2(y0, y1);
            }
        }
        lds_barrier();
    }
}

__device__ __forceinline__ void lru_m1(const MixCtx& c, int unit) {
    LAS unsigned char* lds = c.lds;
    const int tid = ltid(), wid = tid >> 6, lane = tid & 63;
    const int hh = unit & 1, bn = unit >> 1, n = bn & 127; const long row0 = (long)bn * 64; const int c0 = hh * 128;
    LAS float* xc = (LAS float*)lds; LAS float* Aa = (LAS float*)(lds + 32768); LAS bf16_t* xcb = (LAS bf16_t*)(lds + 65536);
    LAS bf16_t* lxs = (LAS bf16_t*)(lds + 83968);
    for (int v = tid; v < 67 * 16; v += 512) {
        const int rr = v >> 4, cc = (v & 15) * 8, tt = rr - 3;
        u32x4 val = (u32x4){0u, 0u, 0u, 0u};
        if (n * 64 + tt >= 0) val = *(const u32x4*)(c.proj + (row0 + tt) * 3840 + 3328 + c0 + cc);
        *(LAS u32x4*)(lxs + rr * 128 + cc) = val;
    }
    LAS bf16_t* wsm = (LAS bf16_t*)(lds + 101376);
#pragma unroll
    for (int i = 0; i < 4; ++i) {
        const int v = tid + 512 * i, mat = v >> 10, nbl = (v >> 9) & 1, d = (v >> 3) & 63, c8 = (v & 7) * 8;
        const u32x4 val = *(const u32x4*)((mat ? c.wxT : c.waT) + (hh * 2 + nbl) * 4096 + d * 64 + c8);
        *(LAS u32x4*)(wsm + ((mat * 2 + nbl) * 64 + d) * 72 + c8) = val;
    }
    const int cc = tid & 127, ch = c0 + cc;
    const float cw0 = c.conv_w[ch], cw1 = c.conv_w[256 + ch], cw2 = c.conv_w[512 + ch], cw3 = c.conv_w[768 + ch], cbv = c.conv_b[ch];
    lds_barrier();
#pragma unroll
    for (int i = 0; i < 16; ++i) {
        const int t = (tid >> 7) + 4 * i;
        const float acc = cbv + cw0 * bf2f(lxs[t * 128 + cc]) + cw1 * bf2f(lxs[(t + 1) * 128 + cc]) + cw2 * bf2f(lxs[(t + 2) * 128 + cc]) + cw3 * bf2f(lxs[(t + 3) * 128 + cc]);
        xc[t * 128 + cc] = acc; xcb[t * 136 + cc] = f2bf(acc);
    }
    lds_barrier();
    const int r = lane & 15, q = lane >> 4;
    for (int i = 0; i < 4; ++i) {
        const int idx = wid * 4 + i, nbl = idx >> 4, tt = (idx >> 2) & 3, dt = idx & 3;
        f32x4 ar = (f32x4){0.f, 0.f, 0.f, 0.f}, ai = (f32x4){0.f, 0.f, 0.f, 0.f};
#pragma unroll
        for (int k0 = 0; k0 < 64; k0 += 32) {
            const bf16x8 a = *(const LAS bf16x8*)(xcb + (tt * 16 + r) * 136 + nbl * 64 + k0 + q * 8);
            const bf16x8 b1 = *(const LAS bf16x8*)(wsm + ((0 + nbl) * 64 + dt * 16 + r) * 72 + k0 + q * 8);
            const bf16x8 b2 = *(const LAS bf16x8*)(wsm + ((2 + nbl) * 64 + dt * 16 + r) * 72 + k0 + q * 8);
            ar = __builtin_amdgcn_mfma_f32_16x16x32_bf16(a, b1, ar, 0, 0, 0);
            ai = __builtin_amdgcn_mfma_f32_16x16x32_bf16(a, b2, ai, 0, 0, 0);
        }
        const int c2 = nbl * 64 + dt * 16 + r, ch2 = c0 + c2;
        const float sp = log1pf(expf(-c.lam[ch2])), bav = c.ba[ch2], bxv = c.bx[ch2];
#pragma unroll
        for (int j = 0; j < 4; ++j) {
            const int t = tt * 16 + q * 4 + j;
            const float rr = 1.0f / (1.0f + __expf(-(ar[j] + bav))), ii = 1.0f / (1.0f + __expf(-(ai[j] + bxv)));
            const float la = -8.0f * sp * rr;
            const float a = __expf(la);
            const float u = sqrtf(fmaxf(1.0f - a * a, 0.f)) * ii * xc[t * 128 + c2];
            Aa[t * 128 + c2] = a; xc[t * 128 + c2] = u;
        }
    }
    lds_barrier();
    {
        LAS float* pt = (LAS float*)(lds + 138240);
        const int part = tid >> 7;
        float hs = 0.f, P = 1.f;
#pragma unroll
        for (int t = part * 16; t < part * 16 + 16; ++t) {
            const float a = Aa[t * 128 + cc], u = xc[t * 128 + cc];
            hs = a * hs + u; P *= a;
            xc[t * 128 + cc] = hs; Aa[t * 128 + cc] = P;
        }
        pt[part * 128 + cc] = P; pt[512 + part * 128 + cc] = hs;
        lds_barrier();
        float ch_ = 0.f, cP = 1.f;
#pragma unroll
        for (int pp = 0; pp < 3; ++pp) if (pp < part) { const float Pp = pt[pp * 128 + cc], hp = pt[512 + pp * 128 + cc]; ch_ = Pp * ch_ + hp; cP *= Pp; }
        if (part > 0) {
#pragma unroll
            for (int t = part * 16; t < part * 16 + 16; ++t) {
                const float Pl = Aa[t * 128 + cc];
                xc[t * 128 + cc] += Pl * ch_; Aa[t * 128 + cc] = Pl * cP;
            }
        }
        if (part == 3) { c.lruhe[(long)bn * 256 + ch] = xc[63 * 128 + cc]; c.lrupe[(long)bn * 256 + ch] = Aa[63 * 128 + cc]; }
    }
    lds_barrier();
#pragma unroll
    for (int i = 0; i < 2; ++i) {
        const int v = tid + 512 * i, t = v >> 4, c8 = (v & 15) * 8;
        const f32x4 h0 = *(const LAS f32x4*)(xc + t * 128 + c8), h1 = *(const LAS f32x4*)(xc + t * 128 + c8 + 4);
        const f32x4 p0 = *(const LAS f32x4*)(Aa + t * 128 + c8), p1 = *(const LAS f32x4*)(Aa + t * 128 + c8 + 4);
        u32x4 ph, pp; ph[0] = pk2(h0[0], h0[1]); ph[1] = pk2(h0[2], h0[3]); ph[2] = pk2(h1[0], h1[1]); ph[3] = pk2(h1[2], h1[3]);
        pp[0] = pk2(p0[0], p0[1]); pp[1] = pk2(p0[2], p0[3]); pp[2] = pk2(p1[0], p1[1]); pp[3] = pk2(p1[2], p1[3]);
        *(u32x4*)(c.lruh + (row0 + t) * 256 + c0 + c8) = ph; *(u32x4*)(c.lrup + (row0 + t) * 256 + c0 + c8) = pp;
    }
    lds_barrier();
}
__device__ __forceinline__ void lru_m3(const MixCtx& c, int bn) {
    const int tid = ltid(); const long row0 = (long)bn * 64;
#pragma unroll
    for (int i = 0; i < 4; ++i) {
        const int v = tid + 512 * i, t = v >> 5, cc = (v & 31) * 8;
        const u32x4 hv = *(const u32x4*)(c.lruh + (row0 + t) * 256 + cc);
        const u32x4 pv = *(const u32x4*)(c.lrup + (row0 + t) * 256 + cc);
        const u32x4 gv = *(const u32x4*)(c.proj + (row0 + t) * 3840 + 3584 + cc);
        const f32x4 ca = *(const f32x4*)(c.lruci + (long)bn * 256 + cc), cb = *(const f32x4*)(c.lruci + (long)bn * 256 + cc + 4);
        float hf[8], pf[8], gf[8]; UNPACK8(hv, hf); UNPACK8(pv, pf); UNPACK8(gv, gf);
        float o[8];
#pragma unroll
        for (int j = 0; j < 4; ++j) { o[j] = (hf[j] + pf[j] * ca[j]) * gelu_tanh(gf[j]); o[4 + j] = (hf[4 + j] + pf[4 + j] * cb[j]) * gelu_tanh(gf[4 + j]); }
        u32x4 pk; pk[0] = pk2(o[0], o[1]); pk[1] = pk2(o[2], o[3]); pk[2] = pk2(o[4], o[5]); pk[3] = pk2(o[6], o[7]);
        *(u32x4*)(c.mix + (row0 + t) * 1024 + 768 + cc) = pk;
    }
}

__device__ __forceinline__ void phase_scan(const MixCtx& c) {
    const long gt = (long)blockIdx.x * NTHREADS + ltid();
    if (gt < 49152) {
        const int bh = (int)(gt / 3072), g4 = (int)(gt % 3072), b = bh >> 2, h = bh & 3, d0 = (g4 * 4) & 127;
        float s0 = 0.f, s1 = 0.f, s2 = 0.f, s3 = 0.f;
        for (int n0 = 0; n0 < 128; n0 += 8) {
            u32x2 kv[8]; f32x4 la[8];
#pragma unroll
            for (int i = 0; i < 8; ++i) {
                const long unit = ((long)(b * 128 + n0 + i)) * 4 + h;
                kv[i] = *(const u32x2*)(c.sth + unit * 12288 + g4 * 4);
                la[i] = *(const f32x4*)(c.lasth + unit * 128 + d0);
            }
#pragma unroll
            for (int i = 0; i < 8; ++i) {
                const long unit = ((long)(b * 128 + n0 + i)) * 4 + h;
                u32x2 o; o[0] = pk2(s0, s1); o[1] = pk2(s2, s3); *(u32x2*)(c.sth + unit * 12288 + g4 * 4) = o;
                s0 = __expf(la[i][0]) * s0 + lo16(kv[i][0]); s1 = __expf(la[i][1]) * s1 + hi16(kv[i][0]);
                s2 = __expf(la[i][2]) * s2 + lo16(kv[i][1]); s3 = __expf(la[i][3]) * s3 + hi16(kv[i][1]);
            }
        }
    } else if (gt < 49152 + 36864) {
        const long g = gt - 49152; const int bh = (int)(g / 2304), g4 = (int)(g % 2304), b = bh >> 2, h = bh & 3;
        const float dec = expf(64.0f * log1pf(-exp2f(-5.0f - (float)h)));
        float s0 = 0.f, s1 = 0.f, s2 = 0.f, s3 = 0.f;
        for (int n0 = 0; n0 < 128; n0 += 8) {
            u32x2 kv[8];
#pragma unroll
            for (int i = 0; i < 8; ++i) { const long unit = ((long)(b * 128 + n0 + i)) * 4 + h; kv[i] = *(const u32x2*)(c.str + unit * 9216 + g4 * 4); }
#pragma unroll
            for (int i = 0; i < 8; ++i) {
                const long unit = ((long)(b * 128 + n0 + i)) * 4 + h;
                u32x2 o; o[0] = pk2(s0, s1); o[1] = pk2(s2, s3); *(u32x2*)(c.str + unit * 9216 + g4 * 4) = o;
                s0 = dec * s0 + lo16(kv[i][0]); s1 = dec * s1 + hi16(kv[i][0]); s2 = dec * s2 + lo16(kv[i][1]); s3 = dec * s3 + hi16(kv[i][1]);
            }
        }
    } else if (gt < 49152 + 36864 + 1024) {
        const int g = (int)(gt - 49152 - 36864), b = g >> 8, ch = g & 255;
        float carry = 0.f;
        for (int n0 = 0; n0 < 128; n0 += 8) {
            float pe[8], he[8];
#pragma unroll
            for (int i = 0; i < 8; ++i) { const long o = (long)(b * 128 + n0 + i) * 256 + ch; pe[i] = c.lrupe[o]; he[i] = c.lruhe[o]; }
#pragma unroll
            for (int i = 0; i < 8; ++i) { const long o = (long)(b * 128 + n0 + i) * 256 + ch; c.lruci[o] = carry; carry = pe[i] * carry + he[i]; }
        }
    }
}

#define XB_TMO      128
#define XB_XCNT(j)  (256  + 64 * (j))
#define XB_XSUB(j)  (1280 + 64 * (j))
#define XB_XGEN(j)  (2304 + 64 * (j))
#define XB_TOP      3328
#define XB_TOPGEN   3392
#define XCD_BAR_WORDS 3456
#define XB_SPIN_CAP (1u << 18)
__device__ __forceinline__ unsigned xb_ld(unsigned* p)              { return __hip_atomic_load(p, __ATOMIC_RELAXED, __HIP_MEMORY_SCOPE_AGENT); }
__device__ __forceinline__ unsigned xb_add(unsigned* p, unsigned v) { return __hip_atomic_fetch_add(p, v, __ATOMIC_RELAXED, __HIP_MEMORY_SCOPE_AGENT); }
__device__ __forceinline__ unsigned xb_xcc_id() { return (unsigned)__builtin_amdgcn_s_getreg((3 << 11) | 20) & 0xFu; }
#define XB_SPIN(cond, bar) do { unsigned _sp = 0; while (cond) { __builtin_amdgcn_s_sleep(1); \
    if ((++_sp & 255u) == 0u) { if (xb_ld(&(bar)[XB_TMO])) break; if (_sp > XB_SPIN_CAP) { atomicAdd(&(bar)[XB_TMO], 1u); break; } } } } while (0)
struct XcdBarrier { unsigned* bar; unsigned x; volatile LAS unsigned* st; };
__device__ __forceinline__ XcdBarrier xcd_barrier_post(unsigned* bar, volatile LAS unsigned* st) {
    XcdBarrier b; b.bar = bar; b.x = xb_xcc_id(); b.st = st;
    if (threadIdx.x == 0) (void)xb_add(&bar[XB_XCNT(b.x)], 1u);
    return b;
}
__device__ __forceinline__ void xcd_barrier_complete(unsigned* bar, unsigned x, unsigned& nloc, unsigned& nx) {
    const unsigned G = gridDim.x * gridDim.y * gridDim.z;
    unsigned sum, cnt, mine, sp = 0u;
    for (;;) {
        sum = 0u; cnt = 0u; mine = 0u;
#pragma unroll
        for (unsigned j = 0; j < 16; ++j) { const unsigned c = xb_ld(&bar[XB_XCNT(j)]); sum += c; cnt += (c > 0u) ? 1u : 0u; mine = (j == x) ? c : mine; }
        if (sum == G) break;
        __builtin_amdgcn_s_sleep(1);
        if ((++sp & 255u) == 0u) { if (xb_ld(&bar[XB_TMO])) break; if (sp > XB_SPIN_CAP) { atomicAdd(&bar[XB_TMO], 1u); break; } }
    }
    nloc = mine > 0u ? mine : 1u; nx = cnt > 0u ? cnt : 1u;
}
__device__ __forceinline__ void xcd_barrier(const XcdBarrier& b) {
    asm volatile("s_waitcnt vmcnt(0)" ::: "memory");
    __syncthreads();
    if (threadIdx.x == 0) {
        unsigned* bar = b.bar;
        __builtin_amdgcn_s_waitcnt(0);
        unsigned nloc = b.st[0], nx = b.st[1];
        if (nloc == 0u) { xcd_barrier_complete(bar, b.x, nloc, nx); b.st[0] = nloc; b.st[1] = nx; }
        const unsigned old = xb_add(&bar[XB_XSUB(b.x)], 1u);
        const unsigned gen = old / nloc;
        if (old + 1u == (gen + 1u) * nloc) {
            __builtin_amdgcn_fence(__ATOMIC_RELEASE, "agent");
            asm volatile("s_waitcnt vmcnt(0)" ::: "memory");
            const unsigned og = xb_add(&bar[XB_TOP], 1u);
            const unsigned tg = og / nx;
            if (og + 1u == (tg + 1u) * nx) xb_add(&bar[XB_TOPGEN], 1u);
            else XB_SPIN(xb_ld(&bar[XB_TOPGEN]) == tg, bar);
            __builtin_amdgcn_fence(__ATOMIC_ACQUIRE, "agent");
            xb_add(&bar[XB_XGEN(b.x)], 1u);
            asm volatile("s_waitcnt vmcnt(0)" ::: "memory");
        } else {
            XB_SPIN(xb_ld(&bar[XB_XGEN(b.x)]) == gen, bar);
            __builtin_amdgcn_fence(__ATOMIC_ACQUIRE, "agent");
            asm volatile("s_waitcnt vmcnt(0)" ::: "memory");
        }
    }
    __syncthreads();
}

__global__ void __launch_bounds__(NTHREADS) mega(Params p) {
    extern __shared__ __attribute__((aligned(16))) unsigned char shm[];
    LAS unsigned char* lds = (LAS unsigned char*)shm;
    cg::grid_group grid = cg::this_grid();
    const int G = gridDim.x, cb = blockIdx.x;
    volatile LAS unsigned* xst = (volatile LAS unsigned*)(lds + LDS_BYTES - 16);
    if (threadIdx.x < 2) xst[threadIdx.x] = 0u;
    __syncthreads();
    const XcdBarrier xb = xcd_barrier_post((unsigned*)(WSP + WS_BAR), xst);
#define ws WSP
#define BIG ((bf16_t*)(WSP + WS_BIG))
#define Hb ((bf16_t*)XOUT)
#define XB ((bf16_t*)(WSP + WS_H))
#define MEMN ((bf16_t*)(WSP + WS_MEMN))
#define KMEM ((bf16_t*)(WSP + WS_KMEM))
#define KV ((bf16_t*)(WSP + WS_KMEM))
#define MBT ((bf16_t*)(WSP + WS_MBT))
#define VWT ((bf16_t*)(WSP + WS_VWT))
#define VT ((bf16_t*)(WSP + WS_VT))
#define Qb (BIG + 32768l * 1024)
#define Pb (BIG + 2 * 32768l * 1024)
#define SSP(i) ((float*)(WSP + WS_SS) + (long)((i) & 1) * 32768 * 16)
#define X XOUT

    for (int ph = 0; ph < 38; ++ph) {
        const int l = ph / 19, k = ph % 19;

        GJob g{}; Epi E{}; bool is_gemm = true;
        g.lda = 1024; g.ldb = 1024; g.K = 1024; g.nM = 128; g.nN = 4; g.nZ = 1; E.scale = 1.0f; E.ldo = 1024;
        const float* ng = nullptr;
        switch (k) {
            case 1: g.A = XB; g.Bt = (const bf16_t*)(ws + WB_UP1); g.nN = 22; E.O = BIG; E.ss_in = SSP(l * 4 + 0); for (int rr = 0; rr < REP_GEMM; ++rr) { PH(2) gemm_phase<0>(lds, g, E, G, cb); } break;
            case 17: g.A = XB; g.Bt = (const bf16_t*)(ws + WB_UP2); g.nN = 22; E.O = BIG; E.ss_in = SSP(l * 4 + 3); for (int rr = 0; rr < REP_GEMM; ++rr) { PH(18) gemm_phase<0>(lds, g, E, G, cb); } break;
            case 2: case 3: continue;
            case 4: g.A = BIG; g.Bt = (const bf16_t*)(ws + WB_DN1); g.lda = 2816; g.ldb = 2816; g.K = 2816; E.resb = XB; E.scale = 0.5f; E.ss_out = SSP(l * 4 + 1); for (int rr = 0; rr < REP_GEMM; ++rr) { E.O = (rr == REP_GEMM - 1) ? XB : Hb; PH(4) gemm_phase<1>(lds, g, E, G, cb); } break;
            case 18: g.A = BIG; g.Bt = (const bf16_t*)(ws + WB_DN2); g.lda = 2816; g.ldb = 2816; g.K = 2816; E.resb = XB; E.scale = 0.5f; E.ss_out = SSP(l * 4 + 4); for (int rr = 0; rr < REP_GEMM; ++rr) { E.O = (rr == REP_GEMM - 1) ? XB : Hb; PH(19) gemm_phase<1>(lds, g, E, G, cb); } break;
            case 6: g.A = XB; g.Bt = (const bf16_t*)(ws + WB_IN); g.nN = 15; E.O = BIG; E.ldo = 3840; E.ss_in = SSP(l * 4 + 1); for (int rr = 0; rr < REP_GEMM; ++rr) { PH(5) gemm_phase<2>(lds, g, E, G, cb); }
                {
                GJob g2{}; Epi E2{}; g2.lda = 1024; g2.ldb = 1024; g2.K = 1024; g2.nZ = 1; E2.scale = 1.0f;
                g2.A = MEMN; g2.Bt = (const bf16_t*)(ws + WB_KV); g2.nM = 4; g2.nN = 8; E2.O = KV; E2.ldo = 2048; gemm_phase<2>(lds, g2, E2, G, (cb + 128) % G);
                } break;
            case 10:
                g.A = Hb; g.Bt = (const bf16_t*)(ws + WB_OUT); E.resb = XB; E.ss_out = SSP(l * 4 + 2); for (int rr = 0; rr < REP_GEMM; ++rr) { E.O = (rr == REP_GEMM - 1) ? XB : BIG; PH(13) gemm_phase<1>(lds, g, E, G, cb); } break;
            case 12: continue;
            case 13: g.A = XB; g.aZ1 = 8192l * 1024; g.Bt = MBT; g.bZ1 = 1024l * 1024; g.nM = 32; g.nN = 4; g.nZ = 4; g.rowZ = 8192;
                     E.O = Pb; E.rowZ = 8192; E.ss_in = SSP(l * 4 + 2); E.tab = (LAS float*)(lds + 131072); for (int rr = 0; rr < REP_GEMM; ++rr) { PH(15) gemm_phase<3>(lds, g, E, G, cb); } break;
            case 14: continue;
            case 15: g.A = Pb; g.aZ1 = 8192l * 1024; g.Bt = VWT; g.bZ1 = 1024l * 1024; g.nM = 32; g.nN = 4; g.nZ = 4; E.rowZ = 8192;
                     E.resb = XB; E.ss_out = SSP(l * 4 + 3); for (int rr = 0; rr < REP_GEMM; ++rr) { E.O = (rr == REP_GEMM - 1) ? XB : BIG; PH(17) gemm_phase<1>(lds, g, E, G, cb); } break;
            case 0: is_gemm = false; ng = PIN(3); break;
            case 5: case 11: case 16: continue;
            default: is_gemm = false; break;
        }
        if (is_gemm) {
        } else if (ng != nullptr) {
            for (int rr = 0; rr < REP_EW; ++rr) {
            if (k == 0) { PH(0) phase_convert(l, lds, 0, 768); PH(0) phase_convert(l, lds, 832, 1024); PH(0) phase_convert_lru(l, lds);
                          PH(0) phase_convert_straight(PIN(22) + l * 1024l * 1024, PIN(20) + l * 1024, (bf16_t*)(ws + WB_Q)); }
            if (l == 0) { PH(1) phase_prep(PIN(0), XB, SSP(0), 32768); PH(1) phase_rope_table((const int*)PIN(2), XOUT + 16777216l, XOUT + 16777216l + 32768l * 48);
                          if (cb == 0) { const int j = ltid(); const float* hp = PIN(10); (XOUT + 16777216l + 2 * 32768l * 48)[j] = sigm(hp[512 + j] - hp[j]); } }
            PH(1) phase_norm(PIN(1), PIN(21) + l * 1024, MEMN, 1024);
            }
        } else {
        MixCtx mc;
            mc.lds = lds; mc.proj = BIG; mc.mix = Hb; mc.sth = (bf16_t*)(ws + WS_STH); mc.str = (bf16_t*)(ws + WS_STR); mc.lasth = (float*)(ws + WS_LASTH);
            mc.lrup = (bf16_t*)(ws + WS_LRUP); mc.lruh = (bf16_t*)(ws + WS_LRUH); mc.lrupe = (float*)(ws + WS_LRUPE); mc.lruhe = (float*)(ws + WS_LRUHE); mc.lruci = (float*)(ws + WS_LRUCI);
            mc.waT = (const bf16_t*)(ws + WB_WA); mc.wxT = (const bf16_t*)(ws + WB_WX);
            mc.pos = (const int*)PIN(2); mc.hg_lb = PIN(10); mc.rcs = XOUT + 16777216l; mc.rsn = XOUT + 16777216l + 32768l * 48; mc.lb1 = XOUT + 16777216l + 2 * 32768l * 48;
            mc.ret_gn_g = PIN(9) + l * 384; mc.hg_norm_g = PIN(11) + l * 384;
            mc.conv_w = PIN(12) + l * 1024; mc.conv_b = PIN(13) + l * 256; mc.ba = PIN(15) + l * 256; mc.bx = PIN(17) + l * 256; mc.lam = PIN(18) + l * 256;
            mc.l = l;
            if (k == 7) {
                for (int rr = 0; rr < REP_MIX; ++rr) for (int idx = cb; idx < 5120; idx += G) {
                    const int kk5 = idx % 5, u = idx / 5;
                    if (kk5 < 2) { RMT(0) ret_unit<false>(mc, 2 * u + kk5); }
                    else if (kk5 < 4) { RMT(1) hg_unit<false>(mc, 2 * u + (kk5 - 2)); }
                    else { RMT(2) lru_m1(mc, u); }
                }
                {
                GJob g2{}; Epi E2{}; g2.A = KV; g2.lda = 2048; g2.aZ1 = 256l * 2048; g2.aZ2 = 256; g2.Bt = (const bf16_t*)(ws + WB_Q); g2.ldb = 1024; g2.bZ2 = 256; g2.K = 256; g2.nM = 1; g2.nN = 4; g2.nZ = 16; g2.zshift = 2;
                E2.O = MBT; E2.ldo = 1024; E2.oZ1 = 1024l * 1024; E2.oZ2 = 256l * 1024; E2.zshift = 2; E2.scale = 0.0625f; gemm_phase<2>(lds, g2, E2, G, cb);
                GJob g3{}; Epi E3{}; g3.A = (const bf16_t*)(ws + WB_O); g3.lda = 1024; g3.aZ2 = 256; g3.Bt = KV + 1024; g3.ldb = 2048; g3.bZ1 = 256l * 2048; g3.bZ2 = 256; g3.K = 256; g3.nM = 4; g3.nN = 1; g3.nZ = 16; g3.zshift = 2;
                E3.O = VWT; E3.ldo = 1024; E3.oZ1 = 1024l * 1024; E3.oZ2 = 256; E3.zshift = 2; E3.scale = 1.0f; gemm_phase<2>(lds, g3, E3, G, (cb + 64) % G);
                                }
            } else if (k == 8) {
                PH(9) phase_scan(mc);
                PH(0) phase_convert(l, lds, 768, 832);
                PH(0) phase_convert(l, lds, 1024, 1552);
            } else {
                for (int rr = 0; rr < REP_MIX; ++rr) for (int idx = cb; idx < 4608; idx += G) {
                    const int kk9 = idx % 9, u = idx / 9;
                    if (kk9 < 4) { RMT(3) ret_unit<true>(mc, 4 * u + kk9); }
                    else if (kk9 < 8) { RMT(4) hg_unit<true>(mc, 4 * u + (kk9 - 4)); }
                    else { RMT(5) lru_m3(mc, u); }
                }
            }
        }
        if (ph == 0) grid.sync(); else xcd_barrier(xb);
    }
    PH(20) phase_final_norm(XB, X, PIN(29), 32768);
}

#undef ws
#undef BIG
#undef Hb
#undef XB
#undef MEMN
#undef KMEM
#undef KV
#undef MBT
#undef VWT
#undef VT
#undef Qb
#undef SSP
#undef Pb
#undef X
extern "C" void kernel_launch(void* const* d_in, const int* in_sizes, int n_in, void* d_out, int out_size, void* d_ws, size_t ws_size, hipStream_t stream) {
    static int grid = 0;
    if (grid == 0) {
        int dev = 0, cus = 0, per_cu = 0;
        (void)hipGetDevice(&dev);
        (void)hipDeviceGetAttribute(&cus, hipDeviceAttributeMultiprocessorCount, dev);
        if (hipFuncSetAttribute((const void*)mega, hipFuncAttributeMaxDynamicSharedMemorySize, LDS_BYTES) != hipSuccess) fprintf(stderr, "kernel_launch: hipFuncSetAttribute failed\n");
        if (hipOccupancyMaxActiveBlocksPerMultiprocessor(&per_cu, (const void*)mega, NTHREADS, LDS_BYTES) != hipSuccess || per_cu < 1) { fprintf(stderr, "kernel_launch: occupancy query says %d\n", per_cu); per_cu = 1; }
        (void)hipGetLastError();
        grid = cus * 1;
        if (ws_size < WS_END) fprintf(stderr, "kernel_launch: workspace too small: %zu < %zu\n", ws_size, (size_t)WS_END);
    }
    Params p{};
    for (int i = 0; i < 30; ++i) p.in[i] = (const float*)d_in[i];
    p.outp_ = (float*)d_out; p.wsp_ = (unsigned char*)d_ws;
    if (hipMemsetAsync((char*)d_ws + WS_BAR, 0, 16384, stream) != hipSuccess) fprintf(stderr, "kernel_launch: memset of barrier words failed\n");
    void* args[] = {&p};
    hipError_t e = hipLaunchCooperativeKernel((const void*)mega, dim3(grid), dim3(NTHREADS), args, LDS_BYTES, stream);
    if (e != hipSuccess) fprintf(stderr, "cooperative launch failed: %s (grid %d)\n", hipGetErrorString(e), grid);
}
```
